# Optimizing an MI355X kernel written in HIP

```python
import math
import jax
import jax.numpy as jnp
from jax import lax
import numpy as np

D_MODEL = 1024
BATCH = 8
SEQ = 2048
DEPTH = 4

N_MIXERS = 2
N_EVEN = (DEPTH + 1) // 2
N_ODD = DEPTH // 2
NORM_EPS = 1e-6

RWKV_HEAD_DIM = 64
RWKV_HEADS = D_MODEL // RWKV_HEAD_DIM
LORA_DECAY = 64
LORA_AAA = 64
LORA_MV = 32
LORA_GATE = 160
LNX_EPS = 64e-5
N_SHIFT_MIX = 6

S5_GROUP = 16
S5_GROUPS = D_MODEL // S5_GROUP
S5_STATE = 64
S5_DT_MIN = 1e-3
S5_DT_MAX = 1e-1
S5_EIG_MAX = -1e-4

D_FF = 2816
N_EXPERTS = 8
TOP_K = 2
D_EXPERT = 3584
MOE_BLOCK = 256

kernel_name = 'rwkv7_s5_moe_hybrid'


def rmsnorm(x, g):
    xf = x.astype(jnp.float32)
    y = xf * lax.rsqrt(jnp.mean(xf * xf, axis=-1, keepdims=True) + NORM_EPS)
    return (y * g.astype(jnp.float32)).astype(x.dtype)


def token_shift(x):
    return jnp.pad(x, ((0, 0), (1, 0), (0, 0)))[:, :-1]


def wkv7_scan(r, decay, k, v, a_vec, b_vec):
    bsz, _, nh, nd = r.shape

    def step(state, inp):
        r_t, w_t, k_t, v_t, a_t, b_t = inp
        sa = jnp.einsum('bhij,bhj->bhi', state, a_t)
        state = (state * w_t[:, :, None, :] + sa[..., None] * b_t[:, :, None, :]
                 + v_t[..., None] * k_t[:, :, None, :])
        return state, jnp.einsum('bhij,bhj->bhi', state, r_t)

    seq = tuple(jnp.moveaxis(t.astype(jnp.float32), 1, 0) for t in (r, decay, k, v, a_vec, b_vec))
    s0 = jnp.zeros((bsz, nh, nd, nd), jnp.float32)
    _, y = lax.scan(step, s0, seq)
    return jnp.moveaxis(y, 0, 1)


def rwkv7_time_mix(x, mu, w_rkv, w0, w1, w2, a0, a1, a2, g1, g2, k_k, k_a, r_k,
                   lnx_w, lnx_b, w_o, v_first, v_mix):
    bsz, seqlen, dim = x.shape
    heads = lambda t: t.reshape(bsz, seqlen, RWKV_HEADS, RWKV_HEAD_DIM)
    xx = token_shift(x) - x
    xs = x[None] + xx[None] * mu[:, None, None, :]
    r, k, v = jnp.einsum('sbtc,scd->sbtd', xs[:3], w_rkv)
    xv, xw, xa, xg = xs[2], xs[3], xs[4], xs[5]
    log_w = -jax.nn.softplus(-(w0 + jnp.tanh(xw @ w1) @ w2).astype(jnp.float32)) - 0.5
    decay = jnp.exp(-jnp.exp(log_w))
    if v_mix is None:
        v_first = v
    else:
        v0, v1, v2 = v_mix
        v = v + (v_first - v) * jax.nn.sigmoid(v0 + (xv @ v1) @ v2)
    a = jax.nn.sigmoid(a0 + (xa @ a1) @ a2)
    g = jax.nn.sigmoid(xg @ g1) @ g2
    kk = heads((k * k_k).astype(jnp.float32))
    kk = kk / jnp.maximum(jnp.linalg.norm(kk, axis=-1, keepdims=True), 1e-12)
    k = k * (1.0 + (a - 1.0) * k_a)
    rh, kh, vh, ah = heads(r), heads(k), heads(v), heads(a)
    y = wkv7_scan(rh, heads(decay), kh, vh, -kk, kk * ah)
    mean = jnp.mean(y, axis=-1, keepdims=True)
    var = jnp.mean((y - mean) ** 2, axis=-1, keepdims=True)
    y = (y - mean) * lax.rsqrt(var + LNX_EPS)
    y = (y * lnx_w.reshape(RWKV_HEADS, RWKV_HEAD_DIM).astype(jnp.float32)
         + lnx_b.reshape(RWKV_HEADS, RWKV_HEAD_DIM).astype(jnp.float32))
    bonus = jnp.sum(rh * kh * r_k, axis=-1, keepdims=True) * vh
    y = (y + bonus).reshape(bsz, seqlen, dim).astype(x.dtype)
    return (y * g) @ w_o, v_first


def _complex_scan_combine(earlier, later):
    a1r, a1i, b1r, b1i = earlier
    a2r, a2i, b2r, b2i = later
    return (a2r * a1r - a2i * a1i, a2r * a1i + a2i * a1r,
            a2r * b1r - a2i * b1i + b2r, a2r * b1i + a2i * b1r + b2i)


def s5_mixer(x, lam_re, lam_im, log_step, b_re, b_im, c_re, c_im, d_skip, w_glu, b_glu):
    bsz, seqlen, dim = x.shape
    f32 = jnp.float32
    u = x.astype(f32).reshape(bsz, seqlen, S5_GROUPS, S5_GROUP)
    lr = jnp.minimum(lam_re.astype(f32), S5_EIG_MAX)
    li = lam_im.astype(f32)
    dt = jnp.exp(log_step.astype(f32))[:, None]
    dr, di = lr * dt, li * dt
    abar_re = jnp.exp(dr) * jnp.cos(di)
    abar_im = jnp.exp(dr) * jnp.sin(di)
    num_re = jnp.expm1(dr) * jnp.cos(di) - 2.0 * jnp.sin(0.5 * di) ** 2
    den = lr * lr + li * li
    coef_re = (num_re * lr + abar_im * li) / den
    coef_im = (abar_im * lr - num_re * li) / den
    bre, bim = b_re.astype(f32), b_im.astype(f32)
    bbar_re = coef_re[..., None] * bre - coef_im[..., None] * bim
    bbar_im = coef_re[..., None] * bim + coef_im[..., None] * bre
    bu_re = jnp.einsum('btgc,gpc->btgp', u, bbar_re)
    bu_im = jnp.einsum('btgc,gpc->btgp', u, bbar_im)
    a_shape = (1, seqlen, S5_GROUPS, S5_STATE)
    elems = (jnp.broadcast_to(abar_re, a_shape), jnp.broadcast_to(abar_im, a_shape), bu_re, bu_im)
    _, _, h_re, h_im = lax.associative_scan(_complex_scan_combine, elems, axis=1)
    y = (jnp.einsum('btgp,gcp->btgc', h_re, c_re.astype(f32))
         - jnp.einsum('btgp,gcp->btgc', h_im, c_im.astype(f32)))
    y = y.reshape(bsz, seqlen, dim) + d_skip.astype(f32) * x.astype(f32)
    y = jax.nn.gelu(y).astype(x.dtype)
    z = y @ w_glu + b_glu
    return z[..., :dim] * jax.nn.sigmoid(z[..., dim:])


def swiglu(x, w_gate, w_up, w_down):
    return (jax.nn.silu(x @ w_gate) * (x @ w_up)) @ w_down


def moe_swiglu(x, router, w_gate, w_up, w_down):
    bsz, seqlen, dim = x.shape
    xt = x.reshape(-1, dim)
    n_tok = xt.shape[0]
    logits = (xt @ router).astype(jnp.float32)
    top_val, top_idx = lax.top_k(logits, TOP_K)
    gates = jax.nn.softmax(top_val, axis=-1)
    n_assign = n_tok * TOP_K
    expert_flat = top_idx.reshape(-1)
    token_flat = jnp.arange(n_assign, dtype=jnp.int32) // TOP_K
    gate_flat = gates.reshape(-1)
    order = jnp.argsort(expert_flat)
    exp_sorted = expert_flat[order]
    counts = jnp.bincount(expert_flat, length=N_EXPERTS)
    padded = (counts + MOE_BLOCK - 1) // MOE_BLOCK * MOE_BLOCK
    start = jnp.cumsum(counts) - counts
    pad_end = jnp.cumsum(padded)
    pad_start = pad_end - padded
    dest = pad_start[exp_sorted] + (jnp.arange(n_assign, dtype=jnp.int32) - start[exp_sorted])
    n_blocks = (n_assign + MOE_BLOCK - 1) // MOE_BLOCK + N_EXPERTS
    cap = n_blocks * MOE_BLOCK
    buf_tok = jnp.zeros((cap,), jnp.int32).at[dest].set(token_flat[order])
    buf_gate = jnp.zeros((cap,), jnp.float32).at[dest].set(gate_flat[order])
    block_start = jnp.arange(n_blocks, dtype=jnp.int32) * MOE_BLOCK
    block_expert = jnp.minimum(jnp.searchsorted(pad_end, block_start, side='right'), N_EXPERTS - 1)

    def block_ffn(args):
        tok, gate, e = args
        xb = xt[tok]
        h = jax.nn.silu(xb @ w_gate[e]) * (xb @ w_up[e])
        return (h @ w_down[e]) * gate[:, None].astype(x.dtype)

    out_blocks = lax.map(block_ffn, (buf_tok.reshape(n_blocks, MOE_BLOCK),
                                     buf_gate.reshape(n_blocks, MOE_BLOCK), block_expert))
    y = jnp.zeros_like(xt).at[buf_tok].add(out_blocks.reshape(cap, dim))
    return y.reshape(bsz, seqlen, dim)


def setup_inputs(seed: int = 0) -> dict:
    key = jax.random.key(seed)
    ks = iter(jax.random.split(key, 48))
    nrm = lambda shape, scale: scale * jax.random.normal(next(ks), shape, jnp.float32)
    uni = lambda shape, lo, hi: jax.random.uniform(next(ks), shape, jnp.float32, lo, hi)
    D, H, N = D_MODEL, RWKV_HEADS, RWKV_HEAD_DIM
    G, P, Q = S5_GROUPS, S5_STATE, S5_GROUP
    NE, NO, NR = N_EVEN, N_ODD, N_EVEN - 1
    E, F, FE = N_EXPERTS, D_FF, D_EXPERT
    return {
        'x': nrm((BATCH, SEQ, D), 1.0),
        'norm_mix': 1.0 + nrm((DEPTH, D), 0.02),
        'norm_ffn': 1.0 + nrm((DEPTH, D), 0.02),
        'final_norm': 1.0 + nrm((D,), 0.02),
        'rwkv_mu': uni((NE, N_SHIFT_MIX, D), 0.0, 1.0),
        'rwkv_w_rkv': nrm((NE, 3, D, D), D ** -0.5),
        'rwkv_w0': uni((NE, D), -6.0, -1.0),
        'rwkv_w1': nrm((NE, D, LORA_DECAY), D ** -0.5),
        'rwkv_w2': nrm((NE, LORA_DECAY, D), 0.1 * LORA_DECAY ** -0.5),
        'rwkv_a0': nrm((NE, D), 0.5),
        'rwkv_a1': nrm((NE, D, LORA_AAA), D ** -0.5),
        'rwkv_a2': nrm((NE, LORA_AAA, D), 0.1 * LORA_AAA ** -0.5),
        'rwkv_g1': nrm((NE, D, LORA_GATE), D ** -0.5),
        'rwkv_g2': nrm((NE, LORA_GATE, D), LORA_GATE ** -0.5),
        'rwkv_k_k': 0.85 + nrm((NE, D), 0.05),
        'rwkv_k_a': 1.0 + nrm((NE, D), 0.05),
        'rwkv_r_k': nrm((NE, H, N), 0.1),
        'rwkv_lnx_w': 1.0 + nrm((NE, D), 0.05),
        'rwkv_lnx_b': nrm((NE, D), 0.01),
        'rwkv_w_o': nrm((NE, D, D), D ** -0.5),
        'rwkv_v0': 1.0 + nrm((NR, D), 0.1),
        'rwkv_v1': nrm((NR, D, LORA_MV), D ** -0.5),
        'rwkv_v2': nrm((NR, LORA_MV, D), 0.1 * LORA_MV ** -0.5),
        's5_lam_re': -0.5 + nrm((NO, G, P), 0.01),
        's5_lam_im': jnp.pi * jnp.arange(P, dtype=jnp.float32) + nrm((NO, G, P), 0.01),
        's5_log_step': uni((NO, G), math.log(S5_DT_MIN), math.log(S5_DT_MAX)),
        's5_b_re': nrm((NO, G, P, Q), (2.0 * Q) ** -0.5),
        's5_b_im': nrm((NO, G, P, Q), (2.0 * Q) ** -0.5),
        's5_c_re': nrm((NO, G, Q, P), (2.0 * P) ** -0.5),
        's5_c_im': nrm((NO, G, Q, P), (2.0 * P) ** -0.5),
        's5_d': nrm((NO, D), 1.0),
        's5_w_glu': nrm((NO, D, 2 * D), D ** -0.5),
        's5_b_glu': nrm((NO, 2 * D), 0.01),
        'ffn_gate': nrm((NE, D, F), D ** -0.5),
        'ffn_up': nrm((NE, D, F), D ** -0.5),
        'ffn_down': nrm((NE, F, D), F ** -0.5),
        'moe_router': nrm((NO, D, E), D ** -0.5),
        'moe_gate': nrm((NO, E, D, FE), D ** -0.5),
        'moe_up': nrm((NO, E, D, FE), D ** -0.5),
        'moe_down': nrm((NO, E, FE, D), FE ** -0.5),
    }


def reference(x, norm_mix, norm_ffn, final_norm,
              rwkv_mu, rwkv_w_rkv, rwkv_w0, rwkv_w1, rwkv_w2, rwkv_a0, rwkv_a1, rwkv_a2,
              rwkv_g1, rwkv_g2, rwkv_k_k, rwkv_k_a, rwkv_r_k, rwkv_lnx_w, rwkv_lnx_b, rwkv_w_o,
              rwkv_v0, rwkv_v1, rwkv_v2,
              s5_lam_re, s5_lam_im, s5_log_step, s5_b_re, s5_b_im, s5_c_re, s5_c_im, s5_d,
              s5_w_glu, s5_b_glu,
              ffn_gate, ffn_up, ffn_down,
              moe_router, moe_gate, moe_up, moe_down):
    h = x
    v_first = None
    for i in range(DEPTH):
        j = i // N_MIXERS
        hn = rmsnorm(h, norm_mix[i])
        if i % N_MIXERS == 0:
            v_mix = None if j == 0 else (rwkv_v0[j - 1], rwkv_v1[j - 1], rwkv_v2[j - 1])
            mix, v_first = rwkv7_time_mix(
                hn, rwkv_mu[j], rwkv_w_rkv[j], rwkv_w0[j], rwkv_w1[j], rwkv_w2[j],
                rwkv_a0[j], rwkv_a1[j], rwkv_a2[j], rwkv_g1[j], rwkv_g2[j],
                rwkv_k_k[j], rwkv_k_a[j], rwkv_r_k[j], rwkv_lnx_w[j], rwkv_lnx_b[j],
                rwkv_w_o[j], v_first, v_mix)
        else:
            mix = s5_mixer(hn, s5_lam_re[j], s5_lam_im[j], s5_log_step[j], s5_b_re[j],
                           s5_b_im[j], s5_c_re[j], s5_c_im[j], s5_d[j], s5_w_glu[j], s5_b_glu[j])
        h = h + mix.astype(h.dtype)
        hn = rmsnorm(h, norm_ffn[i])
        if i % 2 == 0:
            ffn = swiglu(hn, ffn_gate[j], ffn_up[j], ffn_down[j])
        else:
            ffn = moe_swiglu(hn, moe_router[j], moe_gate[j], moe_up[j], moe_down[j])
        h = h + ffn.astype(h.dtype)
    return rmsnorm(h, final_norm)
```

```cpp
#include <hip/hip_runtime.h>
#include <cstdio>
#include <cstdint>

#ifndef MK_STOP_AFTER
#define MK_STOP_AFTER 38
#define MK_PROBE_SRC 1
#define MK_PROBE_Y2 1
#define MK_PROBE_OFF ((size_t)(WS_WR + WR_L2) - (size_t)WS_AR)
#define MK_PROBE_INP 9
#endif
#ifndef MK_CHUNKED
#define MK_CHUNKED 1
#endif
#ifndef MK_REPEAT
#define MK_REPEAT 0
#endif
#ifndef MK_N_LAUNCHES
#define MK_N_LAUNCHES 1
#endif

#define LAS __attribute__((address_space(3)))
#define GAS __attribute__((address_space(1)))
typedef unsigned short bf16_t;
typedef short bf16x8 __attribute__((ext_vector_type(8)));
typedef float f32x4 __attribute__((ext_vector_type(4)));
typedef float f32x2 __attribute__((ext_vector_type(2)));
typedef unsigned u32x4 __attribute__((ext_vector_type(4)));
typedef unsigned u32x2 __attribute__((ext_vector_type(2)));

constexpr int M = 16384, D = 1024, T = 2048, NH = 16, HD = 64;
constexpr int FF = 2816, FE = 3584, NEXP = 8, NASG = 2 * M, CAP = NASG + NEXP * 256;
constexpr int S5L = 32, NBC = M / S5L, S5K = 640;
constexpr float NORM_EPS = 1e-6f, LNX_EPS = 64e-5f;
constexpr int NTHREADS = 512, NWAVES = 8;

constexpr size_t MiB = (size_t)1 << 20;
constexpr size_t WS_CTL = 0, CTL_BYTES = 1 * MiB;
constexpr size_t WS_WR = 1 * MiB, WR_STRIDE = 29 * MiB;
constexpr size_t WR_RKV = 0, WR_L1 = 6 * MiB, WR_L2 = 8 * MiB, WR_WO = 10 * MiB, WR_GU = 12 * MiB, WR_WD = 23 * MiB;
constexpr size_t WS_WS = 59 * MiB, WSS_STRIDE = 60 * MiB;
constexpr size_t WSS_GLU = 0, WSS_TOEP = 4 * MiB, WSS_M1 = 44 * MiB;
constexpr size_t WS_WM = 179 * MiB, WM_GU = 0, WM_WD = 112 * MiB;
constexpr size_t WS_H0 = 347 * MiB, WS_VF = 411 * MiB, WS_Y2 = 443 * MiB, WS_AR = 507 * MiB, WS_Y2T = 847 * MiB, WS_TROW = 859 * MiB, WS_END = 860 * MiB;
constexpr size_t AR_XS = 0, AR_R = 192 * MiB, AR_K = 224 * MiB, AR_V = 256 * MiB, AR_L1 = 288 * MiB;
constexpr size_t AR_LW = 0, AR_A = 32 * MiB, AR_G = 64 * MiB, AR_YRAW = 96 * MiB, AR_YG = 160 * MiB;
constexpr size_t AR_HN2 = 0, AR_HMID = 32 * MiB;
constexpr size_t AR_UG = 0, AR_EB = 40 * MiB, AR_YACT = 56 * MiB;
constexpr size_t AR_ASG = 32 * MiB, AR_XSM = 33 * MiB, AR_ROWM = 101 * MiB, AR_HMIDM = 102 * MiB;
static_assert(AR_HMIDM + (size_t)CAP * FE * 2 <= WS_Y2T - WS_AR, "arena");
constexpr int MOE_MAIN_TILES = 128, MOE_TAIL_ROW0 = MOE_MAIN_TILES * 256;
static_assert(WR_WD + (size_t)D * FF * 2 <= WR_STRIDE, "wr");
constexpr int CW_BAR = 4096;
constexpr int CW_MOECNT = 16384;
constexpr int RING_BYTES = 131072, LDSCTL_OFF = RING_BYTES, MISC_OFF = LDSCTL_OFF + 320, PTAB_OFF = LDSCTL_OFF + 1024, LDS_BYTES = 147456;

constexpr int NPH = 40;

#define VM_WAIT() asm volatile("s_waitcnt vmcnt(0)" ::: "memory")
typedef __bf16 bf16x2_n __attribute__((ext_vector_type(2)));
__device__ __forceinline__ unsigned cvt_pk_bf16(float lo, float hi) { const f32x2 v = {lo, hi}; return __builtin_bit_cast(unsigned, __builtin_convertvector(v, bf16x2_n)); }
__device__ __forceinline__ float bf_lo(unsigned u) { return __uint_as_float(u << 16); }
__device__ __forceinline__ float bf_hi(unsigned u) { return __uint_as_float(u & 0xffff0000u); }
__device__ __forceinline__ float fsigmoid(float x) { return __builtin_amdgcn_rcpf(1.0f + __expf(-x)); }
__device__ __forceinline__ float ftanh(float x) { return 1.0f - 2.0f * __builtin_amdgcn_rcpf(__expf(2.0f * x) + 1.0f); }
__device__ __forceinline__ float fgelu(float x) { const float u = 0.7978845608f * (x + 0.044715f * x * x * x); return x * fsigmoid(2.0f * u); }
template <int CTRL> __device__ __forceinline__ float dpp_f(float x) { return __int_as_float(__builtin_amdgcn_update_dpp(0, __float_as_int(x), CTRL, 0xf, 0xf, true)); }
__device__ __forceinline__ float quad_sum(float x) { x += dpp_f<0xB1>(x); x += dpp_f<0x4E>(x); return x; }
__device__ __forceinline__ float row16_sum(float x) { x = quad_sum(x); x += dpp_f<0x141>(x); x += dpp_f<0x140>(x); return x; }
__device__ __forceinline__ float wave_sum(float v) {
    v = row16_sum(v);
    const float a = __int_as_float(__builtin_amdgcn_readlane(__float_as_int(v), 0)), b = __int_as_float(__builtin_amdgcn_readlane(__float_as_int(v), 16));
    const float c = __int_as_float(__builtin_amdgcn_readlane(__float_as_int(v), 32)), d = __int_as_float(__builtin_amdgcn_readlane(__float_as_int(v), 48));
    return (a + b) + (c + d);
}
__device__ __forceinline__ u32x4 pack8(const f32x4 a, const f32x4 b) { u32x4 w; w.x = cvt_pk_bf16(a[0], a[1]); w.y = cvt_pk_bf16(a[2], a[3]); w.z = cvt_pk_bf16(b[0], b[1]); w.w = cvt_pk_bf16(b[2], b[3]); return w; }
__device__ __forceinline__ void unpack8(const u32x4 w, f32x4& a, f32x4& b) { a = (f32x4){bf_lo(w.x), bf_hi(w.x), bf_lo(w.y), bf_hi(w.y)}; b = (f32x4){bf_lo(w.z), bf_hi(w.z), bf_lo(w.w), bf_hi(w.w)}; }

__device__ __forceinline__ const GAS float* inp_ptr(LAS unsigned long long* tab, int i) {
    const unsigned long long v = tab[i]; const unsigned lo = (unsigned)__builtin_amdgcn_readfirstlane((int)(unsigned)v), hi = (unsigned)__builtin_amdgcn_readfirstlane((int)(unsigned)(v >> 32));
    return (const GAS float*)(((unsigned long long)hi << 32) | lo);
}
#define XB_TMO      128
#define XB_XCNT(j)  (256  + 64 * (j))
#define XB_XSUB(j)  (1280 + 64 * (j))
#define XB_XGEN(j)  (2304 + 64 * (j))
#define XB_TOP      3328
#define XB_TOPGEN   3392
#define XCD_BAR_WORDS 3456
#define XB_SPIN_CAP (1u << 18)
__device__ __forceinline__ unsigned xb_ld(unsigned* p)              { return __hip_atomic_load(p, __ATOMIC_RELAXED, __HIP_MEMORY_SCOPE_AGENT); }
__device__ __forceinline__ unsigned xb_add(unsigned* p, unsigned v) { return __hip_atomic_fetch_add(p, v, __ATOMIC_RELAXED, __HIP_MEMORY_SCOPE_AGENT); }
__device__ __forceinline__ unsigned xb_xcc_id() { return (unsigned)__builtin_amdgcn_s_getreg((3 << 11) | 20) & 0xFu; }
#define XB_SPIN(cond, bar) do { unsigned _sp = 0; while (cond) { __builtin_amdgcn_s_sleep(1); \
    if ((++_sp & 255u) == 0u) { if (xb_ld(&(bar)[XB_TMO])) break; if (_sp > XB_SPIN_CAP) { atomicAdd(&(bar)[XB_TMO], 1u); break; } } } } while (0)
struct XcdBarrier { unsigned* bar; unsigned x; volatile LAS unsigned* st; };
__device__ __forceinline__ XcdBarrier xcd_barrier_post(unsigned* bar, volatile LAS unsigned* st) {
    XcdBarrier b; b.bar = bar; b.x = xb_xcc_id(); b.st = st;
    if (threadIdx.x == 0) (void)xb_add(&bar[XB_XCNT(b.x)], 1u);
    return b;
}
__device__ __forceinline__ void xcd_barrier_complete(unsigned* bar, unsigned x, unsigned& nloc, unsigned& nx) {
    const unsigned G = gridDim.x * gridDim.y * gridDim.z;
    unsigned sum, cnt, mine, sp = 0u;
    for (;;) {
        sum = 0u; cnt = 0u; mine = 0u;
#pragma unroll
        for (unsigned j = 0; j < 16; ++j) { const unsigned c = xb_ld(&bar[XB_XCNT(j)]); sum += c; cnt += (c > 0u) ? 1u : 0u; mine = (j == x) ? c : mine; }
        if (sum == G) break;
        __builtin_amdgcn_s_sleep(1);
        if ((++sp & 255u) == 0u) { if (xb_ld(&bar[XB_TMO])) break; if (sp > XB_SPIN_CAP) { atomicAdd(&bar[XB_TMO], 1u); break; } }
    }
    nloc = mine > 0u ? mine : 1u; nx = cnt > 0u ? cnt : 1u;
}
__device__ __forceinline__ void xcd_barrier(const XcdBarrier& b) {
    asm volatile("s_waitcnt vmcnt(0)" ::: "memory");
    __syncthreads();
    if (threadIdx.x == 0) {
        unsigned* bar = b.bar;
        __builtin_amdgcn_s_waitcnt(0);
        unsigned nloc = b.st[0], nx = b.st[1];
        if (nloc == 0u) { xcd_barrier_complete(bar, b.x, nloc, nx); b.st[0] = nloc; b.st[1] = nx; }
        const unsigned old = xb_add(&bar[XB_XSUB(b.x)], 1u);
        const unsigned gen = old / nloc;
        if (old + 1u == (gen + 1u) * nloc) {
            __builtin_amdgcn_fence(__ATOMIC_RELEASE, "agent");
            asm volatile("s_waitcnt vmcnt(0)" ::: "memory");
            const unsigned og = xb_add(&bar[XB_TOP], 1u);
            const unsigned tg = og / nx;
            if (og + 1u == (tg + 1u) * nx) xb_add(&bar[XB_TOPGEN], 1u);
            else XB_SPIN(xb_ld(&bar[XB_TOPGEN]) == tg, bar);
            __builtin_amdgcn_fence(__ATOMIC_ACQUIRE, "agent");
            xb_add(&bar[XB_XGEN(b.x)], 1u);
            asm volatile("s_waitcnt vmcnt(0)" ::: "memory");
        } else {
            XB_SPIN(xb_ld(&bar[XB_XGEN(b.x)]) == gen, bar);
            __builtin_amdgcn_fence(__ATOMIC_ACQUIRE, "agent");
            asm volatile("s_waitcnt vmcnt(0)" ::: "memory");
        }
    }
    __syncthreads();
}

struct GUnit { const GAS char* A; const GAS char* B; int pm, pn, kind, pad; };
__device__ __forceinline__ int perm32(int rho) { const int n = rho >> 4, i = rho & 15; return 8 * (i >> 2) + 4 * n + (i & 3); }
__device__ __forceinline__ void tile_order(int L, int nM, int nN, int& pm, int& pn) {
    const int nwg = nM * nN; int wgid = L;
    { const int q = nwg / 8, r = nwg % 8, xcd = wgid % 8, off = wgid / 8; wgid = (xcd < r ? xcd * (q + 1) : r * (q + 1) + (xcd - r) * q) + off; }
    const int nig = 8 * nN, gid = wgid / nig, fm = gid * 8, gsz = (nM - fm) < 8 ? (nM - fm) : 8;
    pm = fm + ((wgid % nig) % gsz); pn = (wgid % nig) / gsz;
}

template <class Epi, class Sched>
__device__ __forceinline__ void gemm_phase_simple(LAS unsigned char* lds, int K, int lda, int ldb, const Sched& S, const Epi& E) {
    (void)lds;
    const int tid = threadIdx.x, wid = __builtin_amdgcn_readfirstlane(tid >> 6), lane = tid & 63, wr = wid >> 2, wc = wid & 3, fr = lane & 15, fq = lane >> 4;
    for (int ui = 0;; ++ui) {
        GUnit u; if (!S.next(ui, u)) break;
        f32x4 acc[2][2][4][2];
#pragma unroll
        for (int a = 0; a < 2; ++a)
#pragma unroll
            for (int b = 0; b < 2; ++b)
#pragma unroll
                for (int m = 0; m < 4; ++m)
#pragma unroll
                    for (int n = 0; n < 2; ++n) acc[a][b][m][n] = (f32x4){0.f, 0.f, 0.f, 0.f};
        const GAS char* Ap = u.A + ((size_t)(wr * 64 + fr) * lda + fq * 8) * 2;
        const GAS char* Bp0 = u.B + ((size_t)(wc * 32 + perm32(fr)) * ldb + fq * 8) * 2;
        const GAS char* Bp1 = u.B + ((size_t)(wc * 32 + perm32(16 + fr)) * ldb + fq * 8) * 2;
#pragma unroll 1
        for (int k0 = 0; k0 < K; k0 += 32) {
            bf16x8 a[2][4], b[2][2];
#pragma unroll
            for (int ai = 0; ai < 2; ++ai)
#pragma unroll
                for (int m = 0; m < 4; ++m) a[ai][m] = *(const GAS bf16x8*)(Ap + ((size_t)(ai * 128 + m * 16) * lda + k0) * 2);
#pragma unroll
            for (int bj = 0; bj < 2; ++bj) { b[bj][0] = *(const GAS bf16x8*)(Bp0 + ((size_t)(bj * 128) * ldb + k0) * 2); b[bj][1] = *(const GAS bf16x8*)(Bp1 + ((size_t)(bj * 128) * ldb + k0) * 2); }
#pragma unroll
            for (int ai = 0; ai < 2; ++ai)
#pragma unroll
                for (int bj = 0; bj < 2; ++bj)
#pragma unroll
                    for (int m = 0; m < 4; ++m)
#pragma unroll
                        for (int n = 0; n < 2; ++n) acc[ai][bj][m][n] = __builtin_amdgcn_mfma_f32_16x16x32_bf16(b[bj][n], a[ai][m], acc[ai][bj][m][n], 0, 0, 0);
        }
        E(acc, u, wr, wc, fr, fq);
    }
}

constexpr int HTB = 128 * 64 * 2;
__device__ __forceinline__ int lds_byte(int r, int c) { const int st = (r >> 4) * 2 + (c >> 5), rr = r & 15, cc = c & 31, ob = rr * 64 + cc * 2; return st * 1024 + (ob ^ (((ob >> 9) & 1) << 5)); }
__device__ __forceinline__ void stage_rc(int b, int& R, int& C) { const int st = b / 1024, sb = b % 1024, swz = sb ^ (((sb >> 9) & 1) << 5); R = (st >> 1) * 16 + swz / 64; C = (st & 1) * 32 + (swz % 64) / 2; }
template <class S> struct sched_gather { static constexpr bool value = false; };
__device__ __forceinline__ const GAS char* uni_ptr(const GAS char* p) {
    const unsigned long long v = (unsigned long long)p; const unsigned lo = (unsigned)__builtin_amdgcn_readfirstlane((int)(unsigned)v), hi = (unsigned)__builtin_amdgcn_readfirstlane((int)(unsigned)(v >> 32));
    return (const GAS char*)(((unsigned long long)hi << 32) | lo);
}
template <class Epi, class Sched>
__device__ __forceinline__ void gemm_phase(LAS unsigned char* lds, int tid, int K, int lda, int ldb, const Sched& S, const Epi& E) {
    const int wid = __builtin_amdgcn_readfirstlane(tid >> 6), lane = tid & 63, wr = wid >> 2, wc = wid & 3, fr = lane & 15, fq = lane >> 4;
    const int nt = K / 64;
    constexpr bool GA = sched_gather<Sched>::value;
    unsigned voffA[2], voffB[2];
    unsigned voA[2][2], voN[2][2];
#pragma unroll
    for (int i = 0; i < 2; ++i) { int R, C; stage_rc(tid * 16 + i * 8192, R, C); const int Rb = (R & ~31) + perm32(R & 31);
        voffA[i] = (unsigned)(R * lda + C) * 2u; voffB[i] = (unsigned)(Rb * ldb + C) * 2u; }
#define PG8_STAGE_A(bufoff, base, half) do { if constexpr (GA) PG8_STAGE(bufoff, base, voA[half]); else PG8_STAGE(bufoff, (base) + (half) * hstepA, voffA); } while (0)
    const size_t kstep = 128;
    const size_t hstepA = (size_t)128 * lda * 2, hstepB = (size_t)128 * ldb * 2;
    const unsigned ldsw = (unsigned)wid * 1024u;
    const int aoff = lds_byte(wr * 64 + fr, fq * 8), boff = lds_byte(wc * 32 + fr, fq * 8);
#define PG8_SA(b, h) (((b) * 2 + (h)) * HTB)
#define PG8_SB(b, h) ((4 + (b) * 2 + (h)) * HTB)
#define PG8_STAGE(bufoff, gbase, voff) do { const GAS char* _b = uni_ptr(gbase); _Pragma("unroll") for (int _i = 0; _i < 2; ++_i) \
        __builtin_amdgcn_global_load_lds((const GAS unsigned*)(_b + (voff)[_i]), (LAS unsigned*)(lds + (bufoff) + ldsw + _i * 8192), 16, 0, 0); } while (0)
#define PG8_LDA(dst, b, h) do { _Pragma("unroll") for (int m = 0; m < 4; ++m) _Pragma("unroll") for (int k = 0; k < 2; ++k) dst[m][k] = *(const LAS bf16x8*)(lds + PG8_SA(b, h) + aoff + m * 2048 + k * 1024); } while (0)
#define PG8_LDB(dst, b, h) do { _Pragma("unroll") for (int n = 0; n < 2; ++n) _Pragma("unroll") for (int k = 0; k < 2; ++k) dst[n][k] = *(const LAS bf16x8*)(lds + PG8_SB(b, h) + boff + n * 2048 + k * 1024); } while (0)
#define PG8_MMA(ai, bj, At, Bt) do { __builtin_amdgcn_s_setprio(1); _Pragma("unroll") for (int m = 0; m < 4; ++m) _Pragma("unroll") for (int n = 0; n < 2; ++n) _Pragma("unroll") for (int k = 0; k < 2; ++k) \
        acc[ai][bj][m][n] = __builtin_amdgcn_mfma_f32_16x16x32_bf16(Bt[n][k], At[m][k], acc[ai][bj][m][n], 0, 0, 0); __builtin_amdgcn_s_setprio(0); } while (0)
#define PG8_WAIT_V(n) asm volatile("s_waitcnt vmcnt(" #n ")" ::: "memory")
#define PG8_WAIT_L(n) asm volatile("s_waitcnt lgkmcnt(" #n ")" ::: "memory")
#define PG8_BAR __builtin_amdgcn_s_barrier()
#define PG8_SCHED __builtin_amdgcn_sched_barrier(0)
    GUnit cur, nxt; int ui = 0;
    if (!S.next(0, cur)) return;
    f32x4 acc[2][2][4][2];
#pragma unroll
    for (int a = 0; a < 2; ++a)
#pragma unroll
        for (int b = 0; b < 2; ++b)
#pragma unroll
            for (int m = 0; m < 4; ++m)
#pragma unroll
                for (int n = 0; n < 2; ++n) acc[a][b][m][n] = (f32x4){0.f, 0.f, 0.f, 0.f};
    bf16x8 At[4][2], B0[2][2], B1[2][2];
    const GAS char* cA = uni_ptr(cur.A); const GAS char* cB = uni_ptr(cur.B);
    if constexpr (GA) S.load_offs(cur.pm, tid, voA);
    PG8_STAGE(PG8_SB(0, 0), cB, voffB); PG8_STAGE(PG8_SB(0, 1), cB + hstepB, voffB); PG8_STAGE_A(PG8_SA(0, 0), cA, 0); PG8_STAGE_A(PG8_SA(0, 1), cA, 1);
    if (wr == 1) PG8_BAR;
    PG8_WAIT_V(2); PG8_BAR;
    PG8_STAGE(PG8_SB(1, 0), cB + kstep, voffB); PG8_STAGE_A(PG8_SA(1, 0), cA + kstep, 0); PG8_STAGE(PG8_SB(1, 1), cB + hstepB + kstep, voffB);
    PG8_WAIT_V(6); PG8_BAR;
    for (;;) {
        const bool has_next = S.next(ui + 1, nxt);
        const GAS char* nA = has_next ? uni_ptr(nxt.A) : cA; const GAS char* nB = has_next ? uni_ptr(nxt.B) : cB;
        if constexpr (GA) { if (has_next && nxt.pm != cur.pm) S.load_offs(nxt.pm, tid, voN); else {
#pragma unroll
            for (int h_ = 0; h_ < 2; ++h_) { voN[h_][0] = voA[h_][0]; voN[h_][1] = voA[h_][1]; } } }
        for (int t = 0; t < nt; t += 2) {
            const bool last = (t == nt - 2);
            const GAS char* a1 = cA + (size_t)(t + 1) * kstep;
            const GAS char* a2 = last ? nA : cA + (size_t)(t + 2) * kstep; const GAS char* b2 = last ? nB : cB + (size_t)(t + 2) * kstep;
            const GAS char* a3 = a2 + kstep; const GAS char* b3 = b2 + kstep;
            PG8_LDB(B0, 0, 0); PG8_LDB(B1, 0, 1); PG8_SCHED; PG8_LDA(At, 0, 0); PG8_STAGE_A(PG8_SA(1, 1), a1, 1);
            if constexpr (GA) { if (last) {
#pragma unroll
                for (int h_ = 0; h_ < 2; ++h_) { voA[h_][0] = voN[h_][0]; voA[h_][1] = voN[h_][1]; } } }
            PG8_WAIT_V(8); PG8_WAIT_L(0); PG8_BAR; PG8_MMA(0, 0, At, B0); PG8_MMA(0, 1, At, B1); PG8_BAR; PG8_SCHED;
            PG8_LDA(At, 0, 1); PG8_STAGE(PG8_SB(0, 0), b2, voffB); PG8_STAGE(PG8_SB(0, 1), b2 + hstepB, voffB); PG8_STAGE_A(PG8_SA(0, 0), a2, 0);
            PG8_WAIT_V(8); PG8_WAIT_L(0); PG8_BAR; PG8_MMA(1, 0, At, B0); PG8_MMA(1, 1, At, B1); PG8_BAR; PG8_SCHED;
            PG8_LDB(B0, 1, 0); PG8_LDB(B1, 1, 1); PG8_SCHED; PG8_LDA(At, 1, 0); PG8_STAGE_A(PG8_SA(0, 1), a2, 1);
            PG8_WAIT_V(8); PG8_WAIT_L(0); PG8_BAR; PG8_MMA(0, 0, At, B0); PG8_MMA(0, 1, At, B1); PG8_BAR; PG8_SCHED;
            PG8_LDA(At, 1, 1); PG8_STAGE(PG8_SB(1, 0), b3, voffB); PG8_STAGE(PG8_SB(1, 1), b3 + hstepB, voffB); PG8_STAGE_A(PG8_SA(1, 0), a3, 0);
            PG8_WAIT_V(8); PG8_WAIT_L(0); PG8_BAR; PG8_MMA(1, 0, At, B0); PG8_MMA(1, 1, At, B1); PG8_BAR; PG8_SCHED;
        }
        if (wr == 0) PG8_BAR;
        E(acc, cur, wr, wc, fr, fq);
        if (!has_next) break;
#pragma unroll
        for (int a = 0; a < 2; ++a)
#pragma unroll
            for (int b = 0; b < 2; ++b)
#pragma unroll
                for (int m = 0; m < 4; ++m)
#pragma unroll
                    for (int n = 0; n < 2; ++n) acc[a][b][m][n] = (f32x4){0.f, 0.f, 0.f, 0.f};
        cur = nxt; cA = nA; cB = nB; ++ui;
        if (wr == 1) PG8_BAR;
    }
    PG8_WAIT_V(0);
    PG8_BAR;
#undef PG8_SA
#undef PG8_SB
#undef PG8_STAGE
#undef PG8_STAGE_A
#undef PG8_LDA
#undef PG8_LDB
#undef PG8_MMA
#undef PG8_WAIT_V
#undef PG8_WAIT_L
#undef PG8_BAR
#undef PG8_SCHED
}

struct SchedPlain {
    const GAS char* A; const GAS char* B; size_t tA, tB; int nM, nN, G, c;
    __device__ __forceinline__ bool next(int i, GUnit& u) const {
        const int L = i * G + c; if (L >= nM * nN) return false;
        int pm, pn; tile_order(L, nM, nN, pm, pn);
        u.A = A + (size_t)pm * tA; u.B = B + (size_t)pn * tB; u.pm = pm; u.pn = pn; u.kind = 0; u.pad = 0; return true;
    }
};
struct SchedR2 {
    const GAS char* xs; const GAS char* Wrkv; const GAS char* Wl1; int nvn, G, c;
    __device__ __forceinline__ bool next(int i, GUnit& u) const {
        const int L = i * G + c; if (L >= 64 * nvn) return false;
        int pm, vn; tile_order(L, 64, nvn, pm, vn);
        int kind, pn, s; const GAS char* B;
        if (vn < 12) { kind = vn >> 2; pn = vn & 3; s = kind; B = Wrkv + (size_t)kind * D * D * 2 + (size_t)pn * 256 * D * 2; }
        else { kind = vn - 9; pn = 0; s = (kind == 6) ? 2 : kind; B = Wl1 + (size_t)(kind - 3) * 256 * D * 2; }
        u.A = xs + (size_t)s * M * D * 2 + (size_t)pm * 256 * D * 2; u.B = B; u.pm = pm; u.pn = pn; u.kind = kind; u.pad = 0; return true;
    }
};
struct SchedR3 {
    const GAS char* l1; const GAS char* Wl2; int nvn, G, c;
    __device__ __forceinline__ bool next(int i, GUnit& u) const {
        const int L = i * G + c; if (L >= 64 * nvn) return false;
        int pm, vn; tile_order(L, 64, nvn, pm, vn);
        const int kind = vn >> 2, pn = vn & 3;
        u.A = l1 + (size_t)kind * M * 256 * 2 + (size_t)pm * 256 * 256 * 2; u.B = Wl2 + (size_t)kind * D * 256 * 2 + (size_t)pn * 256 * 256 * 2;
        u.pm = pm; u.pn = pn; u.kind = kind; u.pad = 0; return true;
    }
};
struct SchedGrp {
    const GAS char* A; const GAS char* B; size_t gA, tA, gB, tB; int nMg, nNg, ng, G, vcu;
    __device__ __forceinline__ bool next(int i, GUnit& u) const {
        const int L = i * G + vcu, per = nMg * nNg; if (L >= ng * per) return false;
        const int g = L / per, r = L % per, pm = r % nMg, pn = r / nMg;
        u.A = A + (size_t)g * gA + (size_t)pm * tA; u.B = B + (size_t)g * gB + (size_t)pn * tB; u.pm = pm; u.pn = pn; u.kind = g; u.pad = 0; return true;
    }
};
struct SchedOne {
    GUnit u0;
    __device__ __forceinline__ bool next(int i, GUnit& u) const { if (i != 0) return false; u = u0; return true; }
};
struct SchedMoe {
    const GAS char* A; const GAS char* W; size_t tA, eW, tB; int nN, G, c; volatile LAS unsigned* tpre;
    __device__ __forceinline__ bool next(int i, GUnit& u) const {
        const int MT = (int)tpre[8]; const int L = i * G + c; if (L >= MT * nN) return false;
        int pm, pn; tile_order(L, MT, nN, pm, pn);
        int e = 0;
#pragma unroll
        for (int q = 1; q < 8; ++q) e += ((int)tpre[q] <= pm) ? 1 : 0;
        e = __builtin_amdgcn_readfirstlane(e);
        u.A = A + (size_t)pm * tA; u.B = W + (size_t)e * eW + (size_t)pn * tB; u.pm = pm; u.pn = pn; u.kind = e; u.pad = 0; return true;
    }
};

#define EPI_ARGS const f32x4 (&acc)[2][2][4][2], const GUnit& u, int wr, int wc, int fr, int fq
struct EpiR2 {
    GAS bf16_t* rk; GAS bf16_t* vdst; GAS bf16_t* l1;
    __device__ __forceinline__ void operator()(EPI_ARGS) const {
        const int kind = u.kind; GAS bf16_t* base; int ldc, act = 0;
        if (kind < 3) { base = (kind == 2) ? vdst : rk + (size_t)kind * M * D; ldc = D; }
        else { base = l1 + (size_t)(kind - 3) * M * 256; ldc = 256; act = (kind == 3) ? 1 : ((kind == 5) ? 2 : 0); }
        const int row0 = u.pm * 256 + wr * 64 + fr, col0 = u.pn * 256 + wc * 32 + 8 * fq;
#pragma unroll
        for (int ai = 0; ai < 2; ++ai)
#pragma unroll
            for (int m = 0; m < 4; ++m) { GAS bf16_t* rowp = base + (size_t)(row0 + ai * 128 + m * 16) * ldc + col0;
#pragma unroll
                for (int bj = 0; bj < 2; ++bj) { f32x4 v0 = acc[ai][bj][m][0], v1 = acc[ai][bj][m][1];
                    if (act == 1) {
#pragma unroll
                        for (int j = 0; j < 4; ++j) { v0[j] = ftanh(v0[j]); v1[j] = ftanh(v1[j]); } }
                    if (act == 2) {
#pragma unroll
                        for (int j = 0; j < 4; ++j) { v0[j] = fsigmoid(v0[j]); v1[j] = fsigmoid(v1[j]); } }
                    *(GAS u32x4*)(rowp + bj * 128) = pack8(v0, v1); } }
    }
};
struct EpiR3 {
    GAS unsigned char* wsl; LAS unsigned long long* ptab; int j;
    template <int KIND> __device__ __forceinline__ void run(EPI_ARGS) const {
        GAS unsigned char* ar = wsl + WS_AR;
        GAS bf16_t* vbuf = (j == 0) ? (GAS bf16_t*)(wsl + WS_VF) : (GAS bf16_t*)(ar + AR_V); const GAS bf16_t* vfirst = (const GAS bf16_t*)(wsl + WS_VF);
        const GAS float* bias = inp_ptr(ptab, KIND == 0 ? 6 : (KIND == 1 ? 9 : 20)) + (size_t)((KIND == 3) ? 0 : j) * D;
        GAS bf16_t* base = (KIND == 3) ? vbuf : (GAS bf16_t*)(ar + AR_LW) + (size_t)KIND * M * D;
        const int row0 = u.pm * 256 + wr * 64 + fr, col0 = u.pn * 256 + wc * 32 + 8 * fq;
        f32x4 bv[2][2];
#pragma unroll
        for (int bj = 0; bj < 2; ++bj) { if (KIND != 2) { bv[bj][0] = *(const GAS f32x4*)(bias + col0 + bj * 128); bv[bj][1] = *(const GAS f32x4*)(bias + col0 + bj * 128 + 4); } else { bv[bj][0] = (f32x4){0.f, 0.f, 0.f, 0.f}; bv[bj][1] = bv[bj][0]; } }
#pragma unroll
        for (int ai = 0; ai < 2; ++ai)
#pragma unroll
            for (int m = 0; m < 4; ++m) { const size_t off = (size_t)(row0 + ai * 128 + m * 16) * D + col0;
#pragma unroll
                for (int bj = 0; bj < 2; ++bj) { f32x4 x0 = acc[ai][bj][m][0] + bv[bj][0], x1 = acc[ai][bj][m][1] + bv[bj][1];
                    if (KIND == 0) {
#pragma unroll
                        for (int j = 0; j < 4; ++j) { x0[j] = -0.60653066f * fsigmoid(x0[j]); x1[j] = -0.60653066f * fsigmoid(x1[j]); } }
                    else if (KIND == 1) {
#pragma unroll
                        for (int j = 0; j < 4; ++j) { x0[j] = fsigmoid(x0[j]); x1[j] = fsigmoid(x1[j]); } }
                    else if (KIND == 3) {
                        f32x4 va, vb, fa, fb; unpack8(*(const GAS u32x4*)(vbuf + off + bj * 128), va, vb); unpack8(*(const GAS u32x4*)(vfirst + off + bj * 128), fa, fb);
#pragma unroll
                        for (int j = 0; j < 4; ++j) { x0[j] = va[j] + (fa[j] - va[j]) * fsigmoid(x0[j]); x1[j] = vb[j] + (fb[j] - vb[j]) * fsigmoid(x1[j]); } }
                    *(GAS u32x4*)(base + off + bj * 128) = pack8(x0, x1); } }
    }
    __device__ __forceinline__ void operator()(EPI_ARGS) const {
        const int kind = u.kind;
        if (kind == 0) run<0>(acc, u, wr, wc, fr, fq);
        else if (kind == 1) run<1>(acc, u, wr, wc, fr, fq);
        else if (kind == 2) run<2>(acc, u, wr, wc, fr, fq);
        else run<3>(acc, u, wr, wc, fr, fq);
    }
};
struct EpiRes {
    const GAS float* hin; GAS float* hout;
    __device__ __forceinline__ void operator()(EPI_ARGS) const {
        const int row0 = u.pm * 256 + wr * 64 + fr, col0 = u.pn * 256 + wc * 32 + 8 * fq;
#pragma unroll
        for (int ai = 0; ai < 2; ++ai)
#pragma unroll
            for (int m = 0; m < 4; ++m) { const size_t off = (size_t)(row0 + ai * 128 + m * 16) * D + col0;
#pragma unroll
                for (int bj = 0; bj < 2; ++bj) {
                    const f32x4 h0 = *(const GAS f32x4*)(hin + off + bj * 128), h1 = *(const GAS f32x4*)(hin + off + bj * 128 + 4);
                    *(GAS f32x4*)(hout + off + bj * 128) = h0 + acc[ai][bj][m][0]; *(GAS f32x4*)(hout + off + bj * 128 + 4) = h1 + acc[ai][bj][m][1]; } }
    }
};
struct EpiSwiglu {
    GAS bf16_t* out; int ldc;
    __device__ __forceinline__ void operator()(EPI_ARGS) const {
        const int row0 = u.pm * 256 + wr * 64 + fr, col0 = u.pn * 128 + wc * 32 + 8 * fq;
#pragma unroll
        for (int ai = 0; ai < 2; ++ai)
#pragma unroll
            for (int m = 0; m < 4; ++m) { f32x4 o0, o1;
#pragma unroll
                for (int j = 0; j < 4; ++j) { const float g0 = acc[ai][0][m][0][j], g1 = acc[ai][0][m][1][j]; o0[j] = g0 * fsigmoid(g0) * acc[ai][1][m][0][j]; o1[j] = g1 * fsigmoid(g1) * acc[ai][1][m][1][j]; }
                *(GAS u32x4*)(out + (size_t)(row0 + ai * 128 + m * 16) * ldc + col0) = pack8(o0, o1); }
    }
};
struct EpiGlu {
    GAS float* h; const GAS float* bglu;
    __device__ __forceinline__ void operator()(EPI_ARGS) const {
        const int row0 = u.pm * 256 + wr * 64 + fr, col0 = u.pn * 128 + wc * 32 + 8 * fq;
        const f32x4 bv0 = *(const GAS f32x4*)(bglu + col0), bv1 = *(const GAS f32x4*)(bglu + col0 + 4), bg0 = *(const GAS f32x4*)(bglu + D + col0), bg1 = *(const GAS f32x4*)(bglu + D + col0 + 4);
#pragma unroll
        for (int ai = 0; ai < 2; ++ai)
#pragma unroll
            for (int m = 0; m < 4; ++m) { GAS float* p = h + (size_t)(row0 + ai * 128 + m * 16) * D + col0;
                f32x4 h0 = *(const GAS f32x4*)p, h1 = *(const GAS f32x4*)(p + 4);
#pragma unroll
                for (int j = 0; j < 4; ++j) { h0[j] += (acc[ai][0][m][0][j] + bv0[j]) * fsigmoid(acc[ai][1][m][0][j] + bg0[j]); h1[j] += (acc[ai][0][m][1][j] + bv1[j]) * fsigmoid(acc[ai][1][m][1][j] + bg1[j]); }
                *(GAS f32x4*)p = h0; *(GAS f32x4*)(p + 4) = h1; }
    }
};
struct EpiS5E {
    GAS float* eb;
    __device__ __forceinline__ void operator()(EPI_ARGS) const {
        const int row0 = u.pm * 256 + wr * 64 + fr, col0 = wc * 32 + 8 * fq;
#pragma unroll
        for (int ai = 0; ai < 2; ++ai)
#pragma unroll
            for (int m = 0; m < 4; ++m) { GAS float* p = eb + ((size_t)u.kind * NBC + row0 + ai * 128 + m * 16) * 128 + col0;
                *(GAS f32x4*)p = acc[ai][0][m][0]; *(GAS f32x4*)(p + 4) = acc[ai][0][m][1]; }
    }
};
struct EpiS5Y {
    GAS bf16_t* yact; const GAS bf16_t* ug; const GAS float* dskip;
    __device__ __forceinline__ void operator()(EPI_ARGS) const {
        const int g = u.kind; const int row0 = u.pm * 256 + wr * 64 + fr, col0 = u.pn * 256 + wc * 32 + 8 * fq;
#pragma unroll
        for (int bj = 0; bj < 2; ++bj) { const int n = col0 + bj * 128, tl = n >> 4, ch = n & 15;
            const f32x4 d0 = *(const GAS f32x4*)(dskip + 16 * g + ch), d1 = *(const GAS f32x4*)(dskip + 16 * g + ch + 4);
#pragma unroll
            for (int ai = 0; ai < 2; ++ai)
#pragma unroll
                for (int m = 0; m < 4; ++m) { const int bc = row0 + ai * 128 + m * 16;
                    f32x4 x0, x1; unpack8(*(const GAS u32x4*)(ug + ((size_t)g * NBC + bc) * S5K + n), x0, x1);
                    f32x4 y0 = acc[ai][bj][m][0] + d0 * x0, y1 = acc[ai][bj][m][1] + d1 * x1;
#pragma unroll
                    for (int j = 0; j < 4; ++j) { y0[j] = fgelu(y0[j]); y1[j] = fgelu(y1[j]); }
                    *(GAS u32x4*)(yact + ((size_t)bc * S5L + tl) * D + 16 * g + ch) = pack8(y0, y1); } }
    }
};
struct SchedMoeG {
    const GAS char* A; const GAS char* W; size_t eW, tB; int nN, G, c; volatile LAS unsigned* tpre; const GAS int* rowtok;
    __device__ __forceinline__ bool next(int i, GUnit& u) const {
        const int MT = (int)tpre[8]; const int L = i * G + c; if (L >= MT * nN) return false;
        int pm, pn; tile_order(L, MT, nN, pm, pn);
        int e = 0;
#pragma unroll
        for (int q = 1; q < 8; ++q) e += ((int)tpre[q] <= pm) ? 1 : 0;
        e = __builtin_amdgcn_readfirstlane(e);
        u.A = A; u.B = W + (size_t)e * eW + (size_t)pn * tB; u.pm = pm; u.pn = pn; u.kind = e; u.pad = 0; return true;
    }
    __device__ __forceinline__ void load_offs(int pm, int tid, unsigned (&vo)[2][2]) const {
#pragma unroll
        for (int i = 0; i < 2; ++i) { int R, C; stage_rc(tid * 16 + i * 8192, R, C);
#pragma unroll
            for (int h = 0; h < 2; ++h) { const int tok = rowtok[pm * 256 + 128 * h + R]; vo[h][i] = (unsigned)(tok * D + C) * 2u; } }
    }
};
template <> struct sched_gather<SchedMoeG> { static constexpr bool value = true; };
struct SchedMoeMain {
    const GAS char* A; const GAS char* W; size_t tA, eW, tB; int nN, G, c; volatile LAS unsigned* tpre;
    __device__ __forceinline__ bool next(int i, GUnit& u) const {
        int MT = (int)tpre[8]; MT = MT < MOE_MAIN_TILES ? MT : MOE_MAIN_TILES; const int L = i * G + c; if (L >= MT * nN) return false;
        int pm, pn; tile_order(L, MT, nN, pm, pn);
        int e = 0;
#pragma unroll
        for (int q = 1; q < 8; ++q) e += ((int)tpre[q] <= pm) ? 1 : 0;
        e = __builtin_amdgcn_readfirstlane(e);
        u.A = A + (size_t)pm * tA; u.B = W + (size_t)e * eW + (size_t)pn * tB; u.pm = pm; u.pn = pn; u.kind = e; u.pad = 0; return true;
    }
};
struct SchedMoeTail {
    const GAS char* A; const GAS char* W; size_t tA, eW, tB, kq_bytes; int G, c; volatile LAS unsigned* tpre;
    __device__ __forceinline__ bool next(int i, GUnit& u) const {
        const int MT = (int)tpre[8]; const int ntail = MT - MOE_MAIN_TILES; const int L = i * G + c; if (ntail <= 0 || L >= ntail * 16) return false;
        const int pm = MOE_MAIN_TILES + (L >> 4), pn = (L >> 2) & 3, kq = L & 3;
        int e = 0;
#pragma unroll
        for (int q = 1; q < 8; ++q) e += ((int)tpre[q] <= pm) ? 1 : 0;
        e = __builtin_amdgcn_readfirstlane(e);
        u.A = A + (size_t)pm * tA + (size_t)kq * kq_bytes; u.B = W + (size_t)e * eW + (size_t)pn * tB + (size_t)kq * kq_bytes; u.pm = pm; u.pn = pn; u.kind = e; u.pad = kq; return true;
    }
};
struct EpiMoeDown {
    GAS bf16_t* y2; const GAS int* rowslot; const GAS float* rowgate; GAS bf16_t* y2t;
    __device__ __forceinline__ void operator()(EPI_ARGS) const {
        const int row0 = u.pm * 256 + wr * 64 + fr, col0 = u.pn * 256 + wc * 32 + 8 * fq; const int kq = u.pad;
#pragma unroll
        for (int ai = 0; ai < 2; ++ai)
#pragma unroll
            for (int m = 0; m < 4; ++m) { const int row = row0 + ai * 128 + m * 16; const int slot = rowslot[row]; const float gt = rowgate[row];
                if (slot >= 0) { GAS bf16_t* dst = (kq == 0) ? y2 + (size_t)slot * D : y2t + ((size_t)(kq - 1) * 2048 + (row - MOE_TAIL_ROW0)) * D;
#pragma unroll
                    for (int bj = 0; bj < 2; ++bj) *(GAS u32x4*)(dst + col0 + bj * 128) = pack8(acc[ai][bj][m][0] * gt, acc[ai][bj][m][1] * gt); } }
    }
};

struct CvtTask { const GAS float* W; int Ks, Ns, lds_, Kp, Np; GAS bf16_t* dst; int ldt, mode, row_off; };
__device__ __forceinline__ void cvt_item(const CvtTask& t, LAS float* scr, int item, int lane) {
    const int nblk = t.Np / 64, kb = item / nblk, nb = item % nblk, k0 = 32 * kb, n0 = 64 * nb;
    const int r = lane >> 4, c4 = lane & 15;
    f32x4 v[8];
#pragma unroll
    for (int i = 0; i < 8; ++i) { const int k = k0 + 4 * i + r, n = n0 + 4 * c4;
        v[i] = (f32x4){0.f, 0.f, 0.f, 0.f}; if (k < t.Ks && n < t.Ns) v[i] = *(const GAS f32x4*)(t.W + (size_t)k * t.lds_ + n); }
#pragma unroll
    for (int i = 0; i < 8; ++i) { LAS float* d = scr + (4 * i + r) * 65 + 4 * c4; d[0] = v[i][0]; d[1] = v[i][1]; d[2] = v[i][2]; d[3] = v[i][3]; }
    asm volatile("s_waitcnt lgkmcnt(0)" ::: "memory");
    const int c = lane & 3;
#pragma unroll
    for (int j = 0; j < 4; ++j) { const int nn = (lane >> 2) + 16 * j; const LAS float* s_ = scr + (8 * c) * 65 + nn;
        u32x4 o; o.x = cvt_pk_bf16(s_[0 * 65], s_[1 * 65]); o.y = cvt_pk_bf16(s_[2 * 65], s_[3 * 65]); o.z = cvt_pk_bf16(s_[4 * 65], s_[5 * 65]); o.w = cvt_pk_bf16(s_[6 * 65], s_[7 * 65]);
        const int n = n0 + nn; const int drow = (t.mode == 1) ? (256 * (n >> 7) + (n & 127) + t.row_off) : (n + t.row_off);
        *(GAS u32x4*)(t.dst + (size_t)drow * t.ldt + k0 + 8 * c) = o; }
    asm volatile("s_waitcnt lgkmcnt(0)" ::: "memory");
}
__device__ __forceinline__ void cvt_run(const CvtTask& t, LAS float* scr, int gw, int ngw, int& rot, int lane) {
    const int nitems = (t.Kp / 32) * (t.Np / 64);
    int first = gw - rot; if (first < 0) first += ngw;
    for (int it = first; it < nitems; it += ngw) cvt_item(t, scr, it, lane);
    rot = (rot + nitems) % ngw;
}

struct Args { const float* in[40]; float* out; unsigned char* ws; int ph_lo, ph_hi; };

__global__ void __launch_bounds__(NTHREADS, 2) mk_fwd(Args args) {
    extern __shared__ __attribute__((aligned(16))) unsigned char lds_raw[];
    LAS unsigned char* lds = (LAS unsigned char*)lds_raw;
    volatile LAS unsigned* MISC = (volatile LAS unsigned*)(lds + MISC_OFF);
    const int tid0 = threadIdx.x;
    const int G0 = gridDim.x, bx0 = blockIdx.x;
    GAS unsigned char* ws = (GAS unsigned char*)args.ws;
    for (int u = tid0; u < (LDS_BYTES - LDSCTL_OFF) / 4; u += NTHREADS) ((LAS unsigned*)(lds + LDSCTL_OFF))[u] = 0u;
    __syncthreads();
    LAS unsigned long long* PTAB = (LAS unsigned long long*)(lds + PTAB_OFF);
    if (tid0 < 40) PTAB[tid0] = (unsigned long long)args.in[tid0];
    __syncthreads();
#define INP(i) inp_ptr(PTAB, (i))
#define Y2T_ADD(v_, tok_, q_) do { _Pragma("unroll") for (int k2_ = 0; k2_ < 2; ++k2_) { const int tr_ = __builtin_amdgcn_readfirstlane(((const GAS int*)(wsl + WS_TROW))[2 * (tok_) + k2_]); \
        if (tr_ >= 0) { _Pragma("unroll") for (int kq_ = 0; kq_ < 3; ++kq_) { const u32x2 yt_ = *(const GAS u32x2*)((const GAS bf16_t*)(wsl + WS_Y2T) + ((size_t)kq_ * 2048 + tr_) * D + 4 * lane + 256 * (q_)); \
            v_[0] += bf_lo(yt_.x); v_[1] += bf_hi(yt_.x); v_[2] += bf_lo(yt_.y); v_[3] += bf_hi(yt_.y); } } } } while (0)
#define PHASE_BASE() GAS unsigned char* wsl = ws; int G = G0, bx = bx0, tid = tid0; asm volatile("" : "+s"(wsl), "+s"(G), "+s"(bx), "+v"(tid)); \
    const int lane = tid & 63, wave = __builtin_amdgcn_readfirstlane(tid >> 6); GAS unsigned* ctl = (GAS unsigned*)(wsl + WS_CTL); (void)ctl; (void)lane; \
    const int vcu = (G % 8 == 0) ? (bx % 8) * (G / 8) + bx / 8 : bx; const int gw = bx * NWAVES + wave, NGW = G * NWAVES; GAS unsigned char* ar = wsl + WS_AR; (void)ar; (void)vcu; (void)gw; (void)NGW
    XcdBarrier bar = xcd_barrier_post((unsigned*)args.ws + WS_CTL / 4 + CW_BAR, MISC + 8);
    const int lo = args.ph_lo, hi = args.ph_hi;
#define IN(k) ((lo <= (k) && (k) < hi) || ((k) == NPH - 1 && MK_N_LAUNCHES == 1))
#define SEAM(k) do { if (IN(k) && IN((k) + 1)) xcd_barrier(bar); } while (0)

    GAS float* hbuf1 = (GAS float*)args.out;
#define hbuf0 ((GAS float*)(wsl + WS_H0))
#define vfirst ((GAS bf16_t*)(wsl + WS_VF))
#define y2 ((GAS bf16_t*)(wsl + WS_Y2))

    for (int rep_ = 0; rep_ <= ((MK_REPEAT >> 18) & 1); ++rep_) if (IN(0)) {
        PHASE_BASE();
        LAS float* scr = (LAS float*)(lds + wave * 16384);
        int rot = 0;
        for (int j = 0; j < 2; ++j) {
            GAS unsigned char* wr_ = wsl + WS_WR + (size_t)j * WR_STRIDE;
            for (int s = 0; s < 3; ++s) { CvtTask t{INP(5) + ((size_t)j * 3 + s) * D * D, D, D, D, D, D, (GAS bf16_t*)(wr_ + WR_RKV) + (size_t)s * D * D, D, 0, 0}; cvt_run(t, scr, gw, NGW, rot, lane); }
            { CvtTask t{INP(7) + (size_t)j * D * 64, D, 64, 64, D, 256, (GAS bf16_t*)(wr_ + WR_L1), D, 0, 0}; cvt_run(t, scr, gw, NGW, rot, lane); }
            { CvtTask t{INP(10) + (size_t)j * D * 64, D, 64, 64, D, 256, (GAS bf16_t*)(wr_ + WR_L1) + (size_t)256 * D, D, 0, 0}; cvt_run(t, scr, gw, NGW, rot, lane); }
            { CvtTask t{INP(12) + (size_t)j * D * 160, D, 160, 160, D, 256, (GAS bf16_t*)(wr_ + WR_L1) + (size_t)2 * 256 * D, D, 0, 0}; cvt_run(t, scr, gw, NGW, rot, lane); }
            if (j == 1) { CvtTask t{INP(21), D, 32, 32, D, 256, (GAS bf16_t*)(wr_ + WR_L1) + (size_t)3 * 256 * D, D, 0, 0}; cvt_run(t, scr, gw, NGW, rot, lane); }
            { CvtTask t{INP(8) + (size_t)j * 64 * D, 64, D, D, 256, D, (GAS bf16_t*)(wr_ + WR_L2), 256, 0, 0}; cvt_run(t, scr, gw, NGW, rot, lane); }
            { CvtTask t{INP(11) + (size_t)j * 64 * D, 64, D, D, 256, D, (GAS bf16_t*)(wr_ + WR_L2) + (size_t)D * 256, 256, 0, 0}; cvt_run(t, scr, gw, NGW, rot, lane); }
            { CvtTask t{INP(13) + (size_t)j * 160 * D, 160, D, D, 256, D, (GAS bf16_t*)(wr_ + WR_L2) + (size_t)2 * D * 256, 256, 0, 0}; cvt_run(t, scr, gw, NGW, rot, lane); }
            if (j == 1) { CvtTask t{INP(22), 32, D, D, 256, D, (GAS bf16_t*)(wr_ + WR_L2) + (size_t)3 * D * 256, 256, 0, 0}; cvt_run(t, scr, gw, NGW, rot, lane); }
            { CvtTask t{INP(19) + (size_t)j * D * D, D, D, D, D, D, (GAS bf16_t*)(wr_ + WR_WO), D, 0, 0}; cvt_run(t, scr, gw, NGW, rot, lane); }
            { CvtTask t{INP(33) + (size_t)j * D * FF, D, FF, FF, D, FF, (GAS bf16_t*)(wr_ + WR_GU), D, 1, 0}; cvt_run(t, scr, gw, NGW, rot, lane); }
            { CvtTask t{INP(34) + (size_t)j * D * FF, D, FF, FF, D, FF, (GAS bf16_t*)(wr_ + WR_GU), D, 1, 128}; cvt_run(t, scr, gw, NGW, rot, lane); }
            { CvtTask t{INP(35) + (size_t)j * FF * D, FF, D, D, FF, D, (GAS bf16_t*)(wr_ + WR_WD), FF, 0, 0}; cvt_run(t, scr, gw, NGW, rot, lane); }
            GAS unsigned char* wss = wsl + WS_WS + (size_t)j * WSS_STRIDE;
            { CvtTask t{INP(31) + (size_t)j * D * 2 * D, D, D, 2 * D, D, D, (GAS bf16_t*)(wss + WSS_GLU), D, 1, 0}; cvt_run(t, scr, gw, NGW, rot, lane); }
            { CvtTask t{INP(31) + (size_t)j * D * 2 * D + D, D, D, 2 * D, D, D, (GAS bf16_t*)(wss + WSS_GLU), D, 1, 128}; cvt_run(t, scr, gw, NGW, rot, lane); }
        }
        for (int e = 0; e < NEXP; ++e) {
            { CvtTask t{INP(37) + (size_t)e * D * FE, D, FE, FE, D, FE, (GAS bf16_t*)(wsl + WS_WM + WM_GU) + (size_t)e * 2 * FE * D, D, 1, 0}; cvt_run(t, scr, gw, NGW, rot, lane); }
            { CvtTask t{INP(38) + (size_t)e * D * FE, D, FE, FE, D, FE, (GAS bf16_t*)(wsl + WS_WM + WM_GU) + (size_t)e * 2 * FE * D, D, 1, 128}; cvt_run(t, scr, gw, NGW, rot, lane); }
            { CvtTask t{INP(39) + (size_t)e * FE * D, FE, D, D, FE, D, (GAS bf16_t*)(wsl + WS_WM + WM_WD) + (size_t)e * D * FE, FE, 0, 0}; cvt_run(t, scr, gw, NGW, rot, lane); }
        }
        __syncthreads();
        for (int item = bx; item < 128; item += G) {
            const int jl = item >> 6, g = item & 63;
            LAS float* pw_re = (LAS float*)lds;
            LAS float* pw_im = pw_re + 33 * 64;
            LAS float* bb_re = pw_im + 33 * 64;
            LAS float* bb_im = bb_re + 1024;
            LAS float* cc_re = bb_im + 1024;
            LAS float* cc_im = cc_re + 1024;
            LAS float* kt = cc_im + 1024;
            LAS float* sdr = kt + 8192;
            LAS float* sdi = sdr + 64;
            const GAS float* lam_re = INP(23) + ((size_t)jl * 64 + g) * 64; const GAS float* lam_im = INP(24) + ((size_t)jl * 64 + g) * 64;
            const float dt = __expf(INP(25)[jl * 64 + g]);
            if (tid < 64) { const int p = tid;
                const float lr = fminf(lam_re[p], -1e-4f), li = lam_im[p]; const float dr = lr * dt, di = li * dt;
                sdr[p] = dr; sdi[p] = di;
                const float ed = expf(dr), cd = cosf(di), sd = sinf(di), sh = sinf(0.5f * di);
                const float abar_im = ed * sd; const float num_re = expm1f(dr) * cd - 2.0f * sh * sh; const float den = lr * lr + li * li;
                const float cre = (num_re * lr + abar_im * li) / den, cim = (abar_im * lr - num_re * li) / den;
                const GAS float* bre = INP(26) + (((size_t)jl * 64 + g) * 64 + p) * 16; const GAS float* bim = INP(27) + (((size_t)jl * 64 + g) * 64 + p) * 16;
#pragma unroll
                for (int c = 0; c < 16; ++c) { const float br = bre[c], bi = bim[c]; bb_re[p * 16 + c] = cre * br - cim * bi; bb_im[p * 16 + c] = cre * bi + cim * br; }
            }
            for (int i = tid; i < 1024; i += NTHREADS) { cc_re[i] = INP(28)[((size_t)jl * 64 + g) * 1024 + i]; cc_im[i] = INP(29)[((size_t)jl * 64 + g) * 1024 + i]; }
            __syncthreads();
            for (int i = tid; i < 33 * 64; i += NTHREADS) { const int tau = i >> 6, p = i & 63;
                const float mag = expf((float)tau * sdr[p]); float rev = (float)tau * sdi[p] * 0.15915494309189535f; rev -= floorf(rev);
                const float ang = (rev > 0.5f ? rev - 1.0f : rev) * 6.283185307179586f;
                pw_re[i] = mag * cosf(ang); pw_im[i] = mag * sinf(ang); }
            __syncthreads();
            for (int i = tid; i < 8192; i += NTHREADS) { const int tau = i >> 8, co = (i >> 4) & 15, ci = i & 15; float s = 0.f;
                for (int p = 0; p < 64; ++p) { const float cr = cc_re[co * 64 + p], cm = cc_im[co * 64 + p], pr = pw_re[tau * 64 + p], pi = pw_im[tau * 64 + p];
                    const float abr = cr * pr - cm * pi, abi = cr * pi + cm * pr; s += abr * bb_re[p * 16 + ci] - abi * bb_im[p * 16 + ci]; }
                kt[i] = s; }
            __syncthreads();
            GAS bf16_t* toep = (GAS bf16_t*)(wsl + WS_WS + (size_t)jl * WSS_STRIDE + WSS_TOEP) + (size_t)g * 512 * S5K;
            for (int id = tid; id < 512 * 80; id += NTHREADS) { const int n = id / 80, kc = id % 80, k0 = kc * 8, tlo = n >> 4, co = n & 15;
                float v[8];
                if (k0 < 512) { const int tli = k0 >> 4, ci0 = k0 & 15;
#pragma unroll
                    for (int q = 0; q < 8; ++q) v[q] = (tlo >= tli) ? kt[((tlo - tli) * 16 + co) * 16 + ci0 + q] : 0.f; }
                else { const int p0 = k0 - 512; const bool im = p0 >= 64; const int pb = im ? p0 - 64 : p0; const int tau = tlo + 1;
#pragma unroll
                    for (int q = 0; q < 8; ++q) { const int p = pb + q; const float cr = cc_re[co * 64 + p], cm = cc_im[co * 64 + p], pr = pw_re[tau * 64 + p], pi = pw_im[tau * 64 + p];
                        v[q] = im ? -(cr * pi + cm * pr) : (cr * pr - cm * pi); } }
                u32x4 o; o.x = cvt_pk_bf16(v[0], v[1]); o.y = cvt_pk_bf16(v[2], v[3]); o.z = cvt_pk_bf16(v[4], v[5]); o.w = cvt_pk_bf16(v[6], v[7]);
                *(GAS u32x4*)(toep + (size_t)n * S5K + k0) = o; }
            GAS bf16_t* m1 = (GAS bf16_t*)(wsl + WS_WS + (size_t)jl * WSS_STRIDE + WSS_M1) + (size_t)g * 256 * 512;
            for (int id = tid; id < 256 * 64; id += NTHREADS) { const int n = id >> 6, kc = id & 63, k0 = kc * 8, tli = k0 >> 4, ci0 = k0 & 15;
                float v[8];
                if (n < 128) { const bool im = n >= 64; const int p = im ? n - 64 : n; const int tau = 31 - tli; const float pr = pw_re[tau * 64 + p], pi = pw_im[tau * 64 + p];
#pragma unroll
                    for (int q = 0; q < 8; ++q) { const float br = bb_re[p * 16 + ci0 + q], bi = bb_im[p * 16 + ci0 + q]; v[q] = im ? (pr * bi + pi * br) : (pr * br - pi * bi); } }
                else {
#pragma unroll
                    for (int q = 0; q < 8; ++q) v[q] = 0.f; }
                u32x4 o; o.x = cvt_pk_bf16(v[0], v[1]); o.y = cvt_pk_bf16(v[2], v[3]); o.z = cvt_pk_bf16(v[4], v[5]); o.w = cvt_pk_bf16(v[6], v[7]);
                *(GAS u32x4*)(m1 + (size_t)n * 512 + k0) = o; }
            __syncthreads();
        }
    }
    SEAM(0);

    for (int j = 0; j < 2; ++j) {
        const int pb = 1 + 19 * j;
#define wr_ (wsl + WS_WR + (size_t)j * WR_STRIDE)
#define wss (wsl + WS_WS + (size_t)j * WSS_STRIDE)
#define hin_l ((j == 0) ? INP(0) : (const GAS float*)hbuf0)
#define hcur ((j == 0) ? hbuf0 : hbuf1)
#define xs ((GAS bf16_t*)(ar + AR_XS))
#define rbuf ((GAS bf16_t*)(ar + AR_R))
#define kbuf ((GAS bf16_t*)(ar + AR_K))
#define vbuf ((j == 0) ? vfirst : (GAS bf16_t*)(ar + AR_V))
#define l1 ((GAS bf16_t*)(ar + AR_L1))
#define lwbuf ((GAS bf16_t*)(ar + AR_LW))
#define abuf ((GAS bf16_t*)(ar + AR_A))
#define gbuf ((GAS bf16_t*)(ar + AR_G))
#define yraw ((GAS float*)(ar + AR_YRAW))
#define yg ((GAS bf16_t*)(ar + AR_YG))
#define hn2 ((GAS bf16_t*)(ar + AR_HN2))
#define hmid ((GAS bf16_t*)(ar + AR_HMID))
#define ug ((GAS bf16_t*)(ar + AR_UG))
#define eb ((GAS float*)(ar + AR_EB))
#define yact ((GAS bf16_t*)(ar + AR_YACT))
#define asg_pe ((GAS unsigned*)(ar + AR_ASG))
#define asg_gate ((GAS float*)(ar + AR_ASG + 256 * 1024))
#define xsm ((GAS bf16_t*)(ar + AR_XSM))
#define rowslot ((GAS int*)(ar + AR_ROWM))
#define rowgate ((GAS float*)(ar + AR_ROWM + 512 * 1024))
#define rowtok ((GAS int*)(ar + AR_ROWM + 256 * 1024))
#define hmidm ((GAS bf16_t*)(ar + AR_HMIDM))
#define blkcnt ((GAS unsigned*)(ar + AR_ASG + 512 * 1024))

        for (int rep_ = 0; rep_ <= ((MK_REPEAT >> 0) & 1); ++rep_) if (IN(pb + 0)) {
            PHASE_BASE();
            LAS float* smu = (LAS float*)lds;
            LAS float* sg = smu + 6 * 1024;
            for (int i = tid; i < 6 * 1024; i += NTHREADS) smu[i] = INP(4)[(size_t)j * 6 * 1024 + i];
            for (int i = tid; i < 1024; i += NTHREADS) sg[i] = INP(1)[(size_t)(2 * j) * 1024 + i];
            __syncthreads();
            const bool comb = (j == 1);
            for (int blk = bx; blk < M / 64; blk += G) {
                const int t0 = blk * 64 + wave * 8;
                f32x4 prev[4], cur[4];
#pragma unroll
                for (int tt = -1; tt < 8; ++tt) {
                    const int tok = t0 + tt;
                    if (tt == -1 && (t0 % T) == 0) {
#pragma unroll
                        for (int q = 0; q < 4; ++q) prev[q] = (f32x4){0.f, 0.f, 0.f, 0.f};
                        continue; }
                    float ss = 0.f;
#pragma unroll
                    for (int q = 0; q < 4; ++q) { f32x4 v = *(const GAS f32x4*)(hin_l + (size_t)tok * D + 4 * lane + 256 * q);
                        if (comb) { const u32x2 ya = *(const GAS u32x2*)(y2 + (size_t)(2 * tok) * D + 4 * lane + 256 * q), yb = *(const GAS u32x2*)(y2 + (size_t)(2 * tok + 1) * D + 4 * lane + 256 * q);
                            v[0] += bf_lo(ya.x) + bf_lo(yb.x); v[1] += bf_hi(ya.x) + bf_hi(yb.x); v[2] += bf_lo(ya.y) + bf_lo(yb.y); v[3] += bf_hi(ya.y) + bf_hi(yb.y);
                            Y2T_ADD(v, tok, q);
                            if (tt >= 0) *(GAS f32x4*)(hcur + (size_t)tok * D + 4 * lane + 256 * q) = v; }
                        cur[q] = v; ss += v[0] * v[0] + v[1] * v[1] + v[2] * v[2] + v[3] * v[3]; }
                    const float rs = rsqrtf(wave_sum(ss) * (1.0f / D) + NORM_EPS);
#pragma unroll
                    for (int q = 0; q < 4; ++q) cur[q] = cur[q] * rs * *(const LAS f32x4*)(sg + 4 * lane + 256 * q);
                    if (tt >= 0) {
#pragma unroll
                        for (int s = 0; s < 6; ++s)
#pragma unroll
                            for (int q = 0; q < 4; ++q) { const f32x4 mu = *(const LAS f32x4*)(smu + s * 1024 + 4 * lane + 256 * q); const f32x4 o = cur[q] + (prev[q] - cur[q]) * mu;
                                u32x2 w; w.x = cvt_pk_bf16(o[0], o[1]); w.y = cvt_pk_bf16(o[2], o[3]);
                                *(GAS u32x2*)(xs + (size_t)s * M * D + (size_t)tok * D + 4 * lane + 256 * q) = w; } }
#pragma unroll
                    for (int q = 0; q < 4; ++q) prev[q] = cur[q];
                }
            }
            if (j == 1) {
                __syncthreads();
                LAS float* scr = (LAS float*)(lds + 32768 + wave * 8704);
                int rot = 0;
                for (int e = 0; e < NEXP; ++e) {
                    { CvtTask t{INP(37) + ((size_t)NEXP + e) * D * FE, D, FE, FE, D, FE, (GAS bf16_t*)(wsl + WS_WM + WM_GU) + (size_t)e * 2 * FE * D, D, 1, 0}; cvt_run(t, scr, gw, NGW, rot, lane); }
                    { CvtTask t{INP(38) + ((size_t)NEXP + e) * D * FE, D, FE, FE, D, FE, (GAS bf16_t*)(wsl + WS_WM + WM_GU) + (size_t)e * 2 * FE * D, D, 1, 128}; cvt_run(t, scr, gw, NGW, rot, lane); }
                    { CvtTask t{INP(39) + ((size_t)NEXP + e) * FE * D, FE, D, D, FE, D, (GAS bf16_t*)(wsl + WS_WM + WM_WD) + (size_t)e * D * FE, FE, 0, 0}; cvt_run(t, scr, gw, NGW, rot, lane); }
                }
            }
            __syncthreads();
        }
        SEAM(pb + 0);

        for (int rep_ = 0; rep_ <= ((MK_REPEAT >> 1) & 1); ++rep_) if (IN(pb + 1)) {
            PHASE_BASE();
            SchedR2 S{uni_ptr((const GAS char*)xs), uni_ptr((const GAS char*)(wr_ + WR_RKV)), uni_ptr((const GAS char*)(wr_ + WR_L1)), (j == 0) ? 15 : 16, G, bx};
            EpiR2 E{rbuf, vbuf, l1};
            gemm_phase(lds, tid, D, D, D, S, E);
        }
        SEAM(pb + 1);

        for (int rep_ = 0; rep_ <= ((MK_REPEAT >> 2) & 1); ++rep_) if (IN(pb + 2)) {
            PHASE_BASE();
            SchedR3 S{uni_ptr((const GAS char*)l1), uni_ptr((const GAS char*)(wr_ + WR_L2)), (j == 0) ? 12 : 16, G, bx};
            EpiR3 E{wsl, PTAB, j};
            gemm_phase(lds, tid, 256, 256, 256, S, E);
        }
        SEAM(pb + 2);

#if MK_CHUNKED
#define cqb ((GAS bf16_t*)(wsl + WS_Y2))
#define cnb ((GAS bf16_t*)(wsl + WS_Y2 + 32 * MiB))
#define czb ((GAS bf16_t*)(ar + 96 * MiB))
#define cyl ((GAS bf16_t*)(ar + 128 * MiB))
#define csb ((GAS bf16_t*)(ar + 288 * MiB))
#define cbon ((GAS float*)(ar + 320 * MiB))
        for (int rep_ = 0; rep_ <= ((MK_REPEAT >> 3) & 1); ++rep_) if (IN(pb + 3)) {
            PHASE_BASE();
            constexpr int LD = 72;
            LAS bf16_t* T_ABAR = (LAS bf16_t*)(lds + 0); LAS bf16_t* T_RBAR = (LAS bf16_t*)(lds + 9216); LAS bf16_t* T_BT = (LAS bf16_t*)(lds + 18432); LAS bf16_t* T_KT = (LAS bf16_t*)(lds + 27648);
            LAS bf16_t* T_BTT = (LAS bf16_t*)(lds + 36864); LAS bf16_t* T_KTT = (LAS bf16_t*)(lds + 46080); LAS bf16_t* T_VT = (LAS bf16_t*)(lds + 55296);
            LAS bf16_t* T_AAB = (LAS bf16_t*)(lds + 64512);
            LAS float* F_DIAG = (LAS float*)(lds + 73728);
            LAS float* F_G = (LAS float*)(lds + 64512);
            LAS bf16_t* T_AAK = (LAS bf16_t*)(lds + 81920); LAS bf16_t* T_ABR = (LAS bf16_t*)(lds + 91136); LAS bf16_t* T_AKR = (LAS bf16_t*)(lds + 100352);
            LAS float* F_W = (LAS float*)(lds + 109568);
            LAS bf16_t* T_V = (LAS bf16_t*)(lds + 109568);
            LAS float* F_SEG = (LAS float*)(lds + 125952);
            LAS float* F_TI = (LAS float*)(lds + 125952);
            LAS float* F_PL = (LAS float*)(lds + 130816);
            LAS bf16_t* T_MTT = T_BT; LAS bf16_t* T_X1T = T_KT;
            const int r = lane & 15, q = lane >> 4;
            const GAS float* k_k = INP(14) + (size_t)j * D; const GAS float* k_a = INP(15) + (size_t)j * D; const GAS float* r_k = INP(16) + (size_t)j * D;
#define TILE_MMA(acc_, At_, arow_, Bt_, brow_) do { _Pragma("unroll") for (int ks_ = 0; ks_ < 2; ++ks_) { \
                const bf16x8 a_ = *(const LAS bf16x8*)((At_) + ((arow_) + r) * LD + 32 * ks_ + 8 * q), b_ = *(const LAS bf16x8*)((Bt_) + ((brow_) + r) * LD + 32 * ks_ + 8 * q); \
                acc_ = __builtin_amdgcn_mfma_f32_16x16x32_bf16(a_, b_, acc_, 0, 0, 0); } } while (0)
            u32x4 pf_r, pf_k, pf_v, pf_l, pf_a;
#define W1_LOAD(it_) do { const int hd_ = (it_) >> 5, c_ = (it_) & 31; const size_t go_ = ((size_t)(hd_ >> 4) * T + c_ * 64 + (tid >> 3)) * D + (hd_ & 15) * 64 + 8 * (tid & 7); \
                pf_r = *(const GAS u32x4*)(rbuf + go_); pf_k = *(const GAS u32x4*)(kbuf + go_); pf_v = *(const GAS u32x4*)(vbuf + go_); pf_l = *(const GAS u32x4*)(lwbuf + go_); pf_a = *(const GAS u32x4*)(abuf + go_); } while (0)
            LAS unsigned char* RAW_RKV = lds + 64512;
            LAS unsigned char* RAW_LA = lds + 109568;
            for (int it = bx; it < 4096; it += G) {
                if (it == bx) W1_LOAD(it);
                else { asm volatile("s_waitcnt vmcnt(0)" ::: "memory");
                    const int lo_ = tid * 16; pf_r = *(const LAS u32x4*)(RAW_RKV + lo_); pf_k = *(const LAS u32x4*)(RAW_RKV + 8192 + lo_); pf_v = *(const LAS u32x4*)(RAW_RKV + 16384 + lo_);
                    pf_l = *(const LAS u32x4*)(RAW_LA + lo_); pf_a = *(const LAS u32x4*)(RAW_LA + 8192 + lo_);
                    asm volatile("s_waitcnt lgkmcnt(0)" ::: "memory"); __syncthreads(); }
                const int hd = it >> 5, c = it & 31, b = hd >> 4, h = hd & 15;
                const size_t tok0 = (size_t)b * T + c * 64;
                const int t = tid >> 3, c8 = tid & 7;
                f32x4 al0, al1, be0, be1, km0, km1, r0, r1, lq0, lq1;
                {
                    f32x4 k0, k1, v0, v1, a0, a1;
                    unpack8(pf_r, r0, r1); unpack8(pf_k, k0, k1); unpack8(pf_v, v0, v1); unpack8(pf_l, lq0, lq1); unpack8(pf_a, a0, a1);
                    const int co = h * 64 + 8 * c8;
                    const f32x4 kk0w = *(const GAS f32x4*)(k_k + co), kk1w = *(const GAS f32x4*)(k_k + co + 4), ka0 = *(const GAS f32x4*)(k_a + co), ka1 = *(const GAS f32x4*)(k_a + co + 4);
                    const f32x4 rk0 = *(const GAS f32x4*)(r_k + co), rk1 = *(const GAS f32x4*)(r_k + co + 4);
                    f32x4 kk0 = k0 * kk0w, kk1 = k1 * kk1w; float n2 = 0.f, bon = 0.f;
#pragma unroll
                    for (int e = 0; e < 4; ++e) { n2 += kk0[e] * kk0[e] + kk1[e] * kk1[e]; km0[e] = k0[e] * (1.0f + (a0[e] - 1.0f) * ka0[e]); km1[e] = k1[e] * (1.0f + (a1[e] - 1.0f) * ka1[e]);
                        bon += r0[e] * km0[e] * rk0[e] + r1[e] * km1[e] * rk1[e]; }
                    n2 = quad_sum(n2); n2 += dpp_f<0x141>(n2); bon = quad_sum(bon); bon += dpp_f<0x141>(bon);
                    const float inv = 1.0f / fmaxf(sqrtf(n2), 1e-12f); kk0 = kk0 * inv; kk1 = kk1 * inv;
                    al0 = -kk0; al1 = -kk1; be0 = kk0 * a0; be1 = kk1 * a1;
                    if (c8 == 0) cbon[(tok0 + t) * 16 + h] = bon;
                    *(LAS f32x4*)(F_G + t * 64 + 8 * c8) = lq0; *(LAS f32x4*)(F_G + t * 64 + 8 * c8 + 4) = lq1;
                    *(LAS u32x4*)(T_V + t * LD + 8 * c8) = pack8(v0, v1);
                }
                __syncthreads();
                {
                    const int jj = tid & 63, seg = tid >> 6; float pv[8]; float run = 0.f;
#pragma unroll
                    for (int e = 0; e < 8; ++e) { run += F_G[(8 * seg + e) * 64 + jj]; pv[e] = run; }
                    F_SEG[seg * 64 + jj] = run;
                    __syncthreads();
                    float offs = 0.f;
#pragma unroll
                    for (int s_ = 0; s_ < 7; ++s_) offs += (s_ < seg) ? F_SEG[s_ * 64 + jj] : 0.f;
#pragma unroll
                    for (int e = 0; e < 8; ++e) F_G[(8 * seg + e) * 64 + jj] = pv[e] + offs;
                    if (seg == 7) F_PL[jj] = __expf(pv[7] + offs);
                }
                __syncthreads();
                {
                    const f32x4 g0 = *(const LAS f32x4*)(F_G + t * 64 + 8 * c8), g1 = *(const LAS f32x4*)(F_G + t * 64 + 8 * c8 + 4);
                    f32x4 ab0, ab1, rb0, rb1, bt0, bt1, kt0, kt1;
#pragma unroll
                    for (int e = 0; e < 4; ++e) { const float eg0 = __expf(g0[e]), eg1 = __expf(g1[e]), em0 = __expf(g0[e] - lq0[e]), em1 = __expf(g1[e] - lq1[e]), ei0 = __expf(-g0[e]), ei1 = __expf(-g1[e]);
                        ab0[e] = al0[e] * em0; ab1[e] = al1[e] * em1; rb0[e] = r0[e] * eg0; rb1[e] = r1[e] * eg1; bt0[e] = be0[e] * ei0; bt1[e] = be1[e] * ei1; kt0[e] = km0[e] * ei0; kt1[e] = km1[e] * ei1; }
                    *(LAS u32x4*)(T_ABAR + t * LD + 8 * c8) = pack8(ab0, ab1); *(LAS u32x4*)(T_RBAR + t * LD + 8 * c8) = pack8(rb0, rb1);
                    *(LAS u32x4*)(T_BT + t * LD + 8 * c8) = pack8(bt0, bt1); *(LAS u32x4*)(T_KT + t * LD + 8 * c8) = pack8(kt0, kt1);
                }
                __syncthreads();
                {
                    const int jj = tid & 63, seg = tid >> 6;
                    unsigned wb[4], wk_[4], wv_[4];
#pragma unroll
                    for (int e = 0; e < 4; ++e) { const int s0 = 8 * seg + 2 * e;
                        wb[e] = (unsigned)T_BT[s0 * LD + jj] | ((unsigned)T_BT[(s0 + 1) * LD + jj] << 16); wk_[e] = (unsigned)T_KT[s0 * LD + jj] | ((unsigned)T_KT[(s0 + 1) * LD + jj] << 16);
                        wv_[e] = (unsigned)T_V[s0 * LD + jj] | ((unsigned)T_V[(s0 + 1) * LD + jj] << 16); }
                    *(LAS u32x4*)(T_BTT + jj * LD + 8 * seg) = (u32x4){wb[0], wb[1], wb[2], wb[3]}; *(LAS u32x4*)(T_KTT + jj * LD + 8 * seg) = (u32x4){wk_[0], wk_[1], wk_[2], wk_[3]};
                    *(LAS u32x4*)(T_VT + jj * LD + 8 * seg) = (u32x4){wv_[0], wv_[1], wv_[2], wv_[3]};
                }
                __syncthreads();
                {
                    const int pidx = wave >> 1, mh = wave & 1;
                    const LAS bf16_t* At_ = (pidx < 2) ? T_ABAR : T_RBAR; const LAS bf16_t* Bt_ = (pidx & 1) ? T_KT : T_BT;
                    LAS bf16_t* Ot = (pidx == 0) ? T_AAB : ((pidx == 1) ? T_AAK : ((pidx == 2) ? T_ABR : T_AKR));
#pragma unroll
                    for (int mi = 0; mi < 2; ++mi)
#pragma unroll
                        for (int nt = 0; nt < 4; ++nt) { const int mt = 2 * mh + mi; f32x4 acc = (f32x4){0.f, 0.f, 0.f, 0.f};
                            TILE_MMA(acc, At_, 16 * mt, Bt_, 16 * nt);
                            const int s_ = 16 * nt + r;
#pragma unroll
                            for (int e = 0; e < 4; ++e) { const int tt = 16 * mt + 4 * q + e; const bool keep = (pidx < 2) ? (s_ < tt) : (s_ <= tt); const float v_ = keep ? acc[e] : 0.f;
                                Ot[tt * LD + s_] = (bf16_t)(cvt_pk_bf16(v_, 0.f) & 0xffffu);
                                if (pidx == 0 && (mt == nt)) F_DIAG[(mt * 16 + 4 * q + e) * 20 + r] = v_; } }
                }
                __syncthreads();
                {
                    const int mt = wave >> 1;
#pragma unroll
                    for (int nn = 0; nn < 2; ++nn) { const int nt = 2 * (wave & 1) + nn; f32x4 acc = (f32x4){0.f, 0.f, 0.f, 0.f};
                        TILE_MMA(acc, T_AAK, 16 * mt, T_VT, 16 * nt);
#pragma unroll
                        for (int e = 0; e < 4; ++e) F_W[(16 * mt + 4 * q + e) * 64 + 16 * nt + r] = acc[e]; }
                    if (wave == 7) {
                        const int blk = lane >> 4, cc = lane & 15; float x[16];
#pragma unroll
                        for (int tl = 0; tl < 16; ++tl) { float acc = (tl == cc) ? 1.0f : 0.0f;
#pragma unroll
                            for (int s4 = 0; s4 < (tl + 3) / 4; ++s4) { const f32x4 cf = *(const LAS f32x4*)(F_DIAG + (blk * 16 + tl) * 20 + 4 * s4);
#pragma unroll
                                for (int e = 0; e < 4; ++e) if (4 * s4 + e < tl) acc += cf[e] * x[4 * s4 + e]; }
                            x[tl] = acc; F_TI[(blk * 16 + tl) * 16 + cc] = acc; }
                    }
                }
                __syncthreads();
                {
                    const int sub = wave >> 2, ct = wave & 3;
                    LAS bf16_t* OT = (sub == 0) ? T_MTT : T_X1T;
                    { unsigned z_; asm volatile("v_mov_b32 %0, 0" : "=v"(z_)); LAS bf16_t* zr = OT + (16 * ct + r) * LD + 16 * q; *(LAS u32x4*)zr = (u32x4){z_, z_, z_, z_}; *(LAS u32x4*)(zr + 8) = (u32x4){z_, z_, z_, z_}; }
                    asm volatile("s_waitcnt lgkmcnt(0)" ::: "memory");
                    for (int bk = 0; bk < 4; ++bk) {
                        f32x4 d = (f32x4){0.f, 0.f, 0.f, 0.f};
                        if (bk > 0) TILE_MMA(d, T_AAB, 16 * bk, OT, 16 * ct);
#pragma unroll
                        for (int e = 0; e < 4; ++e) { const int tt = 16 * bk + 4 * q + e; d[e] += (sub == 0) ? __uint_as_float((unsigned)T_ABAR[tt * LD + 16 * ct + r] << 16) : F_W[tt * 64 + 16 * ct + r]; }
                        const f32x4 ti4 = *(const LAS f32x4*)(F_TI + (bk * 16 + r) * 16 + 4 * q);
                        f32x4 o = (f32x4){0.f, 0.f, 0.f, 0.f};
#pragma unroll
                        for (int kk = 0; kk < 4; ++kk) o = __builtin_amdgcn_mfma_f32_16x16x4f32(d[kk], ti4[kk], o, 0, 0, 0);
#pragma unroll
                        for (int e = 0; e < 4; ++e) OT[(16 * ct + 4 * q + e) * LD + 16 * bk + r] = (bf16_t)(cvt_pk_bf16(o[e], 0.f) & 0xffffu);
                        asm volatile("s_waitcnt lgkmcnt(0)" ::: "memory");
                    }
                }
                __syncthreads();
                if (it + G < 4096) {
                    const int itn = it + G, hd_ = itn >> 5, c_ = itn & 31; const size_t go_ = ((size_t)(hd_ >> 4) * T + c_ * 64 + (tid >> 3)) * D + (hd_ & 15) * 64 + 8 * (tid & 7);
                    const int wv_ = __builtin_amdgcn_readfirstlane(tid >> 6);
                    __builtin_amdgcn_global_load_lds((const GAS unsigned*)(rbuf + go_), (LAS unsigned*)(RAW_RKV + wv_ * 1024), 16, 0, 0);
                    __builtin_amdgcn_global_load_lds((const GAS unsigned*)(kbuf + go_), (LAS unsigned*)(RAW_RKV + 8192 + wv_ * 1024), 16, 0, 0);
                    __builtin_amdgcn_global_load_lds((const GAS unsigned*)(vbuf + go_), (LAS unsigned*)(RAW_RKV + 16384 + wv_ * 1024), 16, 0, 0);
                    __builtin_amdgcn_global_load_lds((const GAS unsigned*)(lwbuf + go_), (LAS unsigned*)(RAW_LA + wv_ * 1024), 16, 0, 0);
                    __builtin_amdgcn_global_load_lds((const GAS unsigned*)(abuf + go_), (LAS unsigned*)(RAW_LA + 8192 + wv_ * 1024), 16, 0, 0); }
                {
                    const int mt = wave >> 1; const int row4 = 16 * mt + 4 * q;
                    GAS bf16_t* nb_it = cnb + (size_t)it * 4096; GAS bf16_t* qb_it = cqb + (size_t)it * 4096; GAS bf16_t* zb_it = czb + (size_t)it * 4096; GAS bf16_t* yl_it = cyl + (size_t)it * 4096;
#pragma unroll
                    for (int nn = 0; nn < 2; ++nn) { const int nt = 2 * (wave & 1) + nn; const int col = 16 * nt + r;
                        {
                            f32x4 acc = (f32x4){0.f, 0.f, 0.f, 0.f}; TILE_MMA(acc, T_MTT, 16 * mt, T_ABR, 16 * nt);
                            const u32x2 rb = *(const LAS u32x2*)(T_RBAR + col * LD + row4);
                            acc[0] += bf_lo(rb.x); acc[1] += bf_hi(rb.x); acc[2] += bf_lo(rb.y); acc[3] += bf_hi(rb.y);
                            u32x2 o; o.x = cvt_pk_bf16(acc[0], acc[1]); o.y = cvt_pk_bf16(acc[2], acc[3]); *(GAS u32x2*)(nb_it + col * 64 + row4) = o; } __builtin_amdgcn_sched_barrier(0);
                        {
                            f32x4 acc = (f32x4){0.f, 0.f, 0.f, 0.f}; TILE_MMA(acc, T_X1T, 16 * mt, T_ABR, 16 * nt); TILE_MMA(acc, T_VT, 16 * mt, T_AKR, 16 * nt);
                            u32x2 o; o.x = cvt_pk_bf16(acc[0], acc[1]); o.y = cvt_pk_bf16(acc[2], acc[3]); *(GAS u32x2*)(yl_it + ((mt * 4 + nt) * 64 + lane) * 4) = o; } __builtin_amdgcn_sched_barrier(0);
                        {
                            f32x4 acc = (f32x4){0.f, 0.f, 0.f, 0.f}; TILE_MMA(acc, T_MTT, 16 * mt, T_BTT, 16 * nt);
                            const float pl = F_PL[col];
#pragma unroll
                            for (int e = 0; e < 4; ++e) acc[e] = pl * (acc[e] + ((row4 + e == col) ? 1.0f : 0.0f));
                            u32x2 o; o.x = cvt_pk_bf16(acc[0], acc[1]); o.y = cvt_pk_bf16(acc[2], acc[3]); *(GAS u32x2*)(qb_it + col * 64 + 32 * (mt >> 1) + 8 * q + 4 * (mt & 1)) = o; } __builtin_amdgcn_sched_barrier(0);
                        {
                            f32x4 acc = (f32x4){0.f, 0.f, 0.f, 0.f}; TILE_MMA(acc, T_BTT, 16 * mt, T_X1T, 16 * nt); TILE_MMA(acc, T_KTT, 16 * mt, T_VT, 16 * nt);
                            const f32x4 pl = *(const LAS f32x4*)(F_PL + row4);
                            u32x2 o; o.x = cvt_pk_bf16(acc[0] * pl[0], acc[1] * pl[1]); o.y = cvt_pk_bf16(acc[2] * pl[2], acc[3] * pl[3]); *(GAS u32x2*)(zb_it + col * 64 + row4) = o; } __builtin_amdgcn_sched_barrier(0);
                    }
                }
                __syncthreads();
            }
#undef TILE_MMA
#undef W1_LOAD
        }
        SEAM(pb + 3);

        for (int rep_ = 0; rep_ <= ((MK_REPEAT >> 4) & 1); ++rep_) if (IN(pb + 4)) {
            PHASE_BASE();
            const int r = lane & 15, q = lane >> 4;
            for (int wi = 2 * vcu + wave; wave < 2 && wi < 512; wi += 2 * G) {
                const int hd = wi >> 2, iq = wi & 3, i = 16 * iq + r;
                f32x4 Dt[4];
#pragma unroll
                for (int mt = 0; mt < 4; ++mt) Dt[mt] = (f32x4){0.f, 0.f, 0.f, 0.f};
                u32x4 qa0[4][2], qa1[4][2], qa2[4][2], qa3[4][2]; u32x2 za0[4], za1[4], za2[4], za3[4];
#define W2_LOAD(qa, za, c_) do { const GAS bf16_t* qb_ = cqb + ((size_t)hd * 32 + (c_)) * 4096; const GAS bf16_t* zb_ = czb + ((size_t)hd * 32 + (c_)) * 4096; \
                    _Pragma("unroll") for (int mt = 0; mt < 4; ++mt) { za[mt] = *(const GAS u32x2*)(zb_ + i * 64 + 16 * mt + 4 * q); \
                        _Pragma("unroll") for (int ks = 0; ks < 2; ++ks) qa[mt][ks] = *(const GAS u32x4*)(qb_ + (16 * mt + r) * 64 + 32 * ks + 8 * q); } } while (0)
#define W2_STEP(qa, za, c_) do { GAS bf16_t* sb_ = csb + ((size_t)hd * 32 + (c_)) * 4096 + i * 64 + 4 * q; u32x2 pk[4]; \
                    _Pragma("unroll") for (int mt = 0; mt < 4; ++mt) { pk[mt].x = cvt_pk_bf16(Dt[mt][0], Dt[mt][1]); pk[mt].y = cvt_pk_bf16(Dt[mt][2], Dt[mt][3]); *(GAS u32x2*)(sb_ + 16 * mt) = pk[mt]; } \
                    _Pragma("unroll") for (int mt = 0; mt < 4; ++mt) { f32x4 acc = (f32x4){bf_lo(za[mt].x), bf_hi(za[mt].x), bf_lo(za[mt].y), bf_hi(za[mt].y)}; \
                        _Pragma("unroll") for (int ks = 0; ks < 2; ++ks) { const u32x4 aw = qa[mt][ks]; const u32x4 bw = (u32x4){pk[2 * ks].x, pk[2 * ks].y, pk[2 * ks + 1].x, pk[2 * ks + 1].y}; \
                            acc = __builtin_amdgcn_mfma_f32_16x16x32_bf16(__builtin_bit_cast(bf16x8, aw), __builtin_bit_cast(bf16x8, bw), acc, 0, 0, 0); } \
                        Dt[mt] = acc; } } while (0)
                W2_LOAD(qa0, za0, 0); W2_LOAD(qa1, za1, 1); W2_LOAD(qa2, za2, 2); W2_LOAD(qa3, za3, 3);
                for (int c = 0; c < 32; c += 4) {
                    W2_STEP(qa0, za0, c);     if (c + 4 < 32) W2_LOAD(qa0, za0, c + 4);
                    W2_STEP(qa1, za1, c + 1); if (c + 5 < 32) W2_LOAD(qa1, za1, c + 5);
                    W2_STEP(qa2, za2, c + 2); if (c + 6 < 32) W2_LOAD(qa2, za2, c + 6);
                    W2_STEP(qa3, za3, c + 3); if (c + 7 < 32) W2_LOAD(qa3, za3, c + 7);
                }
#undef W2_LOAD
#undef W2_STEP
            }
        }
        SEAM(pb + 4);

        for (int rep_ = 0; rep_ <= ((MK_REPEAT >> 5) & 1); ++rep_) if (IN(pb + 5)) {
            PHASE_BASE();
            const int r = lane & 15, q = lane >> 4;
            const GAS float* lnw = INP(17) + (size_t)j * D; const GAS float* lnb = INP(18) + (size_t)j * D;
            for (int it = gw; it < 4096; it += NGW) {
                const int hd = it >> 5, c = it & 31, b = hd >> 4, h = hd & 15;
                const size_t tok0 = (size_t)b * T + c * 64;
                const GAS bf16_t* sb_ = csb + (size_t)it * 4096; const GAS bf16_t* nb_ = cnb + (size_t)it * 4096; const GAS bf16_t* yl_ = cyl + (size_t)it * 4096;
                bf16x8 af[4][2], bfm[4][2];
#pragma unroll
                for (int mt = 0; mt < 4; ++mt)
#pragma unroll
                    for (int ks = 0; ks < 2; ++ks) { af[mt][ks] = *(const GAS bf16x8*)(sb_ + (16 * mt + r) * 64 + 32 * ks + 8 * q); bfm[mt][ks] = *(const GAS bf16x8*)(nb_ + (16 * mt + r) * 64 + 32 * ks + 8 * q); }
#pragma unroll
                for (int nt = 0; nt < 4; ++nt) {
                    f32x4 acc[4]; float sum = 0.f;
#pragma unroll
                    for (int mt = 0; mt < 4; ++mt) { const u32x2 yl2 = *(const GAS u32x2*)(yl_ + ((mt * 4 + nt) * 64 + lane) * 4);
                        acc[mt] = (f32x4){bf_lo(yl2.x), bf_hi(yl2.x), bf_lo(yl2.y), bf_hi(yl2.y)};
#pragma unroll
                        for (int ks = 0; ks < 2; ++ks) acc[mt] = __builtin_amdgcn_mfma_f32_16x16x32_bf16(af[mt][ks], bfm[nt][ks], acc[mt], 0, 0, 0);
                        sum += (acc[mt][0] + acc[mt][1]) + (acc[mt][2] + acc[mt][3]); }
                    sum += __int_as_float(__builtin_amdgcn_ds_bpermute(4 * (lane ^ 16), __float_as_int(sum))); sum += __int_as_float(__builtin_amdgcn_ds_bpermute(4 * (lane ^ 32), __float_as_int(sum)));
                    const float mean = sum * (1.0f / 64.0f); float sq = 0.f;
#pragma unroll
                    for (int mt = 0; mt < 4; ++mt)
#pragma unroll
                        for (int e = 0; e < 4; ++e) { const float d_ = acc[mt][e] - mean; sq += d_ * d_; }
                    sq += __int_as_float(__builtin_amdgcn_ds_bpermute(4 * (lane ^ 16), __float_as_int(sq))); sq += __int_as_float(__builtin_amdgcn_ds_bpermute(4 * (lane ^ 32), __float_as_int(sq)));
                    const float rstd = rsqrtf(sq * (1.0f / 64.0f) + LNX_EPS);
                    const size_t tok = tok0 + 16 * nt + r; const float bon = cbon[tok * 16 + h];
#pragma unroll
                    for (int mt = 0; mt < 4; ++mt) { const int ch = h * 64 + 16 * mt + 4 * q;
                        const u32x2 v2 = *(const GAS u32x2*)(vbuf + tok * D + ch), g2 = *(const GAS u32x2*)(gbuf + tok * D + ch);
                        const f32x4 lw4 = *(const GAS f32x4*)(lnw + ch), lb4 = *(const GAS f32x4*)(lnb + ch);
                        const f32x4 v4 = (f32x4){bf_lo(v2.x), bf_hi(v2.x), bf_lo(v2.y), bf_hi(v2.y)}, g4 = (f32x4){bf_lo(g2.x), bf_hi(g2.x), bf_lo(g2.y), bf_hi(g2.y)};
                        f32x4 o;
#pragma unroll
                        for (int e = 0; e < 4; ++e) o[e] = (((acc[mt][e] - mean) * rstd) * lw4[e] + lb4[e] + bon * v4[e]) * g4[e];
                        u32x2 w; w.x = cvt_pk_bf16(o[0], o[1]); w.y = cvt_pk_bf16(o[2], o[3]); *(GAS u32x2*)(yg + tok * D + ch) = w; }
                }
            }
        }
        SEAM(pb + 5);
#undef cqb
#undef cnb
#undef czb
#undef cyl
#undef csb
#undef cbon
#else
        for (int rep_ = 0; rep_ <= ((MK_REPEAT >> 3) & 1); ++rep_) if (IN(pb + 3)) {
            PHASE_BASE();
            constexpr int VB = 5 * 2048 + 1024 + 64;
            LAS float* sbuf = (LAS float*)lds;
            LAS float* syb = sbuf + 2 * VB;
            const GAS float* k_k = INP(14) + (size_t)j * D; const GAS float* k_a = INP(15) + (size_t)j * D;
            constexpr int NBLK = T / 32;
            for (int item = bx; item < 256; item += G) {
                const int b = item >> 5, h = (item >> 1) & 15, half = item & 1;
                const int pt = tid >> 4, pc = tid & 15;
                const int ch0 = h * 64 + 4 * pc;
                const f32x4 kkw = *(const GAS f32x4*)(k_k + ch0), kaw = *(const GAS f32x4*)(k_a + ch0);
                const int srow = wave * 4 + (lane >> 4), sc = lane & 15;
                const GAS bf16_t* rp = rbuf + ((size_t)b * T + pt) * D + ch0; const GAS bf16_t* kp = kbuf + ((size_t)b * T + pt) * D + ch0; const GAS bf16_t* vp = vbuf + ((size_t)b * T + pt) * D + ch0;
                const GAS bf16_t* lp = lwbuf + ((size_t)b * T + pt) * D + ch0; const GAS bf16_t* ap = abuf + ((size_t)b * T + pt) * D + ch0;
                GAS float* yp = yraw + ((size_t)b * T + pt) * D + h * 64 + half * 32 + 2 * pc;
                u32x2 pr_, pk_, pv_, pl_, pa_;
#define SCAN_LOAD(blk_) do { const size_t o_ = (size_t)(blk_) * 32 * D; pr_ = *(const GAS u32x2*)(rp + o_); pk_ = *(const GAS u32x2*)(kp + o_); pv_ = *(const GAS u32x2*)(vp + o_); pl_ = *(const GAS u32x2*)(lp + o_); pa_ = *(const GAS u32x2*)(ap + o_); } while (0)
#define SCAN_PREP(buf_) do { LAS float* B_ = sbuf + (buf_) * VB; \
                    const f32x4 r4 = (f32x4){bf_lo(pr_.x), bf_hi(pr_.x), bf_lo(pr_.y), bf_hi(pr_.y)}, k4 = (f32x4){bf_lo(pk_.x), bf_hi(pk_.x), bf_lo(pk_.y), bf_hi(pk_.y)}; \
                    const f32x4 v4 = (f32x4){bf_lo(pv_.x), bf_hi(pv_.x), bf_lo(pv_.y), bf_hi(pv_.y)}, l4 = (f32x4){bf_lo(pl_.x), bf_hi(pl_.x), bf_lo(pl_.y), bf_hi(pl_.y)}; \
                    const f32x4 a4 = (f32x4){bf_lo(pa_.x), bf_hi(pa_.x), bf_lo(pa_.y), bf_hi(pa_.y)}; \
                    f32x4 kk = k4 * kkw; float n2 = kk[0] * kk[0] + kk[1] * kk[1] + kk[2] * kk[2] + kk[3] * kk[3]; n2 = row16_sum(n2); \
                    const float inv = 1.0f / fmaxf(sqrtf(n2), 1e-12f); kk = kk * inv; f32x4 wv, km; \
                    _Pragma("unroll") for (int q = 0; q < 4; ++q) { wv[q] = __expf(l4[q]); km[q] = k4[q] * (1.0f + (a4[q] - 1.0f) * kaw[q]); } \
                    *(LAS f32x4*)(B_ + pt * 64 + 4 * pc) = -kk; *(LAS f32x4*)(B_ + 2048 + pt * 64 + 4 * pc) = wv; *(LAS f32x4*)(B_ + 4096 + pt * 64 + 4 * pc) = kk * a4; \
                    *(LAS f32x4*)(B_ + 6144 + pt * 64 + 4 * pc) = km; *(LAS f32x4*)(B_ + 8192 + pt * 64 + 4 * pc) = wv * r4; \
                    { const f32x4 bb_ = kk * a4; float br_ = bb_[0] * r4[0] + bb_[1] * r4[1] + bb_[2] * r4[2] + bb_[3] * r4[3], kr_ = km[0] * r4[0] + km[1] * r4[1] + km[2] * r4[2] + km[3] * r4[3]; \
                      br_ = row16_sum(br_); kr_ = row16_sum(kr_); if (pc == 0) *(LAS f32x2*)(B_ + 11264 + 2 * pt) = (f32x2){br_, kr_}; } \
                    if ((pc >> 3) == half) *(LAS f32x4*)(B_ + 10240 + pt * 32 + 4 * (pc & 7)) = v4; } while (0)
                f32x2 s01 = {0.f, 0.f}, s23 = {0.f, 0.f};
                SCAN_LOAD(0); SCAN_PREP(0); SCAN_LOAD(1);
                __syncthreads();
                for (int blk = 0; blk < NBLK; ++blk) {
                    if (blk + 1 < NBLK) SCAN_PREP((blk + 1) & 1);
                    if (blk + 2 < NBLK) SCAN_LOAD(blk + 2);
                    if (blk > 0) *(GAS f32x2*)(yp + (size_t)(blk - 1) * 32 * D) = *(const LAS f32x2*)(syb + ((blk - 1) & 1) * 1024 + pt * 32 + 2 * pc);
                    const LAS float* B_ = sbuf + (blk & 1) * VB + 4 * sc; const LAS float* V_ = sbuf + (blk & 1) * VB + 10240 + srow;
                    LAS float* yb = syb + (blk & 1) * 1024 + srow;
                    const LAS float* C_ = sbuf + (blk & 1) * VB + 11264;
                    f32x4 al = *(const LAS f32x4*)(B_), w4 = *(const LAS f32x4*)(B_ + 2048), be = *(const LAS f32x4*)(B_ + 4096), km = *(const LAS f32x4*)(B_ + 6144), wr4 = *(const LAS f32x4*)(B_ + 8192);
                    float vi = V_[0]; f32x2 sc2 = *(const LAS f32x2*)(C_);
#pragma unroll 8
                    for (int t = 0; t < 32; ++t) {
                        const int tn = (t + 1) & 31;
                        const f32x4 al_n = *(const LAS f32x4*)(B_ + tn * 64), w4_n = *(const LAS f32x4*)(B_ + 2048 + tn * 64), be_n = *(const LAS f32x4*)(B_ + 4096 + tn * 64);
                        const f32x4 km_n = *(const LAS f32x4*)(B_ + 6144 + tn * 64), wr_n = *(const LAS f32x4*)(B_ + 8192 + tn * 64); const float vi_n = V_[tn * 32]; const f32x2 sc2_n = *(const LAS f32x2*)(C_ + 2 * tn);
                        const f32x2 p = s01 * (f32x2){al[0], al[1]} + s23 * (f32x2){al[2], al[3]};
                        const f32x2 q = s01 * (f32x2){wr4[0], wr4[1]} + s23 * (f32x2){wr4[2], wr4[3]};
                        float sa = p.x + p.y, yo = q.x + q.y;
                        sa += dpp_f<0xB1>(sa); yo += dpp_f<0xB1>(yo); sa += dpp_f<0x4E>(sa); yo += dpp_f<0x4E>(yo);
                        sa += dpp_f<0x141>(sa); yo += dpp_f<0x141>(yo); sa += dpp_f<0x140>(sa); yo += dpp_f<0x140>(yo);
                        const f32x2 u01 = (f32x2){be[0], be[1]} * sa + (f32x2){km[0], km[1]} * vi, u23 = (f32x2){be[2], be[3]} * sa + (f32x2){km[2], km[3]} * vi;
                        s01 = s01 * (f32x2){w4[0], w4[1]} + u01; s23 = s23 * (f32x2){w4[2], w4[3]} + u23;
                        const float y = yo + sa * sc2.x + vi * sc2.y;
                        if (sc == 0) yb[t * 32] = y;
                        al = al_n; w4 = w4_n; be = be_n; km = km_n; wr4 = wr_n; vi = vi_n; sc2 = sc2_n;
                    }
                    __syncthreads();
                }
                *(GAS f32x2*)(yp + (size_t)(NBLK - 1) * 32 * D) = *(const LAS f32x2*)(syb + ((NBLK - 1) & 1) * 1024 + pt * 32 + 2 * pc);
                __syncthreads();
#undef SCAN_LOAD
#undef SCAN_PREP
            }
        }
        SEAM(pb + 3);

        for (int rep_ = 0; rep_ <= ((MK_REPEAT >> 4) & 1); ++rep_) if (IN(pb + 4)) {
            PHASE_BASE();
            const int c0 = 16 * lane;
            f32x4 ka[4], rk[4], lw_[4], lb_[4];
#pragma unroll
            for (int q = 0; q < 4; ++q) { ka[q] = *(const GAS f32x4*)(INP(15) + (size_t)j * D + c0 + 4 * q); rk[q] = *(const GAS f32x4*)(INP(16) + (size_t)j * D + c0 + 4 * q);
                lw_[q] = *(const GAS f32x4*)(INP(17) + (size_t)j * D + c0 + 4 * q); lb_[q] = *(const GAS f32x4*)(INP(18) + (size_t)j * D + c0 + 4 * q); }
            for (int tok = gw; tok < M; tok += NGW) {
                const size_t off = (size_t)tok * D + c0;
                f32x4 y[4], r[4], k[4], v[4], a[4], g[4];
#pragma unroll
                for (int q = 0; q < 4; ++q) y[q] = *(const GAS f32x4*)(yraw + off + 4 * q);
                unpack8(*(const GAS u32x4*)(rbuf + off), r[0], r[1]); unpack8(*(const GAS u32x4*)(rbuf + off + 8), r[2], r[3]);
                unpack8(*(const GAS u32x4*)(kbuf + off), k[0], k[1]); unpack8(*(const GAS u32x4*)(kbuf + off + 8), k[2], k[3]);
                unpack8(*(const GAS u32x4*)(vbuf + off), v[0], v[1]); unpack8(*(const GAS u32x4*)(vbuf + off + 8), v[2], v[3]);
                unpack8(*(const GAS u32x4*)(abuf + off), a[0], a[1]); unpack8(*(const GAS u32x4*)(abuf + off + 8), a[2], a[3]);
                unpack8(*(const GAS u32x4*)(gbuf + off), g[0], g[1]); unpack8(*(const GAS u32x4*)(gbuf + off + 8), g[2], g[3]);
                float dot = 0.f, sy = 0.f;
#pragma unroll
                for (int q = 0; q < 4; ++q)
#pragma unroll
                    for (int e = 0; e < 4; ++e) { const float km = k[q][e] * (1.0f + (a[q][e] - 1.0f) * ka[q][e]); dot += r[q][e] * km * rk[q][e]; sy += y[q][e]; }
                dot = quad_sum(dot); sy = quad_sum(sy);
                const float mean = sy * (1.0f / 64.0f); float sq = 0.f;
#pragma unroll
                for (int q = 0; q < 4; ++q)
#pragma unroll
                    for (int e = 0; e < 4; ++e) { const float d = y[q][e] - mean; sq += d * d; }
                sq = quad_sum(sq);
                const float rstd = rsqrtf(sq * (1.0f / 64.0f) + LNX_EPS);
                f32x4 o[4];
#pragma unroll
                for (int q = 0; q < 4; ++q)
#pragma unroll
                    for (int e = 0; e < 4; ++e) o[q][e] = (((y[q][e] - mean) * rstd) * lw_[q][e] + lb_[q][e] + dot * v[q][e]) * g[q][e];
                *(GAS u32x4*)(yg + off) = pack8(o[0], o[1]); *(GAS u32x4*)(yg + off + 8) = pack8(o[2], o[3]);
            }
        }
        SEAM(pb + 4);

        SEAM(pb + 5);
#endif

        for (int rep_ = 0; rep_ <= ((MK_REPEAT >> 5) & 1); ++rep_) if (IN(pb + 6)) {
            PHASE_BASE();
            SchedPlain S{uni_ptr((const GAS char*)yg), uni_ptr((const GAS char*)(wr_ + WR_WO)), (size_t)256 * D * 2, (size_t)256 * D * 2, 64, 4, G, bx};
            EpiRes E{(j == 0) ? INP(0) : hbuf1, hcur};
            gemm_phase(lds, tid, D, D, D, S, E);
        }
        SEAM(pb + 6);

        for (int rep_ = 0; rep_ <= ((MK_REPEAT >> 6) & 1); ++rep_) if (IN(pb + 7)) {
            PHASE_BASE();
            const GAS float* gn = INP(2) + (size_t)(2 * j) * D;
            f32x4 gq[4];
#pragma unroll
            for (int q = 0; q < 4; ++q) gq[q] = *(const GAS f32x4*)(gn + 4 * lane + 256 * q);
            for (int tok = gw; tok < M; tok += NGW) {
                f32x4 v[4]; float ss = 0.f;
#pragma unroll
                for (int q = 0; q < 4; ++q) { v[q] = *(const GAS f32x4*)(hcur + (size_t)tok * D + 4 * lane + 256 * q); ss += v[q][0] * v[q][0] + v[q][1] * v[q][1] + v[q][2] * v[q][2] + v[q][3] * v[q][3]; }
                const float rs = rsqrtf(wave_sum(ss) * (1.0f / D) + NORM_EPS);
#pragma unroll
                for (int q = 0; q < 4; ++q) { const f32x4 o = v[q] * rs * gq[q]; u32x2 w; w.x = cvt_pk_bf16(o[0], o[1]); w.y = cvt_pk_bf16(o[2], o[3]); *(GAS u32x2*)(hn2 + (size_t)tok * D + 4 * lane + 256 * q) = w; }
            }
        }
        SEAM(pb + 7);

        for (int rep_ = 0; rep_ <= ((MK_REPEAT >> 7) & 1); ++rep_) if (IN(pb + 8)) {
            PHASE_BASE();
            SchedPlain S{uni_ptr((const GAS char*)hn2), uni_ptr((const GAS char*)(wr_ + WR_GU)), (size_t)256 * D * 2, (size_t)256 * D * 2, 64, FF / 128, G, bx};
            EpiSwiglu E{hmid, FF};
            gemm_phase(lds, tid, D, D, D, S, E);
        }
        SEAM(pb + 8);

        for (int rep_ = 0; rep_ <= ((MK_REPEAT >> 8) & 1); ++rep_) if (IN(pb + 9)) {
            PHASE_BASE();
            SchedPlain S{uni_ptr((const GAS char*)hmid), uni_ptr((const GAS char*)(wr_ + WR_WD)), (size_t)256 * FF * 2, (size_t)256 * FF * 2, 64, 4, G, bx};
            EpiRes E{hcur, hcur};
            gemm_phase(lds, tid, FF, FF, FF, S, E);
        }
        SEAM(pb + 9);

        for (int rep_ = 0; rep_ <= ((MK_REPEAT >> 9) & 1); ++rep_) if (IN(pb + 10)) {
            PHASE_BASE();
            const GAS float* gn = INP(1) + (size_t)(2 * j + 1) * D;
            f32x4 gq[4];
#pragma unroll
            for (int q = 0; q < 4; ++q) gq[q] = *(const GAS f32x4*)(gn + 16 * lane + 4 * q);
            for (int blk = bx; blk < M / 64; blk += G)
                for (int tt = 0; tt < 8; ++tt) { const int tok = blk * 64 + wave * 8 + tt;
                    f32x4 v[4]; float ss = 0.f;
#pragma unroll
                    for (int q = 0; q < 4; ++q) { v[q] = *(const GAS f32x4*)(hcur + (size_t)tok * D + 16 * lane + 4 * q); ss += v[q][0] * v[q][0] + v[q][1] * v[q][1] + v[q][2] * v[q][2] + v[q][3] * v[q][3]; }
                    const float rs = rsqrtf(wave_sum(ss) * (1.0f / D) + NORM_EPS);
#pragma unroll
                    for (int q = 0; q < 4; ++q) v[q] = v[q] * rs * gq[q];
                    GAS bf16_t* dst = ug + ((size_t)lane * NBC + (tok >> 5)) * S5K + (tok & 31) * 16;
                    *(GAS u32x4*)dst = pack8(v[0], v[1]); *(GAS u32x4*)(dst + 8) = pack8(v[2], v[3]); }
        }
        SEAM(pb + 10);

#define WG_REREAD_FENCE() do { asm volatile("s_waitcnt vmcnt(0)" ::: "memory"); __syncthreads(); if (tid == 0) { __builtin_amdgcn_fence(__ATOMIC_ACQUIRE, "agent"); asm volatile("s_waitcnt vmcnt(0)" ::: "memory"); } __syncthreads(); } while (0)
        for (int rep_ = 0; rep_ <= ((MK_REPEAT >> 10) & 1); ++rep_) if (IN(pb + 11)) {
            PHASE_BASE();
            for (int mu = vcu; mu < 256; mu += G) {
                const int g = mu >> 2, pm = (mu >> 1) & 1, pn = mu & 1;
                {   SchedOne S{GUnit{uni_ptr((const GAS char*)ug + (size_t)g * NBC * S5K * 2 + (size_t)pm * 256 * S5K * 2), uni_ptr((const GAS char*)(wss + WSS_M1) + (size_t)g * 256 * 512 * 2), pm, 0, g, 0}};
                    EpiS5E E{eb};
                    gemm_phase(lds, tid, 512, S5K, 512, S, E); }
                WG_REREAD_FENCE();
                if (tid < 256) { const int bq = tid >> 6, p = tid & 63, b = 4 * pm + bq;
                    const float lr = fminf(INP(23)[((size_t)j * 64 + g) * 64 + p], -1e-4f), li = INP(24)[((size_t)j * 64 + g) * 64 + p]; const float dt = __expf(INP(25)[j * 64 + g]);
                    const float mag = expf(32.0f * lr * dt); float rev = 32.0f * (li * dt) * 0.15915494309189535f; rev -= floorf(rev);
                    const float ang = (rev > 0.5f ? rev - 1.0f : rev) * 6.283185307179586f; const float are = mag * cosf(ang), aim = mag * sinf(ang);
                    float hre = 0.f, him = 0.f;
                    for (int c = 0; c < 64; ++c) { const int bc = b * 64 + c;
                        GAS bf16_t* dst = ug + ((size_t)g * NBC + bc) * S5K + 512;
                        dst[p] = (bf16_t)(cvt_pk_bf16(hre, 0.f) & 0xffffu); dst[64 + p] = (bf16_t)(cvt_pk_bf16(him, 0.f) & 0xffffu);
                        const float ere = eb[((size_t)g * NBC + bc) * 128 + p], eim = eb[((size_t)g * NBC + bc) * 128 + 64 + p];
                        const float nre = are * hre - aim * him + ere, nim = are * him + aim * hre + eim; hre = nre; him = nim; }
                }
                WG_REREAD_FENCE();
                {   SchedOne S{GUnit{uni_ptr((const GAS char*)ug + (size_t)g * NBC * S5K * 2 + (size_t)pm * 256 * S5K * 2), uni_ptr((const GAS char*)(wss + WSS_TOEP) + (size_t)g * 512 * S5K * 2 + (size_t)pn * 256 * S5K * 2), pm, pn, g, 0}};
                    EpiS5Y E{yact, ug, INP(30) + (size_t)j * D};
                    gemm_phase(lds, tid, S5K, S5K, S5K, S, E); }
            }
        }
        SEAM(pb + 11);
#undef WG_REREAD_FENCE

        for (int rep_ = 0; rep_ <= ((MK_REPEAT >> 13) & 1); ++rep_) if (IN(pb + 14)) {
            PHASE_BASE();
            SchedPlain S{uni_ptr((const GAS char*)yact), uni_ptr((const GAS char*)(wss + WSS_GLU)), (size_t)256 * D * 2, (size_t)256 * D * 2, 64, 8, G, bx};
            EpiGlu E{hcur, INP(32) + (size_t)j * 2 * D};
            gemm_phase(lds, tid, D, D, D, S, E);
        }
        SEAM(pb + 14);

        for (int rep_ = 0; rep_ <= ((MK_REPEAT >> 14) & 1); ++rep_) if (IN(pb + 15)) {
            PHASE_BASE();
            LAS float* srt = (LAS float*)lds;
            LAS unsigned* stg = (LAS unsigned*)(srt + 8192);
            for (int i = tid; i < 8192; i += NTHREADS) srt[i] = INP(36)[(size_t)j * 8192 + i];
            const GAS float* gn = INP(2) + (size_t)(2 * j + 1) * D;
            f32x4 gq[4];
#pragma unroll
            for (int q = 0; q < 4; ++q) gq[q] = *(const GAS f32x4*)(gn + 4 * lane + 256 * q);
            __syncthreads();
            for (int blk = bx; blk < M / 64; blk += G) {
                for (int tt = 0; tt < 8; ++tt) { const int tok = blk * 64 + wave * 8 + tt;
                    f32x4 v[4]; float ss = 0.f;
#pragma unroll
                    for (int q = 0; q < 4; ++q) { v[q] = *(const GAS f32x4*)(hcur + (size_t)tok * D + 4 * lane + 256 * q); ss += v[q][0] * v[q][0] + v[q][1] * v[q][1] + v[q][2] * v[q][2] + v[q][3] * v[q][3]; }
                    const float rs = rsqrtf(wave_sum(ss) * (1.0f / D) + NORM_EPS);
                    float lg[8];
#pragma unroll
                    for (int e = 0; e < 8; ++e) lg[e] = 0.f;
#pragma unroll
                    for (int q = 0; q < 4; ++q) { const f32x4 o = v[q] * rs * gq[q]; u32x2 w; w.x = cvt_pk_bf16(o[0], o[1]); w.y = cvt_pk_bf16(o[2], o[3]); *(GAS u32x2*)(hn2 + (size_t)tok * D + 4 * lane + 256 * q) = w;
#pragma unroll
                        for (int e4 = 0; e4 < 4; ++e4) { const LAS f32x4* rp = (const LAS f32x4*)(srt + (4 * lane + 256 * q + e4) * 8); const f32x4 r0 = rp[0], r1 = rp[1];
                            lg[0] += o[e4] * r0[0]; lg[1] += o[e4] * r0[1]; lg[2] += o[e4] * r0[2]; lg[3] += o[e4] * r0[3]; lg[4] += o[e4] * r1[0]; lg[5] += o[e4] * r1[1]; lg[6] += o[e4] * r1[2]; lg[7] += o[e4] * r1[3]; } }
#pragma unroll
                    for (int e = 0; e < 8; ++e) lg[e] = wave_sum(lg[e]);
                    int e0 = 0; float v0 = lg[0];
#pragma unroll
                    for (int e = 1; e < 8; ++e) if (lg[e] > v0) { v0 = lg[e]; e0 = e; }
                    int e1 = -1; float v1 = -3.0e38f;
#pragma unroll
                    for (int e = 0; e < 8; ++e) if (e != e0 && lg[e] > v1) { v1 = lg[e]; e1 = e; }
                    const float g0 = 1.0f / (1.0f + expf(v1 - v0)), g1 = 1.0f - g0;
                    if (lane == 0) { const int lt = wave * 8 + tt; stg[lt * 4 + 0] = (unsigned)e0; stg[lt * 4 + 1] = (unsigned)e1; stg[lt * 4 + 2] = __float_as_uint(g0); stg[lt * 4 + 3] = __float_as_uint(g1); }
                }
                __syncthreads();
                if (wave == 0) { const int tok = blk * 64 + lane;
                    const int e0 = (int)stg[lane * 4 + 0], e1 = (int)stg[lane * 4 + 1]; const float g0 = __uint_as_float(stg[lane * 4 + 2]), g1 = __uint_as_float(stg[lane * 4 + 3]);
                    const unsigned long long lt_mask = (lane == 0) ? 0ull : (~0ull >> (64 - lane));
                    unsigned pos0 = 0, pos1 = 0;
#pragma unroll
                    for (int e = 0; e < 8; ++e) { const unsigned long long m0 = __ballot(e0 == e), m1 = __ballot(e1 == e); const unsigned n0 = (unsigned)__popcll(m0), n1 = (unsigned)__popcll(m1);
                        if (lane == 0) blkcnt[blk * 8 + e] = n0 + n1;
                        if (e0 == e) pos0 = (unsigned)__popcll(m0 & lt_mask);
                        if (e1 == e) pos1 = n0 + (unsigned)__popcll(m1 & lt_mask); }
                    asg_pe[2 * tok] = ((unsigned)e0 << 24) | pos0; asg_pe[2 * tok + 1] = ((unsigned)e1 << 24) | pos1; asg_gate[2 * tok] = g0; asg_gate[2 * tok + 1] = g1; }
                __syncthreads();
            }
        }
        SEAM(pb + 15);

        if (IN(pb + 16) || IN(pb + 17) || IN(pb + 18)) {
            PHASE_BASE();
            LAS unsigned* sbase = (LAS unsigned*)(lds + 65536);
            { const int e = wave; unsigned c[4]; unsigned tot = 0;
#pragma unroll
              for (int i = 0; i < 4; ++i) { c[i] = blkcnt[(4 * lane + i) * 8 + e]; }
              unsigned run = c[0] + c[1] + c[2] + c[3], incl = run;
#pragma unroll
              for (int o = 1; o < 64; o <<= 1) { const unsigned t_ = (unsigned)__builtin_amdgcn_ds_bpermute(4 * (lane - o), (int)incl); if (lane >= o) incl += t_; }
              unsigned ex = incl - run;
#pragma unroll
              for (int i = 0; i < 4; ++i) { sbase[(4 * lane + i) * 8 + e] = ex; ex += c[i]; }
              tot = (unsigned)__builtin_amdgcn_readlane((int)incl, 63);
              if (lane == 0) MISC[32 + e] = tot; }
            __syncthreads();
            if (tid == 0) { unsigned acc_ = 0; MISC[16] = 0u;
                for (int e = 0; e < 8; ++e) { const unsigned c = MISC[32 + e]; acc_ += (c + 255u) >> 8; MISC[17 + e] = acc_; } }
            __syncthreads();
        }
        for (int rep_ = 0; rep_ <= ((MK_REPEAT >> 15) & 1); ++rep_) if (IN(pb + 16)) {
            PHASE_BASE();
            unsigned cnt[8], pst[8];
#pragma unroll
            for (int e = 0; e < 8; ++e) { cnt[e] = MISC[32 + e]; pst[e] = MISC[16 + e] * 256u; }
            const LAS unsigned* sbase = (const LAS unsigned*)(lds + 65536);
            for (int a = gw * 64 + lane; a < NASG; a += NGW * 64) { const unsigned pe = asg_pe[a]; const int e = (int)(pe >> 24); const unsigned pos = pe & 0xffffffu;
                unsigned ps = 0;
#pragma unroll
                for (int q = 0; q < 8; ++q) ps = (q == e) ? pst[q] : ps;
                const int tok = a >> 1; const unsigned row = ps + sbase[(tok >> 6) * 8 + e] + pos;
                rowslot[row] = a; rowgate[row] = asg_gate[a]; rowtok[row] = tok; ((GAS int*)(wsl + WS_TROW))[a] = ((int)row >= MOE_TAIL_ROW0) ? (int)row - MOE_TAIL_ROW0 : -1; }
            if (bx < 8) {
#pragma unroll
                for (int e = 0; e < 8; ++e) if (e == bx) { const unsigned padded = ((cnt[e] + 255u) >> 8) << 8;
                    for (unsigned r = cnt[e] + tid; r < padded; r += NTHREADS) { rowslot[pst[e] + r] = -1; rowgate[pst[e] + r] = 0.f; rowtok[pst[e] + r] = 0; } }
            }
        }
        SEAM(pb + 16);

        for (int rep_ = 0; rep_ <= ((MK_REPEAT >> 16) & 1); ++rep_) if (IN(pb + 17)) {
            PHASE_BASE();
            SchedMoeG S{uni_ptr((const GAS char*)hn2), uni_ptr((const GAS char*)(wsl + WS_WM + WM_GU)), (size_t)2 * FE * D * 2, (size_t)256 * D * 2, FE / 128, G, bx, MISC + 16, rowtok};
            EpiSwiglu E{hmidm, FE};
            gemm_phase(lds, tid, D, D, D, S, E);
        }
        SEAM(pb + 17);

        for (int rep_ = 0; rep_ <= ((MK_REPEAT >> 17) & 1); ++rep_) if (IN(pb + 18)) {
            PHASE_BASE();
            EpiMoeDown E{y2, rowslot, rowgate, (GAS bf16_t*)(wsl + WS_Y2T)};
            {   SchedMoeMain S{uni_ptr((const GAS char*)hmidm), uni_ptr((const GAS char*)(wsl + WS_WM + WM_WD)), (size_t)256 * FE * 2, (size_t)D * FE * 2, (size_t)256 * FE * 2, 4, G, bx, MISC + 16};
                gemm_phase(lds, tid, FE, FE, FE, S, E); }
            {   SchedMoeTail S{uni_ptr((const GAS char*)hmidm), uni_ptr((const GAS char*)(wsl + WS_WM + WM_WD)), (size_t)256 * FE * 2, (size_t)D * FE * 2, (size_t)256 * FE * 2, (size_t)(FE / 4) * 2, G, vcu, MISC + 16};
                gemm_phase(lds, tid, FE / 4, FE, FE, S, E); }
        }
        SEAM(pb + 18);
    }

    if (MK_N_LAUNCHES == 1 && hi < NPH - 1) xcd_barrier(bar);
#if MK_PROBE_SRC >= 2
    if (IN(NPH - 1)) {
        PHASE_BASE();
        for (int tok = gw; tok < M; tok += NGW) {
#pragma unroll
            for (int q = 0; q < 4; ++q) { f32x4 x;
                if (MK_PROBE_SRC == 2) { const u32x2 w = *(const GAS u32x2*)((const GAS bf16_t*)(ar + MK_PROBE_OFF) + (size_t)tok * D + 4 * lane + 256 * q); x = (f32x4){bf_lo(w.x), bf_hi(w.x), bf_lo(w.y), bf_hi(w.y)}; }
                else if (MK_PROBE_SRC == 5) { x = *(const GAS f32x4*)(INP(MK_PROBE_INP) + 4 * lane + 256 * q); }
                else if (MK_PROBE_SRC == 4) { x = (f32x4){0.f, 0.f, 0.f, 0.f}; const size_t offs[5] = {AR_R, AR_K, (size_t)WS_VF - (size_t)WS_AR, AR_A, AR_G};
#pragma unroll
                    for (int z = 0; z < 5; ++z) { const u32x2 w = *(const GAS u32x2*)((const GAS bf16_t*)(ar + offs[z]) + (size_t)tok * D + 4 * lane + 256 * q); x += (f32x4){bf_lo(w.x), bf_hi(w.x), bf_lo(w.y), bf_hi(w.y)}; } }
                else x = *(const GAS f32x4*)((const GAS float*)(ar + MK_PROBE_OFF) + (size_t)tok * D + 4 * lane + 256 * q);
                *(GAS f32x4*)((GAS float*)args.out + (size_t)tok * D + 4 * lane + 256 * q) = x; }
        }
    }
#else
    if (IN(NPH - 1)) {
        PHASE_BASE();
        f32x4 gq[4];
#pragma unroll
        for (int q = 0; q < 4; ++q) gq[q] = *(const GAS f32x4*)(INP(3) + 4 * lane + 256 * q);
        for (int tok = gw; tok < M; tok += NGW) {
            f32x4 v[4]; float ss = 0.f;
#pragma unroll
            for (int q = 0; q < 4; ++q) { f32x4 x = *(const GAS f32x4*)((MK_PROBE_SRC ? hbuf1 : hbuf0) + (size_t)tok * D + 4 * lane + 256 * q);
                if (MK_PROBE_Y2) { const u32x2 ya = *(const GAS u32x2*)(y2 + (size_t)(2 * tok) * D + 4 * lane + 256 * q), yb = *(const GAS u32x2*)(y2 + (size_t)(2 * tok + 1) * D + 4 * lane + 256 * q);
                x[0] += bf_lo(ya.x) + bf_lo(yb.x); x[1] += bf_hi(ya.x) + bf_hi(yb.x); x[2] += bf_lo(ya.y) + bf_lo(yb.y); x[3] += bf_hi(ya.y) + bf_hi(yb.y);
                Y2T_ADD(x, tok, q); }
                v[q] = x; ss += x[0] * x[0] + x[1] * x[1] + x[2] * x[2] + x[3] * x[3]; }
            const float rs = rsqrtf(wave_sum(ss) * (1.0f / D) + NORM_EPS);
#pragma unroll
            for (int q = 0; q < 4; ++q) *(GAS f32x4*)((GAS float*)args.out + (size_t)tok * D + 4 * lane + 256 * q) = v[q] * rs * gq[q];
        }
    }
#endif
#undef IN
#undef SEAM
#undef hbuf0
#undef vfirst
#undef y2
#undef wr_
#undef wss
#undef hin_l
#undef hcur
#undef xs
#undef rbuf
#undef kbuf
#undef vbuf
#undef l1
#undef lwbuf
#undef abuf
#undef gbuf
#undef yraw
#undef yg
#undef hn2
#undef hmid
#undef ug
#undef eb
#undef yact
#undef asg_pe
#undef asg_gate
#undef xsm
#undef rowslot
#undef rowgate
#undef hmidm
#undef blkcnt
#undef rowtok
#undef INP
#undef PHASE_BASE
}

extern "C" void kernel_launch(void* const* d_in, const int* in_sizes, int n_in, void* d_out, int out_size, void* d_ws, size_t ws_size, hipStream_t stream) {
    static int grid = 0;
    if (grid == 0) {
        if (n_in != 40 || out_size != M * D || ws_size < WS_END) { fprintf(stderr, "kernel_launch: unexpected shapes (n_in %d, out %d, ws %zu < %zu)\n", n_in, out_size, ws_size, (size_t)WS_END); grid = -1; return; }
        int dev = 0, cus = 0, per_cu = 0;
        if (hipGetDevice(&dev) != hipSuccess || hipDeviceGetAttribute(&cus, hipDeviceAttributeMultiprocessorCount, dev) != hipSuccess) { grid = -1; return; }
        if (hipFuncSetAttribute((const void*)mk_fwd, hipFuncAttributeMaxDynamicSharedMemorySize, LDS_BYTES) != hipSuccess) { fprintf(stderr, "kernel_launch: hipFuncSetAttribute failed\n"); grid = -1; return; }
        if (hipOccupancyMaxActiveBlocksPerMultiprocessor(&per_cu, (const void*)mk_fwd, NTHREADS, LDS_BYTES) != hipSuccess || per_cu < 1) fprintf(stderr, "kernel_launch: occupancy query says %d\n", per_cu);
        (void)hipGetLastError();
        grid = cus;
    }
    if (grid < 0) return;
    (void)in_sizes;
#ifdef MK_ZERO_WS
    if (hipMemsetAsync((char*)d_ws, 0, WS_END, stream) != hipSuccess) return;
    if (hipMemsetAsync((char*)d_out, 0, (size_t)M * D * 4, stream) != hipSuccess) return;
#endif
    if (hipMemsetAsync((char*)d_ws + WS_CTL, 0, CTL_BYTES, stream) != hipSuccess) return;
    Args a{};
    for (int i = 0; i < 40; ++i) a.in[i] = (const float*)d_in[i];
    a.out = (float*)d_out; a.ws = (unsigned char*)d_ws;
#if MK_N_LAUNCHES == 1
    a.ph_lo = 0; a.ph_hi = (MK_STOP_AFTER + 1 < NPH - 1) ? MK_STOP_AFTER + 1 : NPH;
    hipLaunchKernelGGL(mk_fwd, dim3(grid), dim3(NTHREADS), LDS_BYTES, stream, a);
#else
    for (int p = 0; p < NPH; ++p) { if (p > MK_STOP_AFTER && p != NPH - 1) continue; a.ph_lo = p; a.ph_hi = p + 1; hipLaunchKernelGGL(mk_fwd, dim3(grid), dim3(NTHREADS), LDS_BYTES, stream, a); }
#endif
}
```

```cpp
#include <hip/hip_runtime.h>
#include <cstdio>
#include <cstdint>

#ifndef MK_STOP_AFTER
#define MK_STOP_AFTER 38
#define MK_PROBE_SRC 1
#define MK_PROBE_Y2 1
#define MK_PROBE_OFF ((size_t)(WS_WR + WR_L2) - (size_t)WS_AR)
#define MK_PROBE_INP 9
#endif
#ifndef MK_CHUNKED
#define MK_CHUNKED 1
#endif
#ifndef MK_EPISKIP
#define MK_EPISKIP 0
#endif
#ifndef MK_STAMP
#define MK_STAMP 0
#endif
#ifndef MK_REPEAT
#define MK_REPEAT 0
#endif
#ifndef MK_N_LAUNCHES
#define MK_N_LAUNCHES 1
#endif

#define LAS __attribute__((address_space(3)))
#define GAS __attribute__((address_space(1)))
typedef unsigned short bf16_t;
typedef short bf16x8 __attribute__((ext_vector_type(8)));
typedef float f32x4 __attribute__((ext_vector_type(4)));
typedef float f32x2 __attribute__((ext_vector_type(2)));
typedef unsigned u32x4 __attribute__((ext_vector_type(4)));
typedef unsigned u32x2 __attribute__((ext_vector_type(2)));

constexpr int M = 16384, D = 1024, T = 2048, NH = 16, HD = 64;
constexpr int FF = 2816, FE = 3584, NEXP = 8, NASG = 2 * M, CAP = NASG + NEXP * 256;
constexpr int S5L = 32, NBC = M / S5L, S5K = 640;
constexpr float NORM_EPS = 1e-6f, LNX_EPS = 64e-5f;
constexpr int NTHREADS = 512, NWAVES = 8;

constexpr size_t MiB = (size_t)1 << 20;
constexpr size_t WS_CTL = 0, CTL_BYTES = 1 * MiB;
constexpr size_t WS_WR = 1 * MiB, WR_STRIDE = 29 * MiB;
constexpr size_t WR_RKV = 0, WR_L1 = 6 * MiB, WR_L2 = 8 * MiB, WR_WO = 10 * MiB, WR_GU = 12 * MiB, WR_WD = 23 * MiB;
constexpr size_t WS_WS = 59 * MiB, WSS_STRIDE = 60 * MiB;
constexpr size_t WSS_GLU = 0, WSS_TOEP = 4 * MiB, WSS_M1 = 44 * MiB;
constexpr size_t WS_WM = 179 * MiB, WM_GU = 0, WM_WD = 112 * MiB;
constexpr size_t WS_H0 = 347 * MiB, WS_VF = 411 * MiB, WS_Y2 = 443 * MiB, WS_AR = 507 * MiB, WS_Y2T = 847 * MiB, WS_TROW = 859 * MiB, WS_END = 860 * MiB;
constexpr size_t AR_XS = 0, AR_R = 192 * MiB, AR_K = 224 * MiB, AR_V = 256 * MiB, AR_L1 = 288 * MiB;
constexpr size_t AR_LW = 0, AR_A = 32 * MiB, AR_G = 64 * MiB, AR_YRAW = 96 * MiB, AR_YG = 160 * MiB;
constexpr size_t AR_HN2 = 0, AR_HMID = 32 * MiB;
constexpr size_t AR_UG = 0, AR_EB = 40 * MiB, AR_YACT = 56 * MiB;
constexpr size_t AR_ASG = 32 * MiB, AR_XSM = 33 * MiB, AR_ROWM = 101 * MiB, AR_HMIDM = 102 * MiB;
static_assert(AR_HMIDM + (size_t)CAP * FE * 2 <= WS_Y2T - WS_AR, "arena");
constexpr int MOE_MAIN_TILES = 128, MOE_TAIL_ROW0 = MOE_MAIN_TILES * 256;
static_assert(WR_WD + (size_t)D * FF * 2 <= WR_STRIDE, "wr");
constexpr int CW_BAR = 4096;
constexpr int CW_MOECNT = 16384;
constexpr int RING_BYTES = 131072, LDSCTL_OFF = RING_BYTES, MISC_OFF = LDSCTL_OFF + 320, PTAB_OFF = LDSCTL_OFF + 1024, LDS_BYTES = 147456;

constexpr int NPH = 40;

#define VM_WAIT() asm volatile("s_waitcnt vmcnt(0)" ::: "memory")
typedef __bf16 bf16x2_n __attribute__((ext_vector_type(2)));
__device__ __forceinline__ unsigned cvt_pk_bf16(float lo, float hi) { const f32x2 v = {lo, hi}; return __builtin_bit_cast(unsigned, __builtin_convertvector(v, bf16x2_n)); }
__device__ __forceinline__ float bf_lo(unsigned u) { return __uint_as_float(u << 16); }
__device__ __forceinline__ float bf_hi(unsigned u) { return __uint_as_float(u & 0xffff0000u); }
__device__ __forceinline__ float fsigmoid(float x) { return __builtin_amdgcn_rcpf(1.0f + __expf(-x)); }
__device__ __forceinline__ float ftanh(float x) { return 1.0f - 2.0f * __builtin_amdgcn_rcpf(__expf(2.0f * x) + 1.0f); }
__device__ __forceinline__ float fgelu(float x) { const float u = 0.7978845608f * (x + 0.044715f * x * x * x); return x * fsigmoid(2.0f * u); }
template <int CTRL> __device__ __forceinline__ float dpp_f(float x) { return __int_as_float(__builtin_amdgcn_update_dpp(0, __float_as_int(x), CTRL, 0xf, 0xf, true)); }
__device__ __forceinline__ float quad_sum(float x) { x += dpp_f<0xB1>(x); x += dpp_f<0x4E>(x); return x; }
__device__ __forceinline__ float row16_sum(float x) { x = quad_sum(x); x += dpp_f<0x141>(x); x += dpp_f<0x140>(x); return x; }
__device__ __forceinline__ float wave_sum(float v) {
    v = row16_sum(v);
    const float a = __int_as_float(__builtin_amdgcn_readlane(__float_as_int(v), 0)), b = __int_as_float(__builtin_amdgcn_readlane(__float_as_int(v), 16));
    const float c = __int_as_float(__builtin_amdgcn_readlane(__float_as_int(v), 32)), d = __int_as_float(__builtin_amdgcn_readlane(__float_as_int(v), 48));
    return (a + b) + (c + d);
}
__device__ __forceinline__ u32x4 pack8(const f32x4 a, const f32x4 b) { u32x4 w; w.x = cvt_pk_bf16(a[0], a[1]); w.y = cvt_pk_bf16(a[2], a[3]); w.z = cvt_pk_bf16(b[0], b[1]); w.w = cvt_pk_bf16(b[2], b[3]); return w; }
__device__ __forceinline__ void unpack8(const u32x4 w, f32x4& a, f32x4& b) { a = (f32x4){bf_lo(w.x), bf_hi(w.x), bf_lo(w.y), bf_hi(w.y)}; b = (f32x4){bf_lo(w.z), bf_hi(w.z), bf_lo(w.w), bf_hi(w.w)}; }

__device__ __forceinline__ const GAS float* inp_ptr(LAS unsigned long long* tab, int i) {
    const unsigned long long v = tab[i]; const unsigned lo = (unsigned)__builtin_amdgcn_readfirstlane((int)(unsigned)v), hi = (unsigned)__builtin_amdgcn_readfirstlane((int)(unsigned)(v >> 32));
    return (const GAS float*)(((unsigned long long)hi << 32) | lo);
}
#define XB_TMO      128
#define XB_XCNT(j)  (256  + 64 * (j))
#define XB_XSUB(j)  (1280 + 64 * (j))
#define XB_XGEN(j)  (2304 + 64 * (j))
#define XB_TOP      3328
#define XB_TOPGEN   3392
#define XCD_BAR_WORDS 3456
#define XB_SPIN_CAP (1u << 18)
__device__ __forceinline__ unsigned xb_ld(unsigned* p)              { return __hip_atomic_load(p, __ATOMIC_RELAXED, __HIP_MEMORY_SCOPE_AGENT); }
__device__ __forceinline__ unsigned xb_add(unsigned* p, unsigned v) { return __hip_atomic_fetch_add(p, v, __ATOMIC_RELAXED, __HIP_MEMORY_SCOPE_AGENT); }
__device__ __forceinline__ unsigned xb_xcc_id() { return (unsigned)__builtin_amdgcn_s_getreg((3 << 11) | 20) & 0xFu; }
#define XB_SPIN(cond, bar) do { unsigned _sp = 0; while (cond) { __builtin_amdgcn_s_sleep(1); \
    if ((++_sp & 255u) == 0u) { if (xb_ld(&(bar)[XB_TMO])) break; if (_sp > XB_SPIN_CAP) { atomicAdd(&(bar)[XB_TMO], 1u); break; } } } } while (0)
struct XcdBarrier { unsigned* bar; unsigned x; volatile LAS unsigned* st; };
__device__ __forceinline__ XcdBarrier xcd_barrier_post(unsigned* bar, volatile LAS unsigned* st) {
    XcdBarrier b; b.bar = bar; b.x = xb_xcc_id(); b.st = st;
    if (threadIdx.x == 0) (void)xb_add(&bar[XB_XCNT(b.x)], 1u);
    return b;
}
__device__ __forceinline__ void xcd_barrier_complete(unsigned* bar, unsigned x, unsigned& nloc, unsigned& nx) {
    const unsigned G = gridDim.x * gridDim.y * gridDim.z;
    unsigned sum, cnt, mine, sp = 0u;
    for (;;) {
        sum = 0u; cnt = 0u; mine = 0u;
#pragma unroll
        for (unsigned j = 0; j < 16; ++j) { const unsigned c = xb_ld(&bar[XB_XCNT(j)]); sum += c; cnt += (c > 0u) ? 1u : 0u; mine = (j == x) ? c : mine; }
        if (sum == G) break;
        __builtin_amdgcn_s_sleep(1);
        if ((++sp & 255u) == 0u) { if (xb_ld(&bar[XB_TMO])) break; if (sp > XB_SPIN_CAP) { atomicAdd(&bar[XB_TMO], 1u); break; } }
    }
    nloc = mine > 0u ? mine : 1u; nx = cnt > 0u ? cnt : 1u;
}
__device__ __forceinline__ void xcd_barrier(const XcdBarrier& b) {
    asm volatile("s_waitcnt vmcnt(0)" ::: "memory");
    __syncthreads();
    if (threadIdx.x == 0) {
        unsigned* bar = b.bar;
        __builtin_amdgcn_s_waitcnt(0);
        unsigned nloc = b.st[0], nx = b.st[1];
        if (nloc == 0u) { xcd_barrier_complete(bar, b.x, nloc, nx); b.st[0] = nloc; b.st[1] = nx; }
        const unsigned old = xb_add(&bar[XB_XSUB(b.x)], 1u);
        const unsigned gen = old / nloc;
        if (old + 1u == (gen + 1u) * nloc) {
            __builtin_amdgcn_fence(__ATOMIC_RELEASE, "agent");
            asm volatile("s_waitcnt vmcnt(0)" ::: "memory");
            const unsigned og = xb_add(&bar[XB_TOP], 1u);
            const unsigned tg = og / nx;
            if (og + 1u == (tg + 1u) * nx) xb_add(&bar[XB_TOPGEN], 1u);
            else XB_SPIN(xb_ld(&bar[XB_TOPGEN]) == tg, bar);
            __builtin_amdgcn_fence(__ATOMIC_ACQUIRE, "agent");
            xb_add(&bar[XB_XGEN(b.x)], 1u);
            asm volatile("s_waitcnt vmcnt(0)" ::: "memory");
        } else {
            XB_SPIN(xb_ld(&bar[XB_XGEN(b.x)]) == gen, bar);
            __builtin_amdgcn_fence(__ATOMIC_ACQUIRE, "agent");
            asm volatile("s_waitcnt vmcnt(0)" ::: "memory");
        }
    }
    __syncthreads();
}

struct GUnit { const GAS char* A; const GAS char* B; int pm, pn, kind, pad; };
__device__ __forceinline__ int perm32(int rho) { const int n = rho >> 4, i = rho & 15; return 8 * (i >> 2) + 4 * n + (i & 3); }
__device__ __forceinline__ int fdiv(int a, int b) {
    int q = (int)((float)a * __builtin_amdgcn_rcpf((float)b)); const int r = a - q * b; q += (r >= b) ? 1 : 0; q -= (r < 0) ? 1 : 0; return q;
}
__device__ __forceinline__ void tile_order(int L, int nM, int nN, int& pm, int& pn) {
    const int nwg = nM * nN; int wgid = L;
    { const int q = nwg >> 3, r = nwg & 7, xcd = wgid & 7, off = wgid >> 3; wgid = (xcd < r ? xcd * (q + 1) : r * (q + 1) + (xcd - r) * q) + off; }
    const int nig = 8 * nN, gid = fdiv(wgid, nig), rem = wgid - gid * nig, fm = gid * 8, gsz = (nM - fm) < 8 ? (nM - fm) : 8;
    pn = fdiv(rem, gsz); pm = fm + rem - pn * gsz;
}

template <class Epi, class Sched>
__device__ __forceinline__ void gemm_phase_simple(LAS unsigned char* lds, int K, int lda, int ldb, const Sched& S, const Epi& E) {
    (void)lds;
    const int tid = threadIdx.x, wid = __builtin_amdgcn_readfirstlane(tid >> 6), lane = tid & 63, wr = wid >> 2, wc = wid & 3, fr = lane & 15, fq = lane >> 4;
    for (int ui = 0;; ++ui) {
        GUnit u; if (!S.next(ui, u)) break;
        f32x4 acc[2][2][4][2];
#pragma unroll
        for (int a = 0; a < 2; ++a)
#pragma unroll
            for (int b = 0; b < 2; ++b)
#pragma unroll
                for (int m = 0; m < 4; ++m)
#pragma unroll
                    for (int n = 0; n < 2; ++n) acc[a][b][m][n] = (f32x4){0.f, 0.f, 0.f, 0.f};
        const GAS char* Ap = u.A + ((size_t)(wr * 64 + fr) * lda + fq * 8) * 2;
        const GAS char* Bp0 = u.B + ((size_t)(wc * 32 + perm32(fr)) * ldb + fq * 8) * 2;
        const GAS char* Bp1 = u.B + ((size_t)(wc * 32 + perm32(16 + fr)) * ldb + fq * 8) * 2;
#pragma unroll 1
        for (int k0 = 0; k0 < K; k0 += 32) {
            bf16x8 a[2][4], b[2][2];
#pragma unroll
            for (int ai = 0; ai < 2; ++ai)
#pragma unroll
                for (int m = 0; m < 4; ++m) a[ai][m] = *(const GAS bf16x8*)(Ap + ((size_t)(ai * 128 + m * 16) * lda + k0) * 2);
#pragma unroll
            for (int bj = 0; bj < 2; ++bj) { b[bj][0] = *(const GAS bf16x8*)(Bp0 + ((size_t)(bj * 128) * ldb + k0) * 2); b[bj][1] = *(const GAS bf16x8*)(Bp1 + ((size_t)(bj * 128) * ldb + k0) * 2); }
#pragma unroll
            for (int ai = 0; ai < 2; ++ai)
#pragma unroll
                for (int bj = 0; bj < 2; ++bj)
#pragma unroll
                    for (int m = 0; m < 4; ++m)
#pragma unroll
                        for (int n = 0; n < 2; ++n) acc[ai][bj][m][n] = __builtin_amdgcn_mfma_f32_16x16x32_bf16(b[bj][n], a[ai][m], acc[ai][bj][m][n], 0, 0, 0);
        }
        E(acc, u, wr, wc, fr, fq);
    }
}

constexpr int HTB = 128 * 64 * 2;
__device__ __forceinline__ int lds_byte(int r, int c) { const int st = (r >> 4) * 2 + (c >> 5), rr = r & 15, cc = c & 31, ob = rr * 64 + cc * 2; return st * 1024 + (ob ^ (((ob >> 9) & 1) << 5)); }
__device__ __forceinline__ void stage_rc(int b, int& R, int& C) { const int st = b / 1024, sb = b % 1024, swz = sb ^ (((sb >> 9) & 1) << 5); R = (st >> 1) * 16 + swz / 64; C = (st & 1) * 32 + (swz % 64) / 2; }
template <class S> struct sched_gather { static constexpr bool value = false; };
__device__ __forceinline__ const GAS char* uni_ptr(const GAS char* p) {
    const unsigned long long v = (unsigned long long)p; const unsigned lo = (unsigned)__builtin_amdgcn_readfirstlane((int)(unsigned)v), hi = (unsigned)__builtin_amdgcn_readfirstlane((int)(unsigned)(v >> 32));
    return (const GAS char*)(((unsigned long long)hi << 32) | lo);
}
#if MK_STAMP
#define STAMP_AT(slot_, cond_) do { if (tid == 0 && (cond_) && ((volatile LAS unsigned*)(lds + MISC_OFF))[40]) { \
        ((volatile LAS unsigned long long*)(lds + MISC_OFF + 256))[2 * (slot_)] = __builtin_amdgcn_s_memtime(); ((volatile LAS unsigned long long*)(lds + MISC_OFF + 256))[2 * (slot_) + 1] = __builtin_amdgcn_s_memrealtime(); } } while (0)
#else
#define STAMP_AT(slot_, cond_) do { } while (0)
#endif
template <class Epi, class Sched>
__device__ __forceinline__ void gemm_phase(LAS unsigned char* lds, int tid, int K, int lda, int ldb, const Sched& S, const Epi& E) {
    const int wid = __builtin_amdgcn_readfirstlane(tid >> 6), lane = tid & 63, wr = wid >> 2, wc = wid & 3, fr = lane & 15, fq = lane >> 4;
    const int nt = K / 64;
    constexpr bool GA = sched_gather<Sched>::value;
    unsigned voffA[2], voffB[2];
    unsigned voA[2][2], voN[2][2];
#pragma unroll
    for (int i = 0; i < 2; ++i) { int R, C; stage_rc(tid * 16 + i * 8192, R, C); const int Rb = (R & ~31) + perm32(R & 31);
        voffA[i] = (unsigned)(R * lda + C) * 2u; voffB[i] = (unsigned)(Rb * ldb + C) * 2u; }
#define PG8_STAGE_A(bufoff, base, half) do { if constexpr (GA) PG8_STAGE(bufoff, base, voA[half]); else PG8_STAGE(bufoff, (base) + (half) * hstepA, voffA); } while (0)
    const size_t kstep = 128;
    const size_t hstepA = (size_t)128 * lda * 2, hstepB = (size_t)128 * ldb * 2;
    const unsigned ldsw = (unsigned)wid * 1024u;
    const int aoff = lds_byte(wr * 64 + fr, fq * 8), boff = lds_byte(wc * 32 + fr, fq * 8);
#define PG8_SA(b, h) (((b) * 2 + (h)) * HTB)
#define PG8_SB(b, h) ((4 + (b) * 2 + (h)) * HTB)
#define PG8_STAGE(bufoff, gbase, voff) do { const GAS char* _b = uni_ptr(gbase); _Pragma("unroll") for (int _i = 0; _i < 2; ++_i) \
        __builtin_amdgcn_global_load_lds((const GAS unsigned*)(_b + (voff)[_i]), (LAS unsigned*)(lds + (bufoff) + ldsw + _i * 8192), 16, 0, 0); } while (0)
#define PG8_LDA(dst, b, h) do { _Pragma("unroll") for (int m = 0; m < 4; ++m) _Pragma("unroll") for (int k = 0; k < 2; ++k) dst[m][k] = *(const LAS bf16x8*)(lds + PG8_SA(b, h) + aoff + m * 2048 + k * 1024); } while (0)
#define PG8_LDB(dst, b, h) do { _Pragma("unroll") for (int n = 0; n < 2; ++n) _Pragma("unroll") for (int k = 0; k < 2; ++k) dst[n][k] = *(const LAS bf16x8*)(lds + PG8_SB(b, h) + boff + n * 2048 + k * 1024); } while (0)
#define PG8_MMA(ai, bj, At, Bt) do { __builtin_amdgcn_s_setprio(1); _Pragma("unroll") for (int m = 0; m < 4; ++m) _Pragma("unroll") for (int n = 0; n < 2; ++n) _Pragma("unroll") for (int k = 0; k < 2; ++k) \
        acc[ai][bj][m][n] = __builtin_amdgcn_mfma_f32_16x16x32_bf16(Bt[n][k], At[m][k], acc[ai][bj][m][n], 0, 0, 0); __builtin_amdgcn_s_setprio(0); } while (0)
#define PG8_MMA0(ai, bj, At, Bt) do { __builtin_amdgcn_s_setprio(1); _Pragma("unroll") for (int m = 0; m < 4; ++m) _Pragma("unroll") for (int n = 0; n < 2; ++n) { \
        acc[ai][bj][m][n] = __builtin_amdgcn_mfma_f32_16x16x32_bf16(Bt[n][0], At[m][0], (f32x4){0.f, 0.f, 0.f, 0.f}, 0, 0, 0); \
        acc[ai][bj][m][n] = __builtin_amdgcn_mfma_f32_16x16x32_bf16(Bt[n][1], At[m][1], acc[ai][bj][m][n], 0, 0, 0); } __builtin_amdgcn_s_setprio(0); } while (0)
#define PG8_WAIT_V(n) asm volatile("s_waitcnt vmcnt(" #n ")" ::: "memory")
#define PG8_WAIT_L(n) asm volatile("s_waitcnt lgkmcnt(" #n ")" ::: "memory")
#define PG8_BAR __builtin_amdgcn_s_barrier()
#define PG8_SCHED __builtin_amdgcn_sched_barrier(0)
    GUnit cur, nxt; int ui = 0;
    if (!S.next(0, cur)) return;
    f32x4 acc[2][2][4][2];
    bf16x8 At[4][2], B0[2][2], B1[2][2];
    const GAS char* cA = uni_ptr(cur.A); const GAS char* cB = uni_ptr(cur.B);
    if constexpr (GA) S.load_offs(cur.pm, tid, voA);
    PG8_STAGE(PG8_SB(0, 0), cB, voffB); PG8_STAGE(PG8_SB(0, 1), cB + hstepB, voffB); PG8_STAGE_A(PG8_SA(0, 0), cA, 0); PG8_STAGE_A(PG8_SA(0, 1), cA, 1);
    if (wr == 1) PG8_BAR;
    PG8_WAIT_V(2); PG8_BAR;
    PG8_STAGE(PG8_SB(1, 0), cB + kstep, voffB); PG8_STAGE_A(PG8_SA(1, 0), cA + kstep, 0); PG8_STAGE(PG8_SB(1, 1), cB + hstepB + kstep, voffB);
    PG8_WAIT_V(6); PG8_BAR;
    STAMP_AT(0, true);
#define PG8_KBODY(MM) { \
            const bool last = (t == nt - 2); \
            const GAS char* a1 = cA + (size_t)(t + 1) * kstep; \
            const GAS char* a2 = last ? nA : cA + (size_t)(t + 2) * kstep; const GAS char* b2 = last ? nB : cB + (size_t)(t + 2) * kstep; \
            const GAS char* a3 = a2 + kstep; const GAS char* b3 = b2 + kstep; \
              \
            PG8_LDB(B0, 0, 0); PG8_LDB(B1, 0, 1); PG8_SCHED; PG8_LDA(At, 0, 0); PG8_STAGE_A(PG8_SA(1, 1), a1, 1); \
            if constexpr (GA) { if (last) { \
                _Pragma("unroll") for (int h_ = 0; h_ < 2; ++h_) { voA[h_][0] = voN[h_][0]; voA[h_][1] = voN[h_][1]; } } }        \
            PG8_WAIT_V(8); PG8_WAIT_L(0); PG8_BAR; MM(0, 0, At, B0); MM(0, 1, At, B1); PG8_BAR; PG8_SCHED; \
              \
            PG8_LDA(At, 0, 1); PG8_STAGE(PG8_SB(0, 0), b2, voffB); PG8_STAGE(PG8_SB(0, 1), b2 + hstepB, voffB); PG8_STAGE_A(PG8_SA(0, 0), a2, 0); \
            PG8_WAIT_V(8); PG8_WAIT_L(0); PG8_BAR; MM(1, 0, At, B0); MM(1, 1, At, B1); PG8_BAR; PG8_SCHED; \
              \
            PG8_LDB(B0, 1, 0); PG8_LDB(B1, 1, 1); PG8_SCHED; PG8_LDA(At, 1, 0); PG8_STAGE_A(PG8_SA(0, 1), a2, 1); \
            PG8_WAIT_V(8); PG8_WAIT_L(0); PG8_BAR; PG8_MMA(0, 0, At, B0); PG8_MMA(0, 1, At, B1); PG8_BAR; PG8_SCHED; \
              \
            PG8_LDA(At, 1, 1); PG8_STAGE(PG8_SB(1, 0), b3, voffB); PG8_STAGE(PG8_SB(1, 1), b3 + hstepB, voffB); PG8_STAGE_A(PG8_SA(1, 0), a3, 0); \
            PG8_WAIT_V(8); PG8_WAIT_L(0); PG8_BAR; PG8_MMA(1, 0, At, B0); PG8_MMA(1, 1, At, B1); PG8_BAR; PG8_SCHED; }
    for (;;) {
        const bool has_next = S.next(ui + 1, nxt);
        const GAS char* nA = has_next ? uni_ptr(nxt.A) : cA; const GAS char* nB = has_next ? uni_ptr(nxt.B) : cB;
        if constexpr (GA) { if (has_next && nxt.pm != cur.pm) S.load_offs(nxt.pm, tid, voN); else {
#pragma unroll
            for (int h_ = 0; h_ < 2; ++h_) { voN[h_][0] = voA[h_][0]; voN[h_][1] = voA[h_][1]; } } }
        if (ui >= 0) {
#pragma unroll
    for (int a = 0; a < 2; ++a)
#pragma unroll
        for (int b = 0; b < 2; ++b)
#pragma unroll
            for (int m = 0; m < 4; ++m)
#pragma unroll
                for (int n = 0; n < 2; ++n) acc[a][b][m][n] = (f32x4){0.f, 0.f, 0.f, 0.f}; }
#pragma unroll 1
        for (int t = 0; t < nt; t += 2) PG8_KBODY(PG8_MMA)
        STAMP_AT(1, ui == 0);
        if (wr == 0) PG8_BAR;
        E(acc, cur, wr, wc, fr, fq);
        STAMP_AT(2, ui == 0);
        if (!has_next) break;
        cur = nxt; cA = nA; cB = nB; ++ui;
        if (wr == 1) PG8_BAR;
    }
#undef PG8_KBODY
    PG8_WAIT_V(0);
    PG8_BAR;
    STAMP_AT(3, true);
#undef PG8_SA
#undef PG8_SB
#undef PG8_STAGE
#undef PG8_STAGE_A
#undef PG8_LDA
#undef PG8_LDB
#undef PG8_MMA
#undef PG8_MMA0
#undef PG8_WAIT_V
#undef PG8_WAIT_L
#undef PG8_BAR
#undef PG8_SCHED
}

__device__ __forceinline__ int moe_expert(volatile LAS unsigned* tpre, int pm) {
    const u32x4 p0 = *(const LAS u32x4*)tpre, p1 = *(const LAS u32x4*)(tpre + 4);
    const int e = ((int)p0.y <= pm ? 1 : 0) + ((int)p0.z <= pm ? 1 : 0) + ((int)p0.w <= pm ? 1 : 0) + ((int)p1.x <= pm ? 1 : 0) + ((int)p1.y <= pm ? 1 : 0) + ((int)p1.z <= pm ? 1 : 0) + ((int)p1.w <= pm ? 1 : 0);
    return __builtin_amdgcn_readfirstlane(e);
}
struct SchedPlain {
    const GAS char* A; const GAS char* B; size_t tA, tB; int nM, nN, G, c;
    __device__ __forceinline__ bool next(int i, GUnit& u) const {
        const int L = i * G + c; if (L >= nM * nN) return false;
        int pm, pn; tile_order(L, nM, nN, pm, pn);
        u.A = A + (size_t)pm * tA; u.B = B + (size_t)pn * tB; u.pm = pm; u.pn = pn; u.kind = 0; u.pad = 0; return true;
    }
};
struct SchedR2 {
    const GAS char* xs; const GAS char* Wrkv; const GAS char* Wl1; int nvn, G, c;
    __device__ __forceinline__ bool next(int i, GUnit& u) const {
        const int L = i * G + c; if (L >= 64 * nvn) return false;
        int pm, vn; tile_order(L, 64, nvn, pm, vn);
        int kind, pn, s; const GAS char* B;
        if (vn < 12) { kind = vn >> 2; pn = vn & 3; s = kind; B = Wrkv + (size_t)kind * D * D * 2 + (size_t)pn * 256 * D * 2; }
        else { kind = vn - 9; pn = 0; s = (kind == 6) ? 2 : kind; B = Wl1 + (size_t)(kind - 3) * 256 * D * 2; }
        u.A = xs + (size_t)s * M * D * 2 + (size_t)pm * 256 * D * 2; u.B = B; u.pm = pm; u.pn = pn; u.kind = kind; u.pad = 0; return true;
    }
};
struct SchedR3 {
    const GAS char* l1; const GAS char* Wl2; int nvn, G, c;
    __device__ __forceinline__ bool next(int i, GUnit& u) const {
        const int L = i * G + c; if (L >= 64 * nvn) return false;
        int pm, vn; tile_order(L, 64, nvn, pm, vn);
        const int kind = vn >> 2, pn = vn & 3;
        u.A = l1 + (size_t)kind * M * 256 * 2 + (size_t)pm * 256 * 256 * 2; u.B = Wl2 + (size_t)kind * D * 256 * 2 + (size_t)pn * 256 * 256 * 2;
        u.pm = pm; u.pn = pn; u.kind = kind; u.pad = 0; return true;
    }
};
struct SchedGrp {
    const GAS char* A; const GAS char* B; size_t gA, tA, gB, tB; int nMg, nNg, ng, G, vcu;
    __device__ __forceinline__ bool next(int i, GUnit& u) const {
        const int L = i * G + vcu, per = nMg * nNg; if (L >= ng * per) return false;
        const int g = fdiv(L, per), r = L - g * per, pn = fdiv(r, nMg), pm = r - pn * nMg;
        u.A = A + (size_t)g * gA + (size_t)pm * tA; u.B = B + (size_t)g * gB + (size_t)pn * tB; u.pm = pm; u.pn = pn; u.kind = g; u.pad = 0; return true;
    }
};
struct SchedOne {
    GUnit u0;
    __device__ __forceinline__ bool next(int i, GUnit& u) const { if (i != 0) return false; u = u0; return true; }
};
struct SchedMoe {
    const GAS char* A; const GAS char* W; size_t tA, eW, tB; int nN, G, c; volatile LAS unsigned* tpre;
    __device__ __forceinline__ bool next(int i, GUnit& u) const {
        const int MT = (int)tpre[8]; const int L = i * G + c; if (L >= MT * nN) return false;
        int pm, pn; tile_order(L, MT, nN, pm, pn);
        const int e = moe_expert(tpre, pm);
        u.A = A + (size_t)pm * tA; u.B = W + (size_t)e * eW + (size_t)pn * tB; u.pm = pm; u.pn = pn; u.kind = e; u.pad = 0; return true;
    }
};

#define EPI_ARGS const f32x4 (&acc)[2][2][4][2], const GUnit& u, int wr, int wc, int fr, int fq
struct EpiR2 {
    GAS bf16_t* rk; GAS bf16_t* vdst; GAS bf16_t* l1;
    __device__ __forceinline__ void operator()(EPI_ARGS) const {
        const int kind = u.kind; GAS bf16_t* base; int ldc, act = 0;
        if (kind < 3) { base = (kind == 2) ? vdst : rk + (size_t)kind * M * D; ldc = D; }
        else { base = l1 + (size_t)(kind - 3) * M * 256; ldc = 256; act = (kind == 3) ? 1 : ((kind == 5) ? 2 : 0); }
        const int row0 = u.pm * 256 + wr * 64 + fr, col0 = u.pn * 256 + wc * 32 + 8 * fq;
#pragma unroll
        for (int ai = 0; ai < 2; ++ai)
#pragma unroll
            for (int m = 0; m < 4; ++m) { GAS bf16_t* rowp = base + (size_t)(row0 + ai * 128 + m * 16) * ldc + col0;
#pragma unroll
                for (int bj = 0; bj < 2; ++bj) { f32x4 v0 = acc[ai][bj][m][0], v1 = acc[ai][bj][m][1];
                    if (act == 1) {
#pragma unroll
                        for (int j = 0; j < 4; ++j) { v0[j] = ftanh(v0[j]); v1[j] = ftanh(v1[j]); } }
                    if (act == 2) {
#pragma unroll
                        for (int j = 0; j < 4; ++j) { v0[j] = fsigmoid(v0[j]); v1[j] = fsigmoid(v1[j]); } }
                    *(GAS u32x4*)(rowp + bj * 128) = pack8(v0, v1); } }
    }
};
struct EpiR3 {
    GAS unsigned char* wsl; LAS unsigned long long* ptab; int j;
    template <int KIND> __device__ __forceinline__ void run(EPI_ARGS) const {
        GAS unsigned char* ar = wsl + WS_AR;
        GAS bf16_t* vbuf = (j == 0) ? (GAS bf16_t*)(wsl + WS_VF) : (GAS bf16_t*)(ar + AR_V); const GAS bf16_t* vfirst = (const GAS bf16_t*)(wsl + WS_VF);
        const GAS float* bias = inp_ptr(ptab, KIND == 0 ? 6 : (KIND == 1 ? 9 : 20)) + (size_t)((KIND == 3) ? 0 : j) * D;
        GAS bf16_t* base = (KIND == 3) ? vbuf : (GAS bf16_t*)(ar + AR_LW) + (size_t)KIND * M * D;
        const int row0 = u.pm * 256 + wr * 64 + fr, col0 = u.pn * 256 + wc * 32 + 8 * fq;
        f32x4 bv[2][2];
#pragma unroll
        for (int bj = 0; bj < 2; ++bj) { if (KIND != 2) { bv[bj][0] = *(const GAS f32x4*)(bias + col0 + bj * 128); bv[bj][1] = *(const GAS f32x4*)(bias + col0 + bj * 128 + 4); } else { bv[bj][0] = (f32x4){0.f, 0.f, 0.f, 0.f}; bv[bj][1] = bv[bj][0]; } }
#pragma unroll
        for (int ai = 0; ai < 2; ++ai)
#pragma unroll
            for (int m = 0; m < 4; ++m) { const size_t off = (size_t)(row0 + ai * 128 + m * 16) * D + col0;
#pragma unroll
                for (int bj = 0; bj < 2; ++bj) { f32x4 x0 = acc[ai][bj][m][0] + bv[bj][0], x1 = acc[ai][bj][m][1] + bv[bj][1];
                    if (KIND == 0) {
#pragma unroll
                        for (int j = 0; j < 4; ++j) { x0[j] = -0.60653066f * fsigmoid(x0[j]); x1[j] = -0.60653066f * fsigmoid(x1[j]); } }
                    else if (KIND == 1) {
#pragma unroll
                        for (int j = 0; j < 4; ++j) { x0[j] = fsigmoid(x0[j]); x1[j] = fsigmoid(x1[j]); } }
                    else if (KIND == 3) {
                        f32x4 va, vb, fa, fb; unpack8(*(const GAS u32x4*)(vbuf + off + bj * 128), va, vb); unpack8(*(const GAS u32x4*)(vfirst + off + bj * 128), fa, fb);
#pragma unroll
                        for (int j = 0; j < 4; ++j) { x0[j] = va[j] + (fa[j] - va[j]) * fsigmoid(x0[j]); x1[j] = vb[j] + (fb[j] - vb[j]) * fsigmoid(x1[j]); } }
                    *(GAS u32x4*)(base + off + bj * 128) = pack8(x0, x1); } }
    }
    __device__ __forceinline__ void operator()(EPI_ARGS) const {
        const int kind = u.kind;
        if (kind == 0) run<0>(acc, u, wr, wc, fr, fq);
        else if (kind == 1) run<1>(acc, u, wr, wc, fr, fq);
        else if (kind == 2) run<2>(acc, u, wr, wc, fr, fq);
        else run<3>(acc, u, wr, wc, fr, fq);
    }
};
struct EpiRes {
    const GAS bf16_t* hin; GAS bf16_t* hout;
    __device__ __forceinline__ void operator()(EPI_ARGS) const {
        const int row0 = u.pm * 256 + wr * 64 + fr, col0 = u.pn * 256 + wc * 32 + 8 * fq;
#pragma unroll
        for (int ai = 0; ai < 2; ++ai) { u32x4 hw[4][2];
#pragma unroll
            for (int m = 0; m < 4; ++m)
#pragma unroll
                for (int bj = 0; bj < 2; ++bj) hw[m][bj] = *(const GAS u32x4*)(hin + (size_t)(row0 + ai * 128 + m * 16) * D + col0 + bj * 128);
#pragma unroll
            for (int m = 0; m < 4; ++m) { const size_t off = (size_t)(row0 + ai * 128 + m * 16) * D + col0;
#pragma unroll
                for (int bj = 0; bj < 2; ++bj) {
                    f32x4 h0, h1; unpack8(hw[m][bj], h0, h1);
                    *(GAS u32x4*)(hout + off + bj * 128) = pack8(h0 + acc[ai][bj][m][0], h1 + acc[ai][bj][m][1]); } } }
    }
};
struct EpiSwiglu {
    GAS bf16_t* out; int ldc;
#if MK_EPISKIP
    int skip;
#endif
    __device__ __forceinline__ void operator()(EPI_ARGS) const {
#if MK_EPISKIP == 1
        if (skip) return;
#endif
        const int row0 = u.pm * 256 + wr * 64 + fr, col0 = u.pn * 128 + wc * 32 + 8 * fq;
#pragma unroll
        for (int ai = 0; ai < 2; ++ai)
#pragma unroll
            for (int m = 0; m < 4; ++m) { f32x4 o0, o1;
#pragma unroll
                for (int j = 0; j < 4; ++j) { const float g0 = acc[ai][0][m][0][j], g1 = acc[ai][0][m][1][j]; o0[j] = g0 * fsigmoid(g0) * acc[ai][1][m][0][j]; o1[j] = g1 * fsigmoid(g1) * acc[ai][1][m][1][j]; }
                *(GAS u32x4*)(out + (size_t)(row0 + ai * 128 + m * 16) * ldc + col0) = pack8(o0, o1); }
    }
};
struct EpiGlu {
    GAS bf16_t* h; const GAS float* bglu;
    __device__ __forceinline__ void operator()(EPI_ARGS) const {
        const int row0 = u.pm * 256 + wr * 64 + fr, col0 = u.pn * 128 + wc * 32 + 8 * fq;
        const f32x4 bv0 = *(const GAS f32x4*)(bglu + col0), bv1 = *(const GAS f32x4*)(bglu + col0 + 4), bg0 = *(const GAS f32x4*)(bglu + D + col0), bg1 = *(const GAS f32x4*)(bglu + D + col0 + 4);
        u32x4 hw[2][4];
#pragma unroll
        for (int ai = 0; ai < 2; ++ai)
#pragma unroll
            for (int m = 0; m < 4; ++m) hw[ai][m] = *(const GAS u32x4*)(h + (size_t)(row0 + ai * 128 + m * 16) * D + col0);
#pragma unroll
        for (int ai = 0; ai < 2; ++ai)
#pragma unroll
            for (int m = 0; m < 4; ++m) { GAS bf16_t* p = h + (size_t)(row0 + ai * 128 + m * 16) * D + col0;
                f32x4 h0, h1; unpack8(hw[ai][m], h0, h1);
#pragma unroll
                for (int j = 0; j < 4; ++j) { h0[j] += (acc[ai][0][m][0][j] + bv0[j]) * fsigmoid(acc[ai][1][m][0][j] + bg0[j]); h1[j] += (acc[ai][0][m][1][j] + bv1[j]) * fsigmoid(acc[ai][1][m][1][j] + bg1[j]); }
                *(GAS u32x4*)p = pack8(h0, h1); }
    }
};
struct EpiS5E {
    GAS float* eb;
    __device__ __forceinline__ void operator()(EPI_ARGS) const {
        const int row0 = u.pm * 256 + wr * 64 + fr, col0 = wc * 32 + 8 * fq;
#pragma unroll
        for (int ai = 0; ai < 2; ++ai)
#pragma unroll
            for (int m = 0; m < 4; ++m) { GAS float* p = eb + ((size_t)u.kind * NBC + row0 + ai * 128 + m * 16) * 128 + col0;
                *(GAS f32x4*)p = acc[ai][0][m][0]; *(GAS f32x4*)(p + 4) = acc[ai][0][m][1]; }
    }
};
struct EpiS5Y {
    GAS bf16_t* yact; const GAS bf16_t* ug; const GAS float* dskip;
    __device__ __forceinline__ void operator()(EPI_ARGS) const {
        const int g = u.kind; const int row0 = u.pm * 256 + wr * 64 + fr, col0 = u.pn * 256 + wc * 32 + 8 * fq;
        u32x4 xw[2][2][4];
#pragma unroll
        for (int bj = 0; bj < 2; ++bj)
#pragma unroll
            for (int ai = 0; ai < 2; ++ai)
#pragma unroll
                for (int m = 0; m < 4; ++m) xw[bj][ai][m] = *(const GAS u32x4*)(ug + ((size_t)g * NBC + row0 + ai * 128 + m * 16) * S5K + col0 + bj * 128);
#pragma unroll
        for (int bj = 0; bj < 2; ++bj) { const int n = col0 + bj * 128, tl = n >> 4, ch = n & 15;
            const f32x4 d0 = *(const GAS f32x4*)(dskip + 16 * g + ch), d1 = *(const GAS f32x4*)(dskip + 16 * g + ch + 4);
#pragma unroll
            for (int ai = 0; ai < 2; ++ai)
#pragma unroll
                for (int m = 0; m < 4; ++m) { const int bc = row0 + ai * 128 + m * 16;
                    f32x4 x0, x1; unpack8(xw[bj][ai][m], x0, x1);
                    f32x4 y0 = acc[ai][bj][m][0] + d0 * x0, y1 = acc[ai][bj][m][1] + d1 * x1;
#pragma unroll
                    for (int j = 0; j < 4; ++j) { y0[j] = fgelu(y0[j]); y1[j] = fgelu(y1[j]); }
                    *(GAS u32x4*)(yact + ((size_t)bc * S5L + tl) * D + 16 * g + ch) = pack8(y0, y1); } }
    }
};
struct SchedMoeG {
    const GAS char* A; const GAS char* W; size_t eW, tB; int nN, G, c; volatile LAS unsigned* tpre; const GAS int* rowtok;
    __device__ __forceinline__ bool next(int i, GUnit& u) const {
        const int MT = (int)tpre[8]; const int L = i * G + c; if (L >= MT * nN) return false;
        int pm, pn; tile_order(L, MT, nN, pm, pn);
        const int e = moe_expert(tpre, pm);
        u.A = A; u.B = W + (size_t)e * eW + (size_t)pn * tB; u.pm = pm; u.pn = pn; u.kind = e; u.pad = 0; return true;
    }
    __device__ __forceinline__ void load_offs(int pm, int tid, unsigned (&vo)[2][2]) const {
#pragma unroll
        for (int i = 0; i < 2; ++i) { int R, C; stage_rc(tid * 16 + i * 8192, R, C);
#pragma unroll
            for (int h = 0; h < 2; ++h) { const int tok = rowtok[pm * 256 + 128 * h + R]; vo[h][i] = (unsigned)(tok * D + C) * 2u; } }
    }
};
template <> struct sched_gather<SchedMoeG> { static constexpr bool value = true; };
struct SchedMoeMain {
    const GAS char* A; const GAS char* W; size_t tA, eW, tB; int nN, G, c; volatile LAS unsigned* tpre;
    __device__ __forceinline__ bool next(int i, GUnit& u) const {
        int MT = (int)tpre[8]; MT = MT < MOE_MAIN_TILES ? MT : MOE_MAIN_TILES; const int L = i * G + c; if (L >= MT * nN) return false;
        int pm, pn; tile_order(L, MT, nN, pm, pn);
        const int e = moe_expert(tpre, pm);
        u.A = A + (size_t)pm * tA; u.B = W + (size_t)e * eW + (size_t)pn * tB; u.pm = pm; u.pn = pn; u.kind = e; u.pad = 0; return true;
    }
};
struct SchedMoeTail {
    const GAS char* A; const GAS char* W; size_t tA, eW, tB, kq_bytes; int G, c; volatile LAS unsigned* tpre;
    __device__ __forceinline__ bool next(int i, GUnit& u) const {
        const int MT = (int)tpre[8]; const int ntail = MT - MOE_MAIN_TILES; const int L = i * G + c; if (ntail <= 0 || L >= ntail * 16) return false;
        const int pm = MOE_MAIN_TILES + (L >> 4), pn = (L >> 2) & 3, kq = L & 3;
        const int e = moe_expert(tpre, pm);
        u.A = A + (size_t)pm * tA + (size_t)kq * kq_bytes; u.B = W + (size_t)e * eW + (size_t)pn * tB + (size_t)kq * kq_bytes; u.pm = pm; u.pn = pn; u.kind = e; u.pad = kq; return true;
    }
};
struct EpiMoeDown {
    GAS bf16_t* y2; const GAS int* rowslot; const GAS float* rowgate; GAS bf16_t* y2t;
    __device__ __forceinline__ void operator()(EPI_ARGS) const {
        const int row0 = u.pm * 256 + wr * 64 + fr, col0 = u.pn * 256 + wc * 32 + 8 * fq; const int kq = u.pad;
        int sl[2][4]; float gtv[2][4];
#pragma unroll
        for (int ai = 0; ai < 2; ++ai)
#pragma unroll
            for (int m = 0; m < 4; ++m) { sl[ai][m] = rowslot[row0 + ai * 128 + m * 16]; gtv[ai][m] = rowgate[row0 + ai * 128 + m * 16]; }
#pragma unroll
        for (int ai = 0; ai < 2; ++ai)
#pragma unroll
            for (int m = 0; m < 4; ++m) { const int row = row0 + ai * 128 + m * 16; const int slot = sl[ai][m]; const float gt = gtv[ai][m];
                if (slot >= 0) { GAS bf16_t* dst = (kq == 0) ? y2 + (size_t)slot * D : y2t + ((size_t)(kq - 1) * 2048 + (row - MOE_TAIL_ROW0)) * D;
#pragma unroll
                    for (int bj = 0; bj < 2; ++bj) *(GAS u32x4*)(dst + col0 + bj * 128) = pack8(acc[ai][bj][m][0] * gt, acc[ai][bj][m][1] * gt); } }
    }
};

struct CvtEnt { unsigned long long W, dst; int Ks, Ns, lds_, nblk, ldt, mode, row_off, first; };
constexpr int CVT_TAB_OFF = 102400, CVT_SCR_OFF = 32768, CVT_SCR_WAVE = 8704, CVT_MAX = 80;
__device__ __forceinline__ void cvt_add(LAS CvtEnt* tab, int& n, int& total, const GAS float* W, int Ks, int Ns, int lds_, int Kp, int Np, GAS bf16_t* dst, int ldt, int mode, int row_off) {
    LAS CvtEnt* e = tab + n; e->W = (unsigned long long)W; e->dst = (unsigned long long)dst; e->Ks = Ks; e->Ns = Ns; e->lds_ = lds_; e->nblk = Np / 32; e->ldt = ldt; e->mode = mode; e->row_off = row_off; e->first = total;
    total += (Kp / 64) * (Np / 32); ++n; tab[n].first = total;
}
__device__ __forceinline__ void cvt_fetch(const LAS CvtEnt* tab, int& ti, int f, CvtEnt& e) {
    while (f >= __builtin_amdgcn_readfirstlane(tab[ti + 1].first)) ++ti;
    const LAS CvtEnt* t = tab + ti;
    const unsigned long long w = t->W, d = t->dst;
    e.W = ((unsigned long long)(unsigned)__builtin_amdgcn_readfirstlane((int)(w >> 32)) << 32) | (unsigned)__builtin_amdgcn_readfirstlane((int)w);
    e.dst = ((unsigned long long)(unsigned)__builtin_amdgcn_readfirstlane((int)(d >> 32)) << 32) | (unsigned)__builtin_amdgcn_readfirstlane((int)d);
    e.Ks = __builtin_amdgcn_readfirstlane(t->Ks); e.Ns = __builtin_amdgcn_readfirstlane(t->Ns); e.lds_ = __builtin_amdgcn_readfirstlane(t->lds_); e.nblk = __builtin_amdgcn_readfirstlane(t->nblk);
    e.ldt = __builtin_amdgcn_readfirstlane(t->ldt); e.mode = __builtin_amdgcn_readfirstlane(t->mode); e.row_off = __builtin_amdgcn_readfirstlane(t->row_off); e.first = __builtin_amdgcn_readfirstlane(t->first);
}
__device__ __forceinline__ void cvt_load(const CvtEnt& t, int f, int lane, f32x4 (&v)[8]) {
    const int item = f - t.first, kb = fdiv(item, t.nblk), nb = item - kb * t.nblk, k0 = 64 * kb, n0 = 32 * nb;
    const int r = lane >> 3, c4 = lane & 7; const GAS float* W = (const GAS float*)t.W;
#pragma unroll
    for (int i = 0; i < 8; ++i) { const int k = k0 + 8 * i + r, n = n0 + 4 * c4;
        v[i] = (f32x4){0.f, 0.f, 0.f, 0.f}; if (k < t.Ks && n < t.Ns) v[i] = *(const GAS f32x4*)(W + (size_t)k * t.lds_ + n); }
}
__device__ __forceinline__ void cvt_store(const CvtEnt& t, LAS float* scr, int f, int lane, const f32x4 (&v)[8]) {
    const int item = f - t.first, kb = fdiv(item, t.nblk), nb = item - kb * t.nblk, k0 = 64 * kb, n0 = 32 * nb;
    const int r = lane >> 3, c4 = lane & 7; GAS bf16_t* dst = (GAS bf16_t*)t.dst;
#pragma unroll
    for (int i = 0; i < 8; ++i) { LAS float* d = scr + (8 * i + r) * 33 + 4 * c4; d[0] = v[i][0]; d[1] = v[i][1]; d[2] = v[i][2]; d[3] = v[i][3]; }
    asm volatile("s_waitcnt lgkmcnt(0)" ::: "memory");
#pragma unroll
    for (int j = 0; j < 4; ++j) { const int idx = lane + 64 * j, nn = idx >> 3, c = idx & 7; const LAS float* s_ = scr + (8 * c) * 33 + nn;
        u32x4 o; o.x = cvt_pk_bf16(s_[0 * 33], s_[1 * 33]); o.y = cvt_pk_bf16(s_[2 * 33], s_[3 * 33]); o.z = cvt_pk_bf16(s_[4 * 33], s_[5 * 33]); o.w = cvt_pk_bf16(s_[6 * 33], s_[7 * 33]);
        const int n = n0 + nn; const int drow = (t.mode == 1) ? (256 * (n >> 7) + (n & 127) + t.row_off) : (n + t.row_off);
        *(GAS u32x4*)(dst + (size_t)drow * t.ldt + k0 + 8 * c) = o; }
    asm volatile("s_waitcnt lgkmcnt(0)" ::: "memory");
}
__device__ __forceinline__ void cvt_pipe(const LAS CvtEnt* tab, int ntasks, LAS float* scr, int s0, int stepA, int stepB, int lane) {
    const int total = __builtin_amdgcn_readfirstlane(tab[ntasks].first);
    int ti = 0, fl = s0, st = 0;
    CvtEnt e0, e1, e2, e3; f32x4 v0[8], v1[8], v2[8], v3[8]; int f0 = 0, f1 = 0, f2 = 0, f3 = 0; bool m0, m1, m2, m3;
#define CVT_LD(k) do { m##k = fl < total; if (m##k) { f##k = fl; cvt_fetch(tab, ti, fl, e##k); cvt_load(e##k, fl, lane, v##k); fl += st ? stepB : stepA; st ^= 1; } } while (0)
#define CVT_ST(k) do { if (!m##k) return; cvt_store(e##k, scr, f##k, lane, v##k); } while (0)
    CVT_LD(0); CVT_LD(1); CVT_LD(2);
    for (;;) { CVT_LD(3); CVT_ST(0); CVT_LD(0); CVT_ST(1); CVT_LD(1); CVT_ST(2); CVT_LD(2); CVT_ST(3); }
#undef CVT_LD
#undef CVT_ST
}

struct Args { const float* in[40]; float* out; unsigned char* ws; int ph_lo, ph_hi; };

__global__ void __launch_bounds__(NTHREADS, 2) mk_fwd(Args args) {
    extern __shared__ __attribute__((aligned(16))) unsigned char lds_raw[];
    LAS unsigned char* lds = (LAS unsigned char*)lds_raw;
    volatile LAS unsigned* MISC = (volatile LAS unsigned*)(lds + MISC_OFF);
    const int tid0 = threadIdx.x;
    const int G0 = gridDim.x, bx0 = blockIdx.x;
    GAS unsigned char* ws = (GAS unsigned char*)args.ws;
    for (int u = tid0; u < (LDS_BYTES - LDSCTL_OFF) / 4; u += NTHREADS) ((LAS unsigned*)(lds + LDSCTL_OFF))[u] = 0u;
    __syncthreads();
    LAS unsigned long long* PTAB = (LAS unsigned long long*)(lds + PTAB_OFF);
    if (tid0 < 40) PTAB[tid0] = (unsigned long long)args.in[tid0];
    __syncthreads();
#define INP(i) inp_ptr(PTAB, (i))
#define Y2T_ADD(v_, tok_, q_) do { _Pragma("unroll") for (int k2_ = 0; k2_ < 2; ++k2_) { const int tr_ = __builtin_amdgcn_readfirstlane(((const GAS int*)(wsl + WS_TROW))[2 * (tok_) + k2_]); \
        if (tr_ >= 0) { _Pragma("unroll") for (int kq_ = 0; kq_ < 3; ++kq_) { const u32x2 yt_ = *(const GAS u32x2*)((const GAS bf16_t*)(wsl + WS_Y2T) + ((size_t)kq_ * 2048 + tr_) * D + 4 * lane + 256 * (q_)); \
            v_[0] += bf_lo(yt_.x); v_[1] += bf_hi(yt_.x); v_[2] += bf_lo(yt_.y); v_[3] += bf_hi(yt_.y); } } } } while (0)
#define PHASE_BASE() GAS unsigned char* wsl = ws; int G = G0, bx = bx0, tid = tid0; asm volatile("" : "+s"(wsl), "+s"(G), "+s"(bx), "+v"(tid)); \
    const int lane = tid & 63, wave = __builtin_amdgcn_readfirstlane(tid >> 6); GAS unsigned* ctl = (GAS unsigned*)(wsl + WS_CTL); (void)ctl; (void)lane; \
    const int vcu = (G % 8 == 0) ? (bx % 8) * (G / 8) + bx / 8 : bx; const int gw = bx * NWAVES + wave, NGW = G * NWAVES; GAS unsigned char* ar = wsl + WS_AR; (void)ar; (void)vcu; (void)gw; (void)NGW
    XcdBarrier bar = xcd_barrier_post((unsigned*)args.ws + WS_CTL / 4 + CW_BAR, MISC + 8);
    const int lo = args.ph_lo, hi = args.ph_hi;
#define IN(k) ((lo <= (k) && (k) < hi) || ((k) == NPH - 1 && MK_N_LAUNCHES == 1))
#define SEAM(k) do { if (IN(k) && IN((k) + 1)) xcd_barrier(bar); } while (0)

#define hbuf0 ((GAS bf16_t*)(wsl + WS_H0))
#define hbuf1 ((GAS bf16_t*)(wsl + WS_H0 + (size_t)32 * 1024 * 1024))
#define vfirst ((GAS bf16_t*)(wsl + WS_VF))
#define y2 ((GAS bf16_t*)(wsl + WS_Y2))

    for (int rep_ = 0; rep_ <= ((MK_REPEAT >> 18) & 1); ++rep_) if (IN(0)) {
        PHASE_BASE();
        for (int item = bx; item < 128; item += G) {
            const int jl = item >> 6, g = item & 63;
            LAS float* pw_re = (LAS float*)lds;
            LAS float* pw_im = pw_re + 33 * 64;
            LAS float* bb_re = pw_im + 33 * 64;
            LAS float* bb_im = bb_re + 1024;
            LAS float* cc_re = bb_im + 1024;
            LAS float* cc_im = cc_re + 1024;
            LAS float* kt = cc_im + 1024;
            LAS float* sdr = kt + 8192;
            LAS float* sdi = sdr + 64;
            const GAS float* lam_re = INP(23) + ((size_t)jl * 64 + g) * 64; const GAS float* lam_im = INP(24) + ((size_t)jl * 64 + g) * 64;
            const float dt = __expf(INP(25)[jl * 64 + g]);
            if (tid < 64) { const int p = tid;
                const float lr = fminf(lam_re[p], -1e-4f), li = lam_im[p]; const float dr = lr * dt, di = li * dt;
                sdr[p] = dr; sdi[p] = di;
                const float ed = expf(dr), cd = cosf(di), sd = sinf(di), sh = sinf(0.5f * di);
                const float abar_im = ed * sd; const float num_re = expm1f(dr) * cd - 2.0f * sh * sh; const float den = lr * lr + li * li;
                const float cre = (num_re * lr + abar_im * li) / den, cim = (abar_im * lr - num_re * li) / den;
                const GAS float* bre = INP(26) + (((size_t)jl * 64 + g) * 64 + p) * 16; const GAS float* bim = INP(27) + (((size_t)jl * 64 + g) * 64 + p) * 16;
#pragma unroll
                for (int c = 0; c < 16; ++c) { const float br = bre[c], bi = bim[c]; bb_re[p * 16 + c] = cre * br - cim * bi; bb_im[p * 16 + c] = cre * bi + cim * br; }
            }
            for (int i = tid; i < 1024; i += NTHREADS) { cc_re[i] = INP(28)[((size_t)jl * 64 + g) * 1024 + i]; cc_im[i] = INP(29)[((size_t)jl * 64 + g) * 1024 + i]; }
            __syncthreads();
            for (int i = tid; i < 33 * 64; i += NTHREADS) { const int tau = i >> 6, p = i & 63;
                const float mag = expf((float)tau * sdr[p]); float rev = (float)tau * sdi[p] * 0.15915494309189535f; rev -= floorf(rev);
                const float ang = (rev > 0.5f ? rev - 1.0f : rev) * 6.283185307179586f;
                pw_re[i] = mag * cosf(ang); pw_im[i] = mag * sinf(ang); }
            __syncthreads();
            for (int i = tid; i < 8192; i += NTHREADS) { const int tau = i >> 8, co = (i >> 4) & 15, ci = i & 15; float s = 0.f;
                for (int p = 0; p < 64; ++p) { const float cr = cc_re[co * 64 + p], cm = cc_im[co * 64 + p], pr = pw_re[tau * 64 + p], pi = pw_im[tau * 64 + p];
                    const float abr = cr * pr - cm * pi, abi = cr * pi + cm * pr; s += abr * bb_re[p * 16 + ci] - abi * bb_im[p * 16 + ci]; }
                kt[i] = s; }
            __syncthreads();
            GAS bf16_t* toep = (GAS bf16_t*)(wsl + WS_WS + (size_t)jl * WSS_STRIDE + WSS_TOEP) + (size_t)g * 512 * S5K;
            for (int id = tid; id < 512 * 80; id += NTHREADS) { const int n = id / 80, kc = id % 80, k0 = kc * 8, tlo = n >> 4, co = n & 15;
                float v[8];
                if (k0 < 512) { const int tli = k0 >> 4, ci0 = k0 & 15;
#pragma unroll
                    for (int q = 0; q < 8; ++q) v[q] = (tlo >= tli) ? kt[((tlo - tli) * 16 + co) * 16 + ci0 + q] : 0.f; }
                else { const int p0 = k0 - 512; const bool im = p0 >= 64; const int pb = im ? p0 - 64 : p0; const int tau = tlo + 1;
#pragma unroll
                    for (int q = 0; q < 8; ++q) { const int p = pb + q; const float cr = cc_re[co * 64 + p], cm = cc_im[co * 64 + p], pr = pw_re[tau * 64 + p], pi = pw_im[tau * 64 + p];
                        v[q] = im ? -(cr * pi + cm * pr) : (cr * pr - cm * pi); } }
                u32x4 o; o.x = cvt_pk_bf16(v[0], v[1]); o.y = cvt_pk_bf16(v[2], v[3]); o.z = cvt_pk_bf16(v[4], v[5]); o.w = cvt_pk_bf16(v[6], v[7]);
                *(GAS u32x4*)(toep + (size_t)n * S5K + k0) = o; }
            GAS bf16_t* m1 = (GAS bf16_t*)(wsl + WS_WS + (size_t)jl * WSS_STRIDE + WSS_M1) + (size_t)g * 256 * 512;
            for (int id = tid; id < 256 * 64; id += NTHREADS) { const int n = id >> 6, kc = id & 63, k0 = kc * 8, tli = k0 >> 4, ci0 = k0 & 15;
                float v[8];
                if (n < 128) { const bool im = n >= 64; const int p = im ? n - 64 : n; const int tau = 31 - tli; const float pr = pw_re[tau * 64 + p], pi = pw_im[tau * 64 + p];
#pragma unroll
                    for (int q = 0; q < 8; ++q) { const float br = bb_re[p * 16 + ci0 + q], bi = bb_im[p * 16 + ci0 + q]; v[q] = im ? (pr * bi + pi * br) : (pr * br - pi * bi); } }
                else {
#pragma unroll
                    for (int q = 0; q < 8; ++q) v[q] = 0.f; }
                u32x4 o; o.x = cvt_pk_bf16(v[0], v[1]); o.y = cvt_pk_bf16(v[2], v[3]); o.z = cvt_pk_bf16(v[4], v[5]); o.w = cvt_pk_bf16(v[6], v[7]);
                *(GAS u32x4*)(m1 + (size_t)n * 512 + k0) = o; }
            __syncthreads();
        }
            LAS float* scr = (LAS float*)(lds + CVT_SCR_OFF + wave * CVT_SCR_WAVE);
        LAS CvtEnt* ctab = (LAS CvtEnt*)(lds + CVT_TAB_OFF);
        if (tid == 0) { int cn = 0, ctot = 0;
#pragma unroll 1
        for (int j = 0; j < 2; ++j) {
            GAS unsigned char* wr_ = wsl + WS_WR + (size_t)j * WR_STRIDE;
#pragma unroll 1
            for (int s = 0; s < 3; ++s) cvt_add(ctab, cn, ctot, INP(5) + ((size_t)j * 3 + s) * D * D, D, D, D, D, D, (GAS bf16_t*)(wr_ + WR_RKV) + (size_t)s * D * D, D, 0, 0);
            cvt_add(ctab, cn, ctot, INP(7) + (size_t)j * D * 64, D, 64, 64, D, 256, (GAS bf16_t*)(wr_ + WR_L1), D, 0, 0);
            cvt_add(ctab, cn, ctot, INP(10) + (size_t)j * D * 64, D, 64, 64, D, 256, (GAS bf16_t*)(wr_ + WR_L1) + (size_t)256 * D, D, 0, 0);
            cvt_add(ctab, cn, ctot, INP(12) + (size_t)j * D * 160, D, 160, 160, D, 256, (GAS bf16_t*)(wr_ + WR_L1) + (size_t)2 * 256 * D, D, 0, 0);
            if (j == 1) cvt_add(ctab, cn, ctot, INP(21), D, 32, 32, D, 256, (GAS bf16_t*)(wr_ + WR_L1) + (size_t)3 * 256 * D, D, 0, 0);
            cvt_add(ctab, cn, ctot, INP(8) + (size_t)j * 64 * D, 64, D, D, 256, D, (GAS bf16_t*)(wr_ + WR_L2), 256, 0, 0);
            cvt_add(ctab, cn, ctot, INP(11) + (size_t)j * 64 * D, 64, D, D, 256, D, (GAS bf16_t*)(wr_ + WR_L2) + (size_t)D * 256, 256, 0, 0);
            cvt_add(ctab, cn, ctot, INP(13) + (size_t)j * 160 * D, 160, D, D, 256, D, (GAS bf16_t*)(wr_ + WR_L2) + (size_t)2 * D * 256, 256, 0, 0);
            if (j == 1) cvt_add(ctab, cn, ctot, INP(22), 32, D, D, 256, D, (GAS bf16_t*)(wr_ + WR_L2) + (size_t)3 * D * 256, 256, 0, 0);
            cvt_add(ctab, cn, ctot, INP(19) + (size_t)j * D * D, D, D, D, D, D, (GAS bf16_t*)(wr_ + WR_WO), D, 0, 0);
            cvt_add(ctab, cn, ctot, INP(33) + (size_t)j * D * FF, D, FF, FF, D, FF, (GAS bf16_t*)(wr_ + WR_GU), D, 1, 0);
            cvt_add(ctab, cn, ctot, INP(34) + (size_t)j * D * FF, D, FF, FF, D, FF, (GAS bf16_t*)(wr_ + WR_GU), D, 1, 128);
            cvt_add(ctab, cn, ctot, INP(35) + (size_t)j * FF * D, FF, D, D, FF, D, (GAS bf16_t*)(wr_ + WR_WD), FF, 0, 0);
            GAS unsigned char* wss = wsl + WS_WS + (size_t)j * WSS_STRIDE;
            cvt_add(ctab, cn, ctot, INP(31) + (size_t)j * D * 2 * D, D, D, 2 * D, D, D, (GAS bf16_t*)(wss + WSS_GLU), D, 1, 0);
            cvt_add(ctab, cn, ctot, INP(31) + (size_t)j * D * 2 * D + D, D, D, 2 * D, D, D, (GAS bf16_t*)(wss + WSS_GLU), D, 1, 128);
        }
#pragma unroll 1
        for (int e = 0; e < NEXP; ++e) {
            cvt_add(ctab, cn, ctot, INP(37) + (size_t)e * D * FE, D, FE, FE, D, FE, (GAS bf16_t*)(wsl + WS_WM + WM_GU) + (size_t)e * 2 * FE * D, D, 1, 0);
            cvt_add(ctab, cn, ctot, INP(38) + (size_t)e * D * FE, D, FE, FE, D, FE, (GAS bf16_t*)(wsl + WS_WM + WM_GU) + (size_t)e * 2 * FE * D, D, 1, 128);
            cvt_add(ctab, cn, ctot, INP(39) + (size_t)e * FE * D, FE, D, D, FE, D, (GAS bf16_t*)(wsl + WS_WM + WM_WD) + (size_t)e * D * FE, FE, 0, 0);
        }
        MISC[41] = (unsigned)cn; }
        __syncthreads();
        {
            const int npre = (G < 128 ? G : 128) * NWAVES, NV = npre + 2 * (NGW - npre); const bool two = gw >= npre;
            cvt_pipe(ctab, (int)MISC[41], scr, two ? npre + 2 * (gw - npre) : gw, two ? 1 : NV, two ? NV - 1 : NV, lane); }
        __syncthreads();
}
    SEAM(0);

    for (int j = 0; j < 2; ++j) {
        const int pb = 1 + 19 * j;
#define wr_ (wsl + WS_WR + (size_t)j * WR_STRIDE)
#define wss (wsl + WS_WS + (size_t)j * WSS_STRIDE)
#define hcur ((j == 0) ? hbuf0 : hbuf1)
#define xs ((GAS bf16_t*)(ar + AR_XS))
#define rbuf ((GAS bf16_t*)(ar + AR_R))
#define kbuf ((GAS bf16_t*)(ar + AR_K))
#define vbuf ((j == 0) ? vfirst : (GAS bf16_t*)(ar + AR_V))
#define l1 ((GAS bf16_t*)(ar + AR_L1))
#define lwbuf ((GAS bf16_t*)(ar + AR_LW))
#define abuf ((GAS bf16_t*)(ar + AR_A))
#define gbuf ((GAS bf16_t*)(ar + AR_G))
#define yraw ((GAS float*)(ar + AR_YRAW))
#define yg ((GAS bf16_t*)(ar + AR_YG))
#define hn2 ((GAS bf16_t*)(ar + AR_HN2))
#define hmid ((GAS bf16_t*)(ar + AR_HMID))
#define ug ((GAS bf16_t*)(ar + AR_UG))
#define eb ((GAS float*)(ar + AR_EB))
#define yact ((GAS bf16_t*)(ar + AR_YACT))
#define asg_pe ((GAS unsigned*)(ar + AR_ASG))
#define asg_gate ((GAS float*)(ar + AR_ASG + 256 * 1024))
#define xsm ((GAS bf16_t*)(ar + AR_XSM))
#define rowslot ((GAS int*)(ar + AR_ROWM))
#define rowgate ((GAS float*)(ar + AR_ROWM + 512 * 1024))
#define rowtok ((GAS int*)(ar + AR_ROWM + 256 * 1024))
#define hmidm ((GAS bf16_t*)(ar + AR_HMIDM))
#define blkcnt ((GAS unsigned*)(ar + AR_ASG + 512 * 1024))

        for (int rep_ = 0; rep_ <= ((MK_REPEAT >> 0) & 1); ++rep_) if (IN(pb + 0)) {
            PHASE_BASE();
            LAS float* smu = (LAS float*)lds;
            LAS float* sg = smu + 6 * 1024;
            {   f32x4 mw[3]; float gw_[2];
#pragma unroll
                for (int u = 0; u < 3; ++u) mw[u] = *(const GAS f32x4*)(INP(4) + (size_t)j * 6 * 1024 + 4 * (tid + NTHREADS * u));
#pragma unroll
                for (int u = 0; u < 2; ++u) gw_[u] = INP(1)[(size_t)(2 * j) * 1024 + tid + NTHREADS * u];
#pragma unroll
                for (int u = 0; u < 3; ++u) *(LAS f32x4*)(smu + 4 * (tid + NTHREADS * u)) = mw[u];
#pragma unroll
                for (int u = 0; u < 2; ++u) sg[tid + NTHREADS * u] = gw_[u]; }
            __syncthreads();
            const bool comb = (j == 1);
            for (int blk = bx; blk < M / 64; blk += G) {
                const int t0 = blk * 64 + wave * 8;
                f32x4 prev[4], cur[4];
#pragma unroll
                for (int tt = -1; tt < 8; ++tt) {
                    const int tok = t0 + tt;
                    if (tt == -1 && (t0 % T) == 0) {
#pragma unroll
                        for (int q = 0; q < 4; ++q) prev[q] = (f32x4){0.f, 0.f, 0.f, 0.f};
                        continue; }
                    float ss = 0.f;
#pragma unroll
                    for (int q = 0; q < 4; ++q) { f32x4 v;
                        if (!comb) v = *(const GAS f32x4*)(INP(0) + (size_t)tok * D + 4 * lane + 256 * q);
                        else { const u32x2 hw = *(const GAS u32x2*)(hbuf0 + (size_t)tok * D + 4 * lane + 256 * q); v = (f32x4){bf_lo(hw.x), bf_hi(hw.x), bf_lo(hw.y), bf_hi(hw.y)}; }
                        if (comb) { const u32x2 ya = *(const GAS u32x2*)(y2 + (size_t)(2 * tok) * D + 4 * lane + 256 * q), yb = *(const GAS u32x2*)(y2 + (size_t)(2 * tok + 1) * D + 4 * lane + 256 * q);
                            v[0] += bf_lo(ya.x) + bf_lo(yb.x); v[1] += bf_hi(ya.x) + bf_hi(yb.x); v[2] += bf_lo(ya.y) + bf_lo(yb.y); v[3] += bf_hi(ya.y) + bf_hi(yb.y);
                            Y2T_ADD(v, tok, q); }
                        if (tt >= 0) { u32x2 hw2; hw2.x = cvt_pk_bf16(v[0], v[1]); hw2.y = cvt_pk_bf16(v[2], v[3]); *(GAS u32x2*)(hcur + (size_t)tok * D + 4 * lane + 256 * q) = hw2; }
                        cur[q] = v; ss += v[0] * v[0] + v[1] * v[1] + v[2] * v[2] + v[3] * v[3]; }
                    const float rs = rsqrtf(wave_sum(ss) * (1.0f / D) + NORM_EPS);
#pragma unroll
                    for (int q = 0; q < 4; ++q) cur[q] = cur[q] * rs * *(const LAS f32x4*)(sg + 4 * lane + 256 * q);
                    if (tt >= 0) {
#pragma unroll
                        for (int s = 0; s < 6; ++s)
#pragma unroll
                            for (int q = 0; q < 4; ++q) { const f32x4 mu = *(const LAS f32x4*)(smu + s * 1024 + 4 * lane + 256 * q); const f32x4 o = cur[q] + (prev[q] - cur[q]) * mu;
                                u32x2 w; w.x = cvt_pk_bf16(o[0], o[1]); w.y = cvt_pk_bf16(o[2], o[3]);
                                *(GAS u32x2*)(xs + (size_t)s * M * D + (size_t)tok * D + 4 * lane + 256 * q) = w; } }
#pragma unroll
                    for (int q = 0; q < 4; ++q) prev[q] = cur[q];
                }
            }
            if (j == 1) {
                __syncthreads();
                LAS float* scr = (LAS float*)(lds + CVT_SCR_OFF + wave * CVT_SCR_WAVE);
                LAS CvtEnt* ctab = (LAS CvtEnt*)(lds + CVT_TAB_OFF);
                if (tid == 0) { int cn = 0, ctot = 0;
                int dD = D, dFE = FE; asm volatile("" : "+s"(dD), "+s"(dFE));
#pragma unroll 1
                for (int e = 0; e < NEXP; ++e) {
                    cvt_add(ctab, cn, ctot, INP(37) + ((size_t)NEXP + e) * D * FE, dD, dFE, dFE, dD, dFE, (GAS bf16_t*)(wsl + WS_WM + WM_GU) + (size_t)e * 2 * FE * D, dD, 1, 0);
                    cvt_add(ctab, cn, ctot, INP(38) + ((size_t)NEXP + e) * D * FE, dD, dFE, dFE, dD, dFE, (GAS bf16_t*)(wsl + WS_WM + WM_GU) + (size_t)e * 2 * FE * D, dD, 1, 128);
                    cvt_add(ctab, cn, ctot, INP(39) + ((size_t)NEXP + e) * FE * D, dFE, dD, dD, dFE, dD, (GAS bf16_t*)(wsl + WS_WM + WM_WD) + (size_t)e * D * FE, dFE, 0, 0);
                }
                MISC[41] = (unsigned)cn; }
                __syncthreads();
                cvt_pipe(ctab, (int)MISC[41], scr, gw, NGW, NGW, lane);
            }
            __syncthreads();
        }
        SEAM(pb + 0);

        for (int rep_ = 0; rep_ <= ((MK_REPEAT >> 1) & 1); ++rep_) if (IN(pb + 1)) {
            PHASE_BASE();
            SchedR2 S{uni_ptr((const GAS char*)xs), uni_ptr((const GAS char*)(wr_ + WR_RKV)), uni_ptr((const GAS char*)(wr_ + WR_L1)), (j == 0) ? 15 : 16, G, bx};
            EpiR2 E{rbuf, vbuf, l1};
            gemm_phase(lds, tid, D, D, D, S, E);
        }
        SEAM(pb + 1);

        for (int rep_ = 0; rep_ <= ((MK_REPEAT >> 2) & 1); ++rep_) if (IN(pb + 2)) {
            PHASE_BASE();
            SchedR3 S{uni_ptr((const GAS char*)l1), uni_ptr((const GAS char*)(wr_ + WR_L2)), (j == 0) ? 12 : 16, G, bx};
            EpiR3 E{wsl, PTAB, j};
            gemm_phase(lds, tid, 256, 256, 256, S, E);
        }
        SEAM(pb + 2);

#if MK_CHUNKED
#define cqb ((GAS bf16_t*)(wsl + WS_Y2))
#define cnb ((GAS bf16_t*)(wsl + WS_Y2 + 32 * MiB))
#define czb ((GAS bf16_t*)(ar + 96 * MiB))
#define cyl ((GAS bf16_t*)(ar + 128 * MiB))
#define csb ((GAS bf16_t*)(ar + 288 * MiB))
#define cbon ((GAS float*)(ar + 320 * MiB))
        for (int rep_ = 0; rep_ <= ((MK_REPEAT >> 3) & 1); ++rep_) if (IN(pb + 3)) {
            PHASE_BASE();
#if MK_STAMP == 6
            if (j == 0 && tid == 0) MISC[40] = 1u;
            __syncthreads();
            STAMP_AT(0, true);
#endif
            constexpr int LD = 72;
            LAS bf16_t* T_ABAR = (LAS bf16_t*)(lds + 0); LAS bf16_t* T_RBAR = (LAS bf16_t*)(lds + 9216); LAS bf16_t* T_BT = (LAS bf16_t*)(lds + 18432); LAS bf16_t* T_KT = (LAS bf16_t*)(lds + 27648);
            LAS bf16_t* T_BTT = (LAS bf16_t*)(lds + 36864); LAS bf16_t* T_KTT = (LAS bf16_t*)(lds + 46080); LAS bf16_t* T_VT = (LAS bf16_t*)(lds + 55296);
            LAS bf16_t* T_AAB = (LAS bf16_t*)(lds + 64512);
            LAS float* F_DIAG = (LAS float*)(lds + 73728);
            LAS float* F_G = (LAS float*)(lds + 64512);
            LAS bf16_t* T_AAK = (LAS bf16_t*)(lds + 81920); LAS bf16_t* T_ABR = (LAS bf16_t*)(lds + 91136); LAS bf16_t* T_AKR = (LAS bf16_t*)(lds + 100352);
            LAS float* F_W = (LAS float*)(lds + 109568);
            LAS bf16_t* T_V = (LAS bf16_t*)(lds + 109568);
            LAS float* F_SEG = (LAS float*)(lds + 125952);
            LAS float* F_TI = (LAS float*)(lds + 125952);
            LAS float* F_PL = (LAS float*)(lds + 130816);
            LAS bf16_t* T_MTT = T_BT; LAS bf16_t* T_X1T = T_KT;
            const int r = lane & 15, q = lane >> 4;
            const GAS float* k_k = INP(14) + (size_t)j * D; const GAS float* k_a = INP(15) + (size_t)j * D; const GAS float* r_k = INP(16) + (size_t)j * D;
#define TILE_MMA(acc_, At_, arow_, Bt_, brow_) do { _Pragma("unroll") for (int ks_ = 0; ks_ < 2; ++ks_) { \
                const bf16x8 a_ = *(const LAS bf16x8*)((At_) + ((arow_) + r) * LD + 32 * ks_ + 8 * q), b_ = *(const LAS bf16x8*)((Bt_) + ((brow_) + r) * LD + 32 * ks_ + 8 * q); \
                acc_ = __builtin_amdgcn_mfma_f32_16x16x32_bf16(a_, b_, acc_, 0, 0, 0); } } while (0)
            u32x4 pf_r, pf_k, pf_v, pf_l, pf_a;
#define W1_LOAD(it_) do { const int hd_ = (it_) >> 5, c_ = (it_) & 31; const size_t go_ = ((size_t)(hd_ >> 4) * T + c_ * 64 + (tid >> 3)) * D + (hd_ & 15) * 64 + 8 * (tid & 7); \
                pf_r = *(const GAS u32x4*)(rbuf + go_); pf_k = *(const GAS u32x4*)(kbuf + go_); pf_v = *(const GAS u32x4*)(vbuf + go_); pf_l = *(const GAS u32x4*)(lwbuf + go_); pf_a = *(const GAS u32x4*)(abuf + go_); } while (0)
            for (int it = bx; it < 4096; it += G) {
                W1_LOAD(it);
                const int hd = it >> 5, c = it & 31, b = hd >> 4, h = hd & 15;
                const size_t tok0 = (size_t)b * T + c * 64;
                const int t = tid >> 3, c8 = tid & 7;
                f32x4 al0, al1, be0, be1, km0, km1, r0, r1, lq0, lq1;
                {
                    f32x4 k0, k1, v0, v1, a0, a1;
                    unpack8(pf_r, r0, r1); unpack8(pf_k, k0, k1); unpack8(pf_v, v0, v1); unpack8(pf_l, lq0, lq1); unpack8(pf_a, a0, a1);
                    const int co = h * 64 + 8 * c8;
                    const f32x4 kk0w = *(const GAS f32x4*)(k_k + co), kk1w = *(const GAS f32x4*)(k_k + co + 4), ka0 = *(const GAS f32x4*)(k_a + co), ka1 = *(const GAS f32x4*)(k_a + co + 4);
                    const f32x4 rk0 = *(const GAS f32x4*)(r_k + co), rk1 = *(const GAS f32x4*)(r_k + co + 4);
                    f32x4 kk0 = k0 * kk0w, kk1 = k1 * kk1w; float n2 = 0.f, bon = 0.f;
#pragma unroll
                    for (int e = 0; e < 4; ++e) { n2 += kk0[e] * kk0[e] + kk1[e] * kk1[e]; km0[e] = k0[e] * (1.0f + (a0[e] - 1.0f) * ka0[e]); km1[e] = k1[e] * (1.0f + (a1[e] - 1.0f) * ka1[e]);
                        bon += r0[e] * km0[e] * rk0[e] + r1[e] * km1[e] * rk1[e]; }
                    n2 = quad_sum(n2); n2 += dpp_f<0x141>(n2); bon = quad_sum(bon); bon += dpp_f<0x141>(bon);
                    const float inv = 1.0f / fmaxf(sqrtf(n2), 1e-12f); kk0 = kk0 * inv; kk1 = kk1 * inv;
                    al0 = -kk0; al1 = -kk1; be0 = kk0 * a0; be1 = kk1 * a1;
                    if (c8 == 0) cbon[(tok0 + t) * 16 + h] = bon;
                    *(LAS f32x4*)(F_G + t * 64 + 8 * c8) = lq0; *(LAS f32x4*)(F_G + t * 64 + 8 * c8 + 4) = lq1;
                    *(LAS u32x4*)(T_V + t * LD + 8 * c8) = pack8(v0, v1);
                }
                __syncthreads();
                {
                    const int jj = tid & 63, seg = tid >> 6; float pv[8]; float run = 0.f;
#pragma unroll
                    for (int e = 0; e < 8; ++e) { run += F_G[(8 * seg + e) * 64 + jj]; pv[e] = run; }
                    F_SEG[seg * 64 + jj] = run;
                    __syncthreads();
                    float offs = 0.f;
#pragma unroll
                    for (int s_ = 0; s_ < 7; ++s_) offs += (s_ < seg) ? F_SEG[s_ * 64 + jj] : 0.f;
#pragma unroll
                    for (int e = 0; e < 8; ++e) F_G[(8 * seg + e) * 64 + jj] = pv[e] + offs;
                    if (seg == 7) F_PL[jj] = __expf(pv[7] + offs);
                }
                __syncthreads();
                {
                    const f32x4 g0 = *(const LAS f32x4*)(F_G + t * 64 + 8 * c8), g1 = *(const LAS f32x4*)(F_G + t * 64 + 8 * c8 + 4);
                    f32x4 ab0, ab1, rb0, rb1, bt0, bt1, kt0, kt1;
#pragma unroll
                    for (int e = 0; e < 4; ++e) { const float eg0 = __expf(g0[e]), eg1 = __expf(g1[e]), em0 = __expf(g0[e] - lq0[e]), em1 = __expf(g1[e] - lq1[e]), ei0 = __expf(-g0[e]), ei1 = __expf(-g1[e]);
                        ab0[e] = al0[e] * em0; ab1[e] = al1[e] * em1; rb0[e] = r0[e] * eg0; rb1[e] = r1[e] * eg1; bt0[e] = be0[e] * ei0; bt1[e] = be1[e] * ei1; kt0[e] = km0[e] * ei0; kt1[e] = km1[e] * ei1; }
                    *(LAS u32x4*)(T_ABAR + t * LD + 8 * c8) = pack8(ab0, ab1); *(LAS u32x4*)(T_RBAR + t * LD + 8 * c8) = pack8(rb0, rb1);
                    *(LAS u32x4*)(T_BT + t * LD + 8 * c8) = pack8(bt0, bt1); *(LAS u32x4*)(T_KT + t * LD + 8 * c8) = pack8(kt0, kt1);
                }
                __syncthreads();
                {
                    const int jj = tid & 63, seg = tid >> 6;
                    unsigned wb[4], wk_[4], wv_[4];
#pragma unroll
                    for (int e = 0; e < 4; ++e) { const int s0 = 8 * seg + 2 * e;
                        wb[e] = (unsigned)T_BT[s0 * LD + jj] | ((unsigned)T_BT[(s0 + 1) * LD + jj] << 16); wk_[e] = (unsigned)T_KT[s0 * LD + jj] | ((unsigned)T_KT[(s0 + 1) * LD + jj] << 16);
                        wv_[e] = (unsigned)T_V[s0 * LD + jj] | ((unsigned)T_V[(s0 + 1) * LD + jj] << 16); }
                    *(LAS u32x4*)(T_BTT + jj * LD + 8 * seg) = (u32x4){wb[0], wb[1], wb[2], wb[3]}; *(LAS u32x4*)(T_KTT + jj * LD + 8 * seg) = (u32x4){wk_[0], wk_[1], wk_[2], wk_[3]};
                    *(LAS u32x4*)(T_VT + jj * LD + 8 * seg) = (u32x4){wv_[0], wv_[1], wv_[2], wv_[3]};
                }
                __syncthreads();
                {
                    const int pidx = wave >> 1, mh = wave & 1;
                    const LAS bf16_t* At_ = (pidx < 2) ? T_ABAR : T_RBAR; const LAS bf16_t* Bt_ = (pidx & 1) ? T_KT : T_BT;
                    LAS bf16_t* Ot = (pidx == 0) ? T_AAB : ((pidx == 1) ? T_AAK : ((pidx == 2) ? T_ABR : T_AKR));
#pragma unroll
                    for (int mi = 0; mi < 2; ++mi)
#pragma unroll
                        for (int nt = 0; nt < 4; ++nt) { const int mt = 2 * mh + mi; f32x4 acc = (f32x4){0.f, 0.f, 0.f, 0.f};
                            TILE_MMA(acc, At_, 16 * mt, Bt_, 16 * nt);
                            const int s_ = 16 * nt + r;
#pragma unroll
                            for (int e = 0; e < 4; ++e) { const int tt = 16 * mt + 4 * q + e; const bool keep = (pidx < 2) ? (s_ < tt) : (s_ <= tt); const float v_ = keep ? acc[e] : 0.f;
                                Ot[tt * LD + s_] = (bf16_t)(cvt_pk_bf16(v_, 0.f) & 0xffffu);
                                if (pidx == 0 && (mt == nt)) F_DIAG[(mt * 16 + 4 * q + e) * 20 + r] = v_; } }
                }
                __syncthreads();
                {
                    const int mt = wave >> 1;
#pragma unroll
                    for (int nn = 0; nn < 2; ++nn) { const int nt = 2 * (wave & 1) + nn; f32x4 acc = (f32x4){0.f, 0.f, 0.f, 0.f};
                        TILE_MMA(acc, T_AAK, 16 * mt, T_VT, 16 * nt);
#pragma unroll
                        for (int e = 0; e < 4; ++e) F_W[(16 * mt + 4 * q + e) * 64 + 16 * nt + r] = acc[e]; }
                    if (wave == 7) {
                        const int blk = lane >> 4, cc = lane & 15; float x[16];
#pragma unroll
                        for (int tl = 0; tl < 16; ++tl) { float acc = (tl == cc) ? 1.0f : 0.0f;
#pragma unroll
                            for (int s4 = 0; s4 < (tl + 3) / 4; ++s4) { const f32x4 cf = *(const LAS f32x4*)(F_DIAG + (blk * 16 + tl) * 20 + 4 * s4);
#pragma unroll
                                for (int e = 0; e < 4; ++e) if (4 * s4 + e < tl) acc += cf[e] * x[4 * s4 + e]; }
                            x[tl] = acc; F_TI[(blk * 16 + tl) * 16 + cc] = acc; }
                    }
                }
                __syncthreads();
                {
                    const int sub = wave >> 2, ct = wave & 3;
                    LAS bf16_t* OT = (sub == 0) ? T_MTT : T_X1T;
                    { unsigned z_; asm volatile("v_mov_b32 %0, 0" : "=v"(z_)); LAS bf16_t* zr = OT + (16 * ct + r) * LD + 16 * q; *(LAS u32x4*)zr = (u32x4){z_, z_, z_, z_}; *(LAS u32x4*)(zr + 8) = (u32x4){z_, z_, z_, z_}; }
                    asm volatile("s_waitcnt lgkmcnt(0)" ::: "memory");
                    for (int bk = 0; bk < 4; ++bk) {
                        f32x4 d = (f32x4){0.f, 0.f, 0.f, 0.f};
                        if (bk > 0) TILE_MMA(d, T_AAB, 16 * bk, OT, 16 * ct);
#pragma unroll
                        for (int e = 0; e < 4; ++e) { const int tt = 16 * bk + 4 * q + e; d[e] += (sub == 0) ? __uint_as_float((unsigned)T_ABAR[tt * LD + 16 * ct + r] << 16) : F_W[tt * 64 + 16 * ct + r]; }
                        const f32x4 ti4 = *(const LAS f32x4*)(F_TI + (bk * 16 + r) * 16 + 4 * q);
                        f32x4 o = (f32x4){0.f, 0.f, 0.f, 0.f};
#pragma unroll
                        for (int kk = 0; kk < 4; ++kk) o = __builtin_amdgcn_mfma_f32_16x16x4f32(d[kk], ti4[kk], o, 0, 0, 0);
#pragma unroll
                        for (int e = 0; e < 4; ++e) OT[(16 * ct + 4 * q + e) * LD + 16 * bk + r] = (bf16_t)(cvt_pk_bf16(o[e], 0.f) & 0xffffu);
                        asm volatile("s_waitcnt lgkmcnt(0)" ::: "memory");
                    }
                }
                __syncthreads();
                {
                    const int mt = wave >> 1; const int row4 = 16 * mt + 4 * q;
                    GAS bf16_t* nb_it = cnb + (size_t)it * 4096; GAS bf16_t* qb_it = cqb + (size_t)it * 4096; GAS bf16_t* zb_it = czb + (size_t)it * 4096; GAS bf16_t* yl_it = cyl + (size_t)it * 4096;
#pragma unroll
                    for (int nn = 0; nn < 2; ++nn) { const int nt = 2 * (wave & 1) + nn; const int col = 16 * nt + r;
                        {
                            f32x4 acc = (f32x4){0.f, 0.f, 0.f, 0.f}; TILE_MMA(acc, T_MTT, 16 * mt, T_ABR, 16 * nt);
                            const u32x2 rb = *(const LAS u32x2*)(T_RBAR + col * LD + row4);
                            acc[0] += bf_lo(rb.x); acc[1] += bf_hi(rb.x); acc[2] += bf_lo(rb.y); acc[3] += bf_hi(rb.y);
                            u32x2 o; o.x = cvt_pk_bf16(acc[0], acc[1]); o.y = cvt_pk_bf16(acc[2], acc[3]); *(GAS u32x2*)(nb_it + col * 64 + row4) = o; } __builtin_amdgcn_sched_barrier(0);
                        {
                            f32x4 acc = (f32x4){0.f, 0.f, 0.f, 0.f}; TILE_MMA(acc, T_X1T, 16 * mt, T_ABR, 16 * nt); TILE_MMA(acc, T_VT, 16 * mt, T_AKR, 16 * nt);
                            u32x2 o; o.x = cvt_pk_bf16(acc[0], acc[1]); o.y = cvt_pk_bf16(acc[2], acc[3]); *(GAS u32x2*)(yl_it + ((mt * 4 + nt) * 64 + lane) * 4) = o; } __builtin_amdgcn_sched_barrier(0);
                        {
                            f32x4 acc = (f32x4){0.f, 0.f, 0.f, 0.f}; TILE_MMA(acc, T_MTT, 16 * mt, T_BTT, 16 * nt);
                            const float pl = F_PL[col];
#pragma unroll
                            for (int e = 0; e < 4; ++e) acc[e] = pl * (acc[e] + ((row4 + e == col) ? 1.0f : 0.0f));
                            u32x2 o; o.x = cvt_pk_bf16(acc[0], acc[1]); o.y = cvt_pk_bf16(acc[2], acc[3]); *(GAS u32x2*)(qb_it + col * 64 + 32 * (mt >> 1) + 8 * q + 4 * (mt & 1)) = o; } __builtin_amdgcn_sched_barrier(0);
                        {
                            f32x4 acc = (f32x4){0.f, 0.f, 0.f, 0.f}; TILE_MMA(acc, T_BTT, 16 * mt, T_X1T, 16 * nt); TILE_MMA(acc, T_KTT, 16 * mt, T_VT, 16 * nt);
                            const f32x4 pl = *(const LAS f32x4*)(F_PL + row4);
                            u32x2 o; o.x = cvt_pk_bf16(acc[0] * pl[0], acc[1] * pl[1]); o.y = cvt_pk_bf16(acc[2] * pl[2], acc[3] * pl[3]); *(GAS u32x2*)(zb_it + col * 64 + row4) = o; } __builtin_amdgcn_sched_barrier(0);
                    }
                }
                __syncthreads();
            }
#undef TILE_MMA
#undef W1_LOAD
        #if MK_STAMP == 6
            __syncthreads(); STAMP_AT(3, true); __syncthreads(); if (tid == 0) MISC[40] = 0u;
#endif
        }
        SEAM(pb + 3);

        for (int rep_ = 0; rep_ <= ((MK_REPEAT >> 4) & 1); ++rep_) if (IN(pb + 4)) {
            PHASE_BASE();
            const int r = lane & 15, q = lane >> 4;
            for (int wi = 2 * vcu + wave; wave < 2 && wi < 512; wi += 2 * G) {
                const int hd = wi >> 2, iq = wi & 3, i = 16 * iq + r;
                f32x4 Dt[4];
#pragma unroll
                for (int mt = 0; mt < 4; ++mt) Dt[mt] = (f32x4){0.f, 0.f, 0.f, 0.f};
                u32x4 qa0[4][2], qa1[4][2], qa2[4][2], qa3[4][2]; u32x2 za0[4], za1[4], za2[4], za3[4];
#define W2_LOAD(qa, za, c_) do { const GAS bf16_t* qb_ = cqb + ((size_t)hd * 32 + (c_)) * 4096; const GAS bf16_t* zb_ = czb + ((size_t)hd * 32 + (c_)) * 4096; \
                    _Pragma("unroll") for (int mt = 0; mt < 4; ++mt) { za[mt] = *(const GAS u32x2*)(zb_ + i * 64 + 16 * mt + 4 * q); \
                        _Pragma("unroll") for (int ks = 0; ks < 2; ++ks) qa[mt][ks] = *(const GAS u32x4*)(qb_ + (16 * mt + r) * 64 + 32 * ks + 8 * q); } } while (0)
#define W2_STEP(qa, za, c_) do { GAS bf16_t* sb_ = csb + ((size_t)hd * 32 + (c_)) * 4096 + i * 64 + 4 * q; u32x2 pk[4]; \
                    _Pragma("unroll") for (int mt = 0; mt < 4; ++mt) { pk[mt].x = cvt_pk_bf16(Dt[mt][0], Dt[mt][1]); pk[mt].y = cvt_pk_bf16(Dt[mt][2], Dt[mt][3]); *(GAS u32x2*)(sb_ + 16 * mt) = pk[mt]; } \
                    _Pragma("unroll") for (int mt = 0; mt < 4; ++mt) { f32x4 acc = (f32x4){bf_lo(za[mt].x), bf_hi(za[mt].x), bf_lo(za[mt].y), bf_hi(za[mt].y)}; \
                        _Pragma("unroll") for (int ks = 0; ks < 2; ++ks) { const u32x4 aw = qa[mt][ks]; const u32x4 bw = (u32x4){pk[2 * ks].x, pk[2 * ks].y, pk[2 * ks + 1].x, pk[2 * ks + 1].y}; \
                            acc = __builtin_amdgcn_mfma_f32_16x16x32_bf16(__builtin_bit_cast(bf16x8, aw), __builtin_bit_cast(bf16x8, bw), acc, 0, 0, 0); } \
                        Dt[mt] = acc; } } while (0)
                W2_LOAD(qa0, za0, 0); W2_LOAD(qa1, za1, 1); W2_LOAD(qa2, za2, 2); W2_LOAD(qa3, za3, 3);
                for (int c = 0; c < 32; c += 4) {
                    W2_STEP(qa0, za0, c);     if (c + 4 < 32) W2_LOAD(qa0, za0, c + 4);
                    W2_STEP(qa1, za1, c + 1); if (c + 5 < 32) W2_LOAD(qa1, za1, c + 5);
                    W2_STEP(qa2, za2, c + 2); if (c + 6 < 32) W2_LOAD(qa2, za2, c + 6);
                    W2_STEP(qa3, za3, c + 3); if (c + 7 < 32) W2_LOAD(qa3, za3, c + 7);
                }
#undef W2_LOAD
#undef W2_STEP
            }
        }
        SEAM(pb + 4);

        for (int rep_ = 0; rep_ <= ((MK_REPEAT >> 5) & 1); ++rep_) if (IN(pb + 5)) {
            PHASE_BASE();
            const int r = lane & 15, q = lane >> 4;
            const GAS float* lnw = INP(17) + (size_t)j * D; const GAS float* lnb = INP(18) + (size_t)j * D;
            for (int it = gw; it < 4096; it += NGW) {
                const int hd = it >> 5, c = it & 31, b = hd >> 4, h = hd & 15;
                const size_t tok0 = (size_t)b * T + c * 64;
                const GAS bf16_t* sb_ = csb + (size_t)it * 4096; const GAS bf16_t* nb_ = cnb + (size_t)it * 4096; const GAS bf16_t* yl_ = cyl + (size_t)it * 4096;
                bf16x8 af[4][2], bfm[4][2];
#pragma unroll
                for (int mt = 0; mt < 4; ++mt)
#pragma unroll
                    for (int ks = 0; ks < 2; ++ks) { af[mt][ks] = *(const GAS bf16x8*)(sb_ + (16 * mt + r) * 64 + 32 * ks + 8 * q); bfm[mt][ks] = *(const GAS bf16x8*)(nb_ + (16 * mt + r) * 64 + 32 * ks + 8 * q); }
                u32x2 ylr[4][4], vr[4][4], gr[4][4]; float bonr[4]; f32x4 lw4[4], lb4[4];
#pragma unroll
                for (int nt = 0; nt < 4; ++nt) { const size_t tok = tok0 + 16 * nt + r; bonr[nt] = cbon[tok * 16 + h];
#pragma unroll
                    for (int mt = 0; mt < 4; ++mt) { const int ch = h * 64 + 16 * mt + 4 * q;
                        ylr[nt][mt] = *(const GAS u32x2*)(yl_ + ((mt * 4 + nt) * 64 + lane) * 4); vr[nt][mt] = *(const GAS u32x2*)(vbuf + tok * D + ch); gr[nt][mt] = *(const GAS u32x2*)(gbuf + tok * D + ch); } }
#pragma unroll
                for (int mt = 0; mt < 4; ++mt) { const int ch = h * 64 + 16 * mt + 4 * q; lw4[mt] = *(const GAS f32x4*)(lnw + ch); lb4[mt] = *(const GAS f32x4*)(lnb + ch); }
                asm volatile("" ::: "memory");
                u32x2 wout[4][4];
#pragma unroll
                for (int nt = 0; nt < 4; ++nt) {
                    f32x4 acc[4]; float sum = 0.f;
#pragma unroll
                    for (int mt = 0; mt < 4; ++mt) { const u32x2 yl2 = ylr[nt][mt];
                        acc[mt] = (f32x4){bf_lo(yl2.x), bf_hi(yl2.x), bf_lo(yl2.y), bf_hi(yl2.y)};
#pragma unroll
                        for (int ks = 0; ks < 2; ++ks) acc[mt] = __builtin_amdgcn_mfma_f32_16x16x32_bf16(af[mt][ks], bfm[nt][ks], acc[mt], 0, 0, 0);
                        sum += (acc[mt][0] + acc[mt][1]) + (acc[mt][2] + acc[mt][3]); }
                    sum += __int_as_float(__builtin_amdgcn_ds_bpermute(4 * (lane ^ 16), __float_as_int(sum))); sum += __int_as_float(__builtin_amdgcn_ds_bpermute(4 * (lane ^ 32), __float_as_int(sum)));
                    const float mean = sum * (1.0f / 64.0f); float sq = 0.f;
#pragma unroll
                    for (int mt = 0; mt < 4; ++mt)
#pragma unroll
                        for (int e = 0; e < 4; ++e) { const float d_ = acc[mt][e] - mean; sq += d_ * d_; }
                    sq += __int_as_float(__builtin_amdgcn_ds_bpermute(4 * (lane ^ 16), __float_as_int(sq))); sq += __int_as_float(__builtin_amdgcn_ds_bpermute(4 * (lane ^ 32), __float_as_int(sq)));
                    const float rstd = rsqrtf(sq * (1.0f / 64.0f) + LNX_EPS);
                    const float bon = bonr[nt];
#pragma unroll
                    for (int mt = 0; mt < 4; ++mt) {
                        const u32x2 v2 = vr[nt][mt], g2 = gr[nt][mt];
                        const f32x4 v4 = (f32x4){bf_lo(v2.x), bf_hi(v2.x), bf_lo(v2.y), bf_hi(v2.y)}, g4 = (f32x4){bf_lo(g2.x), bf_hi(g2.x), bf_lo(g2.y), bf_hi(g2.y)};
                        f32x4 o;
#pragma unroll
                        for (int e = 0; e < 4; ++e) o[e] = (((acc[mt][e] - mean) * rstd) * lw4[mt][e] + lb4[mt][e] + bon * v4[e]) * g4[e];
                        wout[nt][mt].x = cvt_pk_bf16(o[0], o[1]); wout[nt][mt].y = cvt_pk_bf16(o[2], o[3]); }
                }
#pragma unroll
                for (int nt = 0; nt < 4; ++nt) { const size_t tok = tok0 + 16 * nt + r;
#pragma unroll
                    for (int mt = 0; mt < 4; ++mt) *(GAS u32x2*)(yg + tok * D + h * 64 + 16 * mt + 4 * q) = wout[nt][mt]; }
            }
        }
        SEAM(pb + 5);
#undef cqb
#undef cnb
#undef czb
#undef cyl
#undef csb
#undef cbon
#else
        for (int rep_ = 0; rep_ <= ((MK_REPEAT >> 3) & 1); ++rep_) if (IN(pb + 3)) {
            PHASE_BASE();
            constexpr int VB = 5 * 2048 + 1024 + 64;
            LAS float* sbuf = (LAS float*)lds;
            LAS float* syb = sbuf + 2 * VB;
            const GAS float* k_k = INP(14) + (size_t)j * D; const GAS float* k_a = INP(15) + (size_t)j * D;
            constexpr int NBLK = T / 32;
            for (int item = bx; item < 256; item += G) {
                const int b = item >> 5, h = (item >> 1) & 15, half = item & 1;
                const int pt = tid >> 4, pc = tid & 15;
                const int ch0 = h * 64 + 4 * pc;
                const f32x4 kkw = *(const GAS f32x4*)(k_k + ch0), kaw = *(const GAS f32x4*)(k_a + ch0);
                const int srow = wave * 4 + (lane >> 4), sc = lane & 15;
                const GAS bf16_t* rp = rbuf + ((size_t)b * T + pt) * D + ch0; const GAS bf16_t* kp = kbuf + ((size_t)b * T + pt) * D + ch0; const GAS bf16_t* vp = vbuf + ((size_t)b * T + pt) * D + ch0;
                const GAS bf16_t* lp = lwbuf + ((size_t)b * T + pt) * D + ch0; const GAS bf16_t* ap = abuf + ((size_t)b * T + pt) * D + ch0;
                GAS float* yp = yraw + ((size_t)b * T + pt) * D + h * 64 + half * 32 + 2 * pc;
                u32x2 pr_, pk_, pv_, pl_, pa_;
#define SCAN_LOAD(blk_) do { const size_t o_ = (size_t)(blk_) * 32 * D; pr_ = *(const GAS u32x2*)(rp + o_); pk_ = *(const GAS u32x2*)(kp + o_); pv_ = *(const GAS u32x2*)(vp + o_); pl_ = *(const GAS u32x2*)(lp + o_); pa_ = *(const GAS u32x2*)(ap + o_); } while (0)
#define SCAN_PREP(buf_) do { LAS float* B_ = sbuf + (buf_) * VB; \
                    const f32x4 r4 = (f32x4){bf_lo(pr_.x), bf_hi(pr_.x), bf_lo(pr_.y), bf_hi(pr_.y)}, k4 = (f32x4){bf_lo(pk_.x), bf_hi(pk_.x), bf_lo(pk_.y), bf_hi(pk_.y)}; \
                    const f32x4 v4 = (f32x4){bf_lo(pv_.x), bf_hi(pv_.x), bf_lo(pv_.y), bf_hi(pv_.y)}, l4 = (f32x4){bf_lo(pl_.x), bf_hi(pl_.x), bf_lo(pl_.y), bf_hi(pl_.y)}; \
                    const f32x4 a4 = (f32x4){bf_lo(pa_.x), bf_hi(pa_.x), bf_lo(pa_.y), bf_hi(pa_.y)}; \
                    f32x4 kk = k4 * kkw; float n2 = kk[0] * kk[0] + kk[1] * kk[1] + kk[2] * kk[2] + kk[3] * kk[3]; n2 = row16_sum(n2); \
                    const float inv = 1.0f / fmaxf(sqrtf(n2), 1e-12f); kk = kk * inv; f32x4 wv, km; \
                    _Pragma("unroll") for (int q = 0; q < 4; ++q) { wv[q] = __expf(l4[q]); km[q] = k4[q] * (1.0f + (a4[q] - 1.0f) * kaw[q]); } \
                    *(LAS f32x4*)(B_ + pt * 64 + 4 * pc) = -kk; *(LAS f32x4*)(B_ + 2048 + pt * 64 + 4 * pc) = wv; *(LAS f32x4*)(B_ + 4096 + pt * 64 + 4 * pc) = kk * a4; \
                    *(LAS f32x4*)(B_ + 6144 + pt * 64 + 4 * pc) = km; *(LAS f32x4*)(B_ + 8192 + pt * 64 + 4 * pc) = wv * r4; \
                    { const f32x4 bb_ = kk * a4; float br_ = bb_[0] * r4[0] + bb_[1] * r4[1] + bb_[2] * r4[2] + bb_[3] * r4[3], kr_ = km[0] * r4[0] + km[1] * r4[1] + km[2] * r4[2] + km[3] * r4[3]; \
                      br_ = row16_sum(br_); kr_ = row16_sum(kr_); if (pc == 0) *(LAS f32x2*)(B_ + 11264 + 2 * pt) = (f32x2){br_, kr_}; } \
                    if ((pc >> 3) == half) *(LAS f32x4*)(B_ + 10240 + pt * 32 + 4 * (pc & 7)) = v4; } while (0)
                f32x2 s01 = {0.f, 0.f}, s23 = {0.f, 0.f};
                SCAN_LOAD(0); SCAN_PREP(0); SCAN_LOAD(1);
                __syncthreads();
                for (int blk = 0; blk < NBLK; ++blk) {
                    if (blk + 1 < NBLK) SCAN_PREP((blk + 1) & 1);
                    if (blk + 2 < NBLK) SCAN_LOAD(blk + 2);
                    if (blk > 0) *(GAS f32x2*)(yp + (size_t)(blk - 1) * 32 * D) = *(const LAS f32x2*)(syb + ((blk - 1) & 1) * 1024 + pt * 32 + 2 * pc);
                    const LAS float* B_ = sbuf + (blk & 1) * VB + 4 * sc; const LAS float* V_ = sbuf + (blk & 1) * VB + 10240 + srow;
                    LAS float* yb = syb + (blk & 1) * 1024 + srow;
                    const LAS float* C_ = sbuf + (blk & 1) * VB + 11264;
                    f32x4 al = *(const LAS f32x4*)(B_), w4 = *(const LAS f32x4*)(B_ + 2048), be = *(const LAS f32x4*)(B_ + 4096), km = *(const LAS f32x4*)(B_ + 6144), wr4 = *(const LAS f32x4*)(B_ + 8192);
                    float vi = V_[0]; f32x2 sc2 = *(const LAS f32x2*)(C_);
#pragma unroll 8
                    for (int t = 0; t < 32; ++t) {
                        const int tn = (t + 1) & 31;
                        const f32x4 al_n = *(const LAS f32x4*)(B_ + tn * 64), w4_n = *(const LAS f32x4*)(B_ + 2048 + tn * 64), be_n = *(const LAS f32x4*)(B_ + 4096 + tn * 64);
                        const f32x4 km_n = *(const LAS f32x4*)(B_ + 6144 + tn * 64), wr_n = *(const LAS f32x4*)(B_ + 8192 + tn * 64); const float vi_n = V_[tn * 32]; const f32x2 sc2_n = *(const LAS f32x2*)(C_ + 2 * tn);
                        const f32x2 p = s01 * (f32x2){al[0], al[1]} + s23 * (f32x2){al[2], al[3]};
                        const f32x2 q = s01 * (f32x2){wr4[0], wr4[1]} + s23 * (f32x2){wr4[2], wr4[3]};
                        float sa = p.x + p.y, yo = q.x + q.y;
                        sa += dpp_f<0xB1>(sa); yo += dpp_f<0xB1>(yo); sa += dpp_f<0x4E>(sa); yo += dpp_f<0x4E>(yo);
                        sa += dpp_f<0x141>(sa); yo += dpp_f<0x141>(yo); sa += dpp_f<0x140>(sa); yo += dpp_f<0x140>(yo);
                        const f32x2 u01 = (f32x2){be[0], be[1]} * sa + (f32x2){km[0], km[1]} * vi, u23 = (f32x2){be[2], be[3]} * sa + (f32x2){km[2], km[3]} * vi;
                        s01 = s01 * (f32x2){w4[0], w4[1]} + u01; s23 = s23 * (f32x2){w4[2], w4[3]} + u23;
                        const float y = yo + sa * sc2.x + vi * sc2.y;
                        if (sc == 0) yb[t * 32] = y;
                        al = al_n; w4 = w4_n; be = be_n; km = km_n; wr4 = wr_n; vi = vi_n; sc2 = sc2_n;
                    }
                    __syncthreads();
                }
                *(GAS f32x2*)(yp + (size_t)(NBLK - 1) * 32 * D) = *(const LAS f32x2*)(syb + ((NBLK - 1) & 1) * 1024 + pt * 32 + 2 * pc);
                __syncthreads();
#undef SCAN_LOAD
#undef SCAN_PREP
            }
        }
        SEAM(pb + 3);

        for (int rep_ = 0; rep_ <= ((MK_REPEAT >> 4) & 1); ++rep_) if (IN(pb + 4)) {
            PHASE_BASE();
            const int c0 = 16 * lane;
            f32x4 ka[4], rk[4], lw_[4], lb_[4];
#pragma unroll
            for (int q = 0; q < 4; ++q) { ka[q] = *(const GAS f32x4*)(INP(15) + (size_t)j * D + c0 + 4 * q); rk[q] = *(const GAS f32x4*)(INP(16) + (size_t)j * D + c0 + 4 * q);
                lw_[q] = *(const GAS f32x4*)(INP(17) + (size_t)j * D + c0 + 4 * q); lb_[q] = *(const GAS f32x4*)(INP(18) + (size_t)j * D + c0 + 4 * q); }
            for (int tok = gw; tok < M; tok += NGW) {
                const size_t off = (size_t)tok * D + c0;
                f32x4 y[4], r[4], k[4], v[4], a[4], g[4];
#pragma unroll
                for (int q = 0; q < 4; ++q) y[q] = *(const GAS f32x4*)(yraw + off + 4 * q);
                unpack8(*(const GAS u32x4*)(rbuf + off), r[0], r[1]); unpack8(*(const GAS u32x4*)(rbuf + off + 8), r[2], r[3]);
                unpack8(*(const GAS u32x4*)(kbuf + off), k[0], k[1]); unpack8(*(const GAS u32x4*)(kbuf + off + 8), k[2], k[3]);
                unpack8(*(const GAS u32x4*)(vbuf + off), v[0], v[1]); unpack8(*(const GAS u32x4*)(vbuf + off + 8), v[2], v[3]);
                unpack8(*(const GAS u32x4*)(abuf + off), a[0], a[1]); unpack8(*(const GAS u32x4*)(abuf + off + 8), a[2], a[3]);
                unpack8(*(const GAS u32x4*)(gbuf + off), g[0], g[1]); unpack8(*(const GAS u32x4*)(gbuf + off + 8), g[2], g[3]);
                float dot = 0.f, sy = 0.f;
#pragma unroll
                for (int q = 0; q < 4; ++q)
#pragma unroll
                    for (int e = 0; e < 4; ++e) { const float km = k[q][e] * (1.0f + (a[q][e] - 1.0f) * ka[q][e]); dot += r[q][e] * km * rk[q][e]; sy += y[q][e]; }
                dot = quad_sum(dot); sy = quad_sum(sy);
                const float mean = sy * (1.0f / 64.0f); float sq = 0.f;
#pragma unroll
                for (int q = 0; q < 4; ++q)
#pragma unroll
                    for (int e = 0; e < 4; ++e) { const float d = y[q][e] - mean; sq += d * d; }
                sq = quad_sum(sq);
                const float rstd = rsqrtf(sq * (1.0f / 64.0f) + LNX_EPS);
                f32x4 o[4];
#pragma unroll
                for (int q = 0; q < 4; ++q)
#pragma unroll
                    for (int e = 0; e < 4; ++e) o[q][e] = (((y[q][e] - mean) * rstd) * lw_[q][e] + lb_[q][e] + dot * v[q][e]) * g[q][e];
                *(GAS u32x4*)(yg + off) = pack8(o[0], o[1]); *(GAS u32x4*)(yg + off + 8) = pack8(o[2], o[3]);
            }
        }
        SEAM(pb + 4);

        SEAM(pb + 5);
#endif

        for (int rep_ = 0; rep_ <= ((MK_REPEAT >> 5) & 1); ++rep_) if (IN(pb + 6)) {
            PHASE_BASE();
            SchedPlain S{uni_ptr((const GAS char*)yg), uni_ptr((const GAS char*)(wr_ + WR_WO)), (size_t)256 * D * 2, (size_t)256 * D * 2, 64, 4, G, bx};
            EpiRes E{hcur, hcur};
            gemm_phase(lds, tid, D, D, D, S, E);
        }
        SEAM(pb + 6);

        for (int rep_ = 0; rep_ <= ((MK_REPEAT >> 6) & 1); ++rep_) if (IN(pb + 7)) {
            PHASE_BASE();
            const GAS float* gn = INP(2) + (size_t)(2 * j) * D;
            f32x4 gq[4];
#pragma unroll
            for (int q = 0; q < 4; ++q) gq[q] = *(const GAS f32x4*)(gn + 4 * lane + 256 * q);
            u32x2 hwn[4];
#pragma unroll
            for (int q = 0; q < 4; ++q) hwn[q] = *(const GAS u32x2*)(hcur + (size_t)gw * D + 4 * lane + 256 * q);
            for (int tok = gw; tok < M; tok += NGW) {
                f32x4 v[4]; float ss = 0.f; u32x2 hwc[4]; const int tn = (tok + NGW < M) ? tok + NGW : tok;
#pragma unroll
                for (int q = 0; q < 4; ++q) hwc[q] = hwn[q];
#pragma unroll
                for (int q = 0; q < 4; ++q) hwn[q] = *(const GAS u32x2*)(hcur + (size_t)tn * D + 4 * lane + 256 * q);
#pragma unroll
                for (int q = 0; q < 4; ++q) { const u32x2 hw = hwc[q]; v[q] = (f32x4){bf_lo(hw.x), bf_hi(hw.x), bf_lo(hw.y), bf_hi(hw.y)}; ss += v[q][0] * v[q][0] + v[q][1] * v[q][1] + v[q][2] * v[q][2] + v[q][3] * v[q][3]; }
                const float rs = rsqrtf(wave_sum(ss) * (1.0f / D) + NORM_EPS);
#pragma unroll
                for (int q = 0; q < 4; ++q) { const f32x4 o = v[q] * rs * gq[q]; u32x2 w; w.x = cvt_pk_bf16(o[0], o[1]); w.y = cvt_pk_bf16(o[2], o[3]); *(GAS u32x2*)(hn2 + (size_t)tok * D + 4 * lane + 256 * q) = w; }
            }
        }
        SEAM(pb + 7);

        for (int rep_ = 0; rep_ <= ((MK_REPEAT >> 7) & 1); ++rep_) if (IN(pb + 8)) {
            PHASE_BASE();
            SchedPlain S{uni_ptr((const GAS char*)hn2), uni_ptr((const GAS char*)(wr_ + WR_GU)), (size_t)256 * D * 2, (size_t)256 * D * 2, 64, FF / 128, G, bx};
            EpiSwiglu E{hmid, FF};
            gemm_phase(lds, tid, D, D, D, S, E);
        }
        SEAM(pb + 8);

        for (int rep_ = 0; rep_ <= ((MK_REPEAT >> 8) & 1); ++rep_) if (IN(pb + 9)) {
            PHASE_BASE();
            SchedPlain S{uni_ptr((const GAS char*)hmid), uni_ptr((const GAS char*)(wr_ + WR_WD)), (size_t)256 * FF * 2, (size_t)256 * FF * 2, 64, 4, G, bx};
            EpiRes E{hcur, hcur};
            gemm_phase(lds, tid, FF, FF, FF, S, E);
        }
        SEAM(pb + 9);

        for (int rep_ = 0; rep_ <= ((MK_REPEAT >> 9) & 1); ++rep_) if (IN(pb + 10)) {
            PHASE_BASE();
            const GAS float* gn = INP(1) + (size_t)(2 * j + 1) * D;
            f32x4 gq[4];
#pragma unroll
            for (int q = 0; q < 4; ++q) gq[q] = *(const GAS f32x4*)(gn + 16 * lane + 4 * q);
            for (int blk = bx; blk < M / 64; blk += G) {
                u32x4 hn0 = *(const GAS u32x4*)(hcur + (size_t)(blk * 64 + wave * 8) * D + 16 * lane), hn1 = *(const GAS u32x4*)(hcur + (size_t)(blk * 64 + wave * 8) * D + 16 * lane + 8);
                for (int tt = 0; tt < 8; ++tt) { const int tok = blk * 64 + wave * 8 + tt; const int tn = tt < 7 ? tok + 1 : tok;
                    f32x4 v[4]; float ss = 0.f;
                    const u32x4 hc0 = hn0, hc1 = hn1;
                    hn0 = *(const GAS u32x4*)(hcur + (size_t)tn * D + 16 * lane); hn1 = *(const GAS u32x4*)(hcur + (size_t)tn * D + 16 * lane + 8);
                    unpack8(hc0, v[0], v[1]); unpack8(hc1, v[2], v[3]);
#pragma unroll
                    for (int q = 0; q < 4; ++q) { ss += v[q][0] * v[q][0] + v[q][1] * v[q][1] + v[q][2] * v[q][2] + v[q][3] * v[q][3]; }
                    const float rs = rsqrtf(wave_sum(ss) * (1.0f / D) + NORM_EPS);
#pragma unroll
                    for (int q = 0; q < 4; ++q) v[q] = v[q] * rs * gq[q];
                    GAS bf16_t* dst = ug + ((size_t)lane * NBC + (tok >> 5)) * S5K + (tok & 31) * 16;
                    *(GAS u32x4*)dst = pack8(v[0], v[1]); *(GAS u32x4*)(dst + 8) = pack8(v[2], v[3]); } }
        }
        SEAM(pb + 10);

#define WG_REREAD_FENCE() do { asm volatile("s_waitcnt vmcnt(0)" ::: "memory"); __syncthreads(); if (tid == 0) { __builtin_amdgcn_fence(__ATOMIC_ACQUIRE, "agent"); asm volatile("s_waitcnt vmcnt(0)" ::: "memory"); } __syncthreads(); } while (0)
        for (int rep_ = 0; rep_ <= ((MK_REPEAT >> 10) & 1); ++rep_) if (IN(pb + 11)) {
            PHASE_BASE();
            for (int mu = vcu; mu < 256; mu += G) {
                const int g = mu >> 2, pm = (mu >> 1) & 1, pn = mu & 1;
                {   SchedOne S{GUnit{uni_ptr((const GAS char*)ug + (size_t)g * NBC * S5K * 2 + (size_t)pm * 256 * S5K * 2), uni_ptr((const GAS char*)(wss + WSS_M1) + (size_t)g * 256 * 512 * 2), pm, 0, g, 0}};
                    EpiS5E E{eb};
                    gemm_phase(lds, tid, 512, S5K, 512, S, E); }
                WG_REREAD_FENCE();
                if (tid < 256) { const int bq = tid >> 6, p = tid & 63, b = 4 * pm + bq;
                    const float lr = fminf(INP(23)[((size_t)j * 64 + g) * 64 + p], -1e-4f), li = INP(24)[((size_t)j * 64 + g) * 64 + p]; const float dt = __expf(INP(25)[j * 64 + g]);
                    const float mag = expf(32.0f * lr * dt); float rev = 32.0f * (li * dt) * 0.15915494309189535f; rev -= floorf(rev);
                    const float ang = (rev > 0.5f ? rev - 1.0f : rev) * 6.283185307179586f; const float are = mag * cosf(ang), aim = mag * sinf(ang);
                    float hre = 0.f, him = 0.f;
#pragma unroll 1
                    for (int c0 = 0; c0 < 64; c0 += 16) {
                        float ere[16], eim[16];
                        const GAS float* ep = eb + ((size_t)g * NBC + b * 64 + c0) * 128 + p;
#pragma unroll
                        for (int q = 0; q < 16; ++q) { ere[q] = ep[q * 128]; eim[q] = ep[q * 128 + 64]; }
                        GAS bf16_t* dst = ug + ((size_t)g * NBC + b * 64 + c0) * S5K + 512 + p;
#pragma unroll
                        for (int q = 0; q < 16; ++q) {
                            dst[(size_t)q * S5K] = (bf16_t)(cvt_pk_bf16(hre, 0.f) & 0xffffu); dst[(size_t)q * S5K + 64] = (bf16_t)(cvt_pk_bf16(him, 0.f) & 0xffffu);
                            const float nre = are * hre - aim * him + ere[q], nim = are * him + aim * hre + eim[q]; hre = nre; him = nim; }
                    }
                }
                WG_REREAD_FENCE();
                {   SchedOne S{GUnit{uni_ptr((const GAS char*)ug + (size_t)g * NBC * S5K * 2 + (size_t)pm * 256 * S5K * 2), uni_ptr((const GAS char*)(wss + WSS_TOEP) + (size_t)g * 512 * S5K * 2 + (size_t)pn * 256 * S5K * 2), pm, pn, g, 0}};
                    EpiS5Y E{yact, ug, INP(30) + (size_t)j * D};
                    gemm_phase(lds, tid, S5K, S5K, S5K, S, E); }
            }
        }
        SEAM(pb + 11);
#undef WG_REREAD_FENCE

        for (int rep_ = 0; rep_ <= ((MK_REPEAT >> 13) & 1); ++rep_) if (IN(pb + 14)) {
            PHASE_BASE();
            SchedPlain S{uni_ptr((const GAS char*)yact), uni_ptr((const GAS char*)(wss + WSS_GLU)), (size_t)256 * D * 2, (size_t)256 * D * 2, 64, 8, G, bx};
            EpiGlu E{hcur, INP(32) + (size_t)j * 2 * D};
            gemm_phase(lds, tid, D, D, D, S, E);
        }
        SEAM(pb + 14);

        for (int rep_ = 0; rep_ <= ((MK_REPEAT >> 14) & 1); ++rep_) if (IN(pb + 15)) {
            PHASE_BASE();
            LAS float* srt = (LAS float*)lds;
            LAS unsigned* stg = (LAS unsigned*)(srt + 8192);
            {   f32x4 rw[4];
#pragma unroll
                for (int u = 0; u < 4; ++u) rw[u] = *(const GAS f32x4*)(INP(36) + (size_t)j * 8192 + 4 * (tid + NTHREADS * u));
#pragma unroll
                for (int u = 0; u < 4; ++u) { const int i = 4 * (tid + NTHREADS * u);
#pragma unroll
                    for (int z = 0; z < 4; ++z) srt[((i + z) & 7) * 1024 + ((i + z) >> 3)] = rw[u][z]; } }
            const GAS float* gn = INP(2) + (size_t)(2 * j + 1) * D;
            f32x4 gq[4];
#pragma unroll
            for (int q = 0; q < 4; ++q) gq[q] = *(const GAS f32x4*)(gn + 4 * lane + 256 * q);
            __syncthreads();
            for (int blk = bx; blk < M / 64; blk += G) {
                u32x2 hwn[4];
#pragma unroll
                for (int q = 0; q < 4; ++q) hwn[q] = *(const GAS u32x2*)(hcur + (size_t)(blk * 64 + wave * 8) * D + 4 * lane + 256 * q);
                for (int tt = 0; tt < 8; ++tt) { const int tok = blk * 64 + wave * 8 + tt; const int tn = tt < 7 ? tok + 1 : tok;
                    f32x4 v[4]; float ss = 0.f; u32x2 hwc[4];
#pragma unroll
                    for (int q = 0; q < 4; ++q) hwc[q] = hwn[q];
#pragma unroll
                    for (int q = 0; q < 4; ++q) hwn[q] = *(const GAS u32x2*)(hcur + (size_t)tn * D + 4 * lane + 256 * q);
#pragma unroll
                    for (int q = 0; q < 4; ++q) { const u32x2 hw = hwc[q]; v[q] = (f32x4){bf_lo(hw.x), bf_hi(hw.x), bf_lo(hw.y), bf_hi(hw.y)}; ss += v[q][0] * v[q][0] + v[q][1] * v[q][1] + v[q][2] * v[q][2] + v[q][3] * v[q][3]; }
                    const float rs = rsqrtf(wave_sum(ss) * (1.0f / D) + NORM_EPS);
                    float lg[8];
#pragma unroll
                    for (int e = 0; e < 8; ++e) lg[e] = 0.f;
#pragma unroll
                    for (int q = 0; q < 4; ++q) { const f32x4 o = v[q] * rs * gq[q]; u32x2 w; w.x = cvt_pk_bf16(o[0], o[1]); w.y = cvt_pk_bf16(o[2], o[3]); *(GAS u32x2*)(hn2 + (size_t)tok * D + 4 * lane + 256 * q) = w;
#pragma unroll
                        for (int e = 0; e < 8; ++e) { const f32x4 rr = *(const LAS f32x4*)(srt + e * 1024 + 4 * lane + 256 * q);
                            lg[e] += o[0] * rr[0]; lg[e] += o[1] * rr[1]; lg[e] += o[2] * rr[2]; lg[e] += o[3] * rr[3]; } }
#pragma unroll
                    for (int e = 0; e < 8; ++e) lg[e] = wave_sum(lg[e]);
                    int e0 = 0; float v0 = lg[0];
#pragma unroll
                    for (int e = 1; e < 8; ++e) if (lg[e] > v0) { v0 = lg[e]; e0 = e; }
                    int e1 = -1; float v1 = -3.0e38f;
#pragma unroll
                    for (int e = 0; e < 8; ++e) if (e != e0 && lg[e] > v1) { v1 = lg[e]; e1 = e; }
                    const float g0 = 1.0f / (1.0f + expf(v1 - v0)), g1 = 1.0f - g0;
                    if (lane == 0) { const int lt = wave * 8 + tt; stg[lt * 4 + 0] = (unsigned)e0; stg[lt * 4 + 1] = (unsigned)e1; stg[lt * 4 + 2] = __float_as_uint(g0); stg[lt * 4 + 3] = __float_as_uint(g1); }
                }
                __syncthreads();
                if (wave == 0) { const int tok = blk * 64 + lane;
                    const int e0 = (int)stg[lane * 4 + 0], e1 = (int)stg[lane * 4 + 1]; const float g0 = __uint_as_float(stg[lane * 4 + 2]), g1 = __uint_as_float(stg[lane * 4 + 3]);
                    const unsigned long long lt_mask = (lane == 0) ? 0ull : (~0ull >> (64 - lane));
                    unsigned pos0 = 0, pos1 = 0;
#pragma unroll
                    for (int e = 0; e < 8; ++e) { const unsigned long long m0 = __ballot(e0 == e), m1 = __ballot(e1 == e); const unsigned n0 = (unsigned)__popcll(m0), n1 = (unsigned)__popcll(m1);
                        if (lane == 0) blkcnt[blk * 8 + e] = n0 + n1;
                        if (e0 == e) pos0 = (unsigned)__popcll(m0 & lt_mask);
                        if (e1 == e) pos1 = n0 + (unsigned)__popcll(m1 & lt_mask); }
                    asg_pe[2 * tok] = ((unsigned)e0 << 24) | pos0; asg_pe[2 * tok + 1] = ((unsigned)e1 << 24) | pos1; asg_gate[2 * tok] = g0; asg_gate[2 * tok + 1] = g1; }
                __syncthreads();
            }
        }
        SEAM(pb + 15);

        if (IN(pb + 16) || IN(pb + 17) || IN(pb + 18)) {
            PHASE_BASE();
            LAS unsigned* sbase = (LAS unsigned*)(lds + 65536);
            { const int e = wave; unsigned c[4]; unsigned tot = 0;
#pragma unroll
              for (int i = 0; i < 4; ++i) { c[i] = blkcnt[(4 * lane + i) * 8 + e]; }
              unsigned run = c[0] + c[1] + c[2] + c[3], incl = run;
#pragma unroll
              for (int o = 1; o < 64; o <<= 1) { const unsigned t_ = (unsigned)__builtin_amdgcn_ds_bpermute(4 * (lane - o), (int)incl); if (lane >= o) incl += t_; }
              unsigned ex = incl - run;
#pragma unroll
              for (int i = 0; i < 4; ++i) { sbase[(4 * lane + i) * 8 + e] = ex; ex += c[i]; }
              tot = (unsigned)__builtin_amdgcn_readlane((int)incl, 63);
              if (lane == 0) MISC[32 + e] = tot; }
            __syncthreads();
            if (tid == 0) { unsigned acc_ = 0; MISC[16] = 0u;
                for (int e = 0; e < 8; ++e) { const unsigned c = MISC[32 + e]; acc_ += (c + 255u) >> 8; MISC[17 + e] = acc_; } }
            __syncthreads();
        }
        for (int rep_ = 0; rep_ <= ((MK_REPEAT >> 15) & 1); ++rep_) if (IN(pb + 16)) {
            PHASE_BASE();
            unsigned cnt[8], pst[8];
#pragma unroll
            for (int e = 0; e < 8; ++e) { cnt[e] = MISC[32 + e]; pst[e] = MISC[16 + e] * 256u; }
            const LAS unsigned* sbase = (const LAS unsigned*)(lds + 65536);
            for (int a = gw * 64 + lane; a < NASG; a += NGW * 64) { const unsigned pe = asg_pe[a]; const int e = (int)(pe >> 24); const unsigned pos = pe & 0xffffffu;
                unsigned ps = 0;
#pragma unroll
                for (int q = 0; q < 8; ++q) ps = (q == e) ? pst[q] : ps;
                const int tok = a >> 1; const unsigned row = ps + sbase[(tok >> 6) * 8 + e] + pos;
                rowslot[row] = a; rowgate[row] = asg_gate[a]; rowtok[row] = tok; ((GAS int*)(wsl + WS_TROW))[a] = ((int)row >= MOE_TAIL_ROW0) ? (int)row - MOE_TAIL_ROW0 : -1; }
            if (bx < 8) {
#pragma unroll
                for (int e = 0; e < 8; ++e) if (e == bx) { const unsigned padded = ((cnt[e] + 255u) >> 8) << 8;
                    for (unsigned r = cnt[e] + tid; r < padded; r += NTHREADS) { rowslot[pst[e] + r] = -1; rowgate[pst[e] + r] = 0.f; rowtok[pst[e] + r] = 0; } }
            }
        }
        SEAM(pb + 16);

        for (int rep_ = 0; rep_ <= ((MK_REPEAT >> 16) & 1); ++rep_) if (IN(pb + 17)) {
            PHASE_BASE();
            SchedMoeG S{uni_ptr((const GAS char*)hn2), uni_ptr((const GAS char*)(wsl + WS_WM + WM_GU)), (size_t)2 * FE * D * 2, (size_t)256 * D * 2, FE / 128, G, bx, MISC + 16, rowtok};
#if MK_EPISKIP
            EpiSwiglu E{hmidm, FE, rep_};
#else
            EpiSwiglu E{hmidm, FE};
#endif
#if MK_STAMP && MK_STAMP != 6
            if (j == 0 && tid == 0) MISC[40] = 1u;
            __syncthreads();
#endif
            gemm_phase(lds, tid, D, D, D, S, E);
#if MK_STAMP
            __syncthreads();
            if (tid == 0) MISC[40] = 0u;
#endif
        }
        SEAM(pb + 17);

        for (int rep_ = 0; rep_ <= ((MK_REPEAT >> 17) & 1); ++rep_) if (IN(pb + 18)) {
            PHASE_BASE();
            EpiMoeDown E{y2, rowslot, rowgate, (GAS bf16_t*)(wsl + WS_Y2T)};
            {   SchedMoeMain S{uni_ptr((const GAS char*)hmidm), uni_ptr((const GAS char*)(wsl + WS_WM + WM_WD)), (size_t)256 * FE * 2, (size_t)D * FE * 2, (size_t)256 * FE * 2, 4, G, bx, MISC + 16};
                gemm_phase(lds, tid, FE, FE, FE, S, E); }
            {   SchedMoeTail S{uni_ptr((const GAS char*)hmidm), uni_ptr((const GAS char*)(wsl + WS_WM + WM_WD)), (size_t)256 * FE * 2, (size_t)D * FE * 2, (size_t)256 * FE * 2, (size_t)(FE / 4) * 2, G, vcu, MISC + 16};
                gemm_phase(lds, tid, FE / 4, FE, FE, S, E); }
        }
        SEAM(pb + 18);
    }

    if (MK_N_LAUNCHES == 1 && hi < NPH - 1) xcd_barrier(bar);
#if MK_PROBE_SRC >= 2
    if (IN(NPH - 1)) {
        PHASE_BASE();
        for (int tok = gw; tok < M; tok += NGW) {
#pragma unroll
            for (int q = 0; q < 4; ++q) { f32x4 x;
                if (MK_PROBE_SRC == 2) { const u32x2 w = *(const GAS u32x2*)((const GAS bf16_t*)(ar + MK_PROBE_OFF) + (size_t)tok * D + 4 * lane + 256 * q); x = (f32x4){bf_lo(w.x), bf_hi(w.x), bf_lo(w.y), bf_hi(w.y)}; }
                else if (MK_PROBE_SRC == 5) { x = *(const GAS f32x4*)(INP(MK_PROBE_INP) + 4 * lane + 256 * q); }
                else if (MK_PROBE_SRC == 4) { x = (f32x4){0.f, 0.f, 0.f, 0.f}; const size_t offs[5] = {AR_R, AR_K, (size_t)WS_VF - (size_t)WS_AR, AR_A, AR_G};
#pragma unroll
                    for (int z = 0; z < 5; ++z) { const u32x2 w = *(const GAS u32x2*)((const GAS bf16_t*)(ar + offs[z]) + (size_t)tok * D + 4 * lane + 256 * q); x += (f32x4){bf_lo(w.x), bf_hi(w.x), bf_lo(w.y), bf_hi(w.y)}; } }
                else x = *(const GAS f32x4*)((const GAS float*)(ar + MK_PROBE_OFF) + (size_t)tok * D + 4 * lane + 256 * q);
                *(GAS f32x4*)((GAS float*)args.out + (size_t)tok * D + 4 * lane + 256 * q) = x; }
        }
    }
#else
    if (IN(NPH - 1)) {
        PHASE_BASE();
        f32x4 gq[4];
#pragma unroll
        for (int q = 0; q < 4; ++q) gq[q] = *(const GAS f32x4*)(INP(3) + 4 * lane + 256 * q);
        u32x2 hwn[4], yan[4], ybn[4];
#pragma unroll
        for (int q = 0; q < 4; ++q) { hwn[q] = *(const GAS u32x2*)((MK_PROBE_SRC ? hbuf1 : hbuf0) + (size_t)gw * D + 4 * lane + 256 * q);
            yan[q] = *(const GAS u32x2*)(y2 + (size_t)(2 * gw) * D + 4 * lane + 256 * q); ybn[q] = *(const GAS u32x2*)(y2 + (size_t)(2 * gw + 1) * D + 4 * lane + 256 * q); }
        for (int tok = gw; tok < M; tok += NGW) {
            f32x4 v[4]; float ss = 0.f; u32x2 hwc[4], yac[4], ybc[4]; const int tn = (tok + NGW < M) ? tok + NGW : tok;
#pragma unroll
            for (int q = 0; q < 4; ++q) { hwc[q] = hwn[q]; yac[q] = yan[q]; ybc[q] = ybn[q]; }
#pragma unroll
            for (int q = 0; q < 4; ++q) { hwn[q] = *(const GAS u32x2*)((MK_PROBE_SRC ? hbuf1 : hbuf0) + (size_t)tn * D + 4 * lane + 256 * q);
                yan[q] = *(const GAS u32x2*)(y2 + (size_t)(2 * tn) * D + 4 * lane + 256 * q); ybn[q] = *(const GAS u32x2*)(y2 + (size_t)(2 * tn + 1) * D + 4 * lane + 256 * q); }
#pragma unroll
            for (int q = 0; q < 4; ++q) { const u32x2 hw = hwc[q];
                f32x4 x = (f32x4){bf_lo(hw.x), bf_hi(hw.x), bf_lo(hw.y), bf_hi(hw.y)};
                if (MK_PROBE_Y2) { const u32x2 ya = yac[q], yb = ybc[q];
                x[0] += bf_lo(ya.x) + bf_lo(yb.x); x[1] += bf_hi(ya.x) + bf_hi(yb.x); x[2] += bf_lo(ya.y) + bf_lo(yb.y); x[3] += bf_hi(ya.y) + bf_hi(yb.y);
                Y2T_ADD(x, tok, q); }
                v[q] = x; ss += x[0] * x[0] + x[1] * x[1] + x[2] * x[2] + x[3] * x[3]; }
            const float rs = rsqrtf(wave_sum(ss) * (1.0f / D) + NORM_EPS);
#pragma unroll
            for (int q = 0; q < 4; ++q) *(GAS f32x4*)((GAS float*)args.out + (size_t)tok * D + 4 * lane + 256 * q) = v[q] * rs * gq[q];
        }
    }
#endif
#if MK_STAMP
    if (bx0 == 0 && tid0 == 0) {
        volatile LAS unsigned long long* st_ = (volatile LAS unsigned long long*)(lds + MISC_OFF + 256);
        const unsigned long long c0 = st_[0], r0 = st_[1], c1 = st_[2], r1 = st_[3], c2 = st_[4], r2 = st_[5], c3 = st_[6], r3 = st_[7];
        unsigned long long us_ = 0;
        if (MK_STAMP == 1) us_ = (c1 - c0) / 16;
        if (MK_STAMP == 2) us_ = (r1 - r0) * 10 / 16;
        if (MK_STAMP == 3) us_ = (r3 - r0) / 20;
        if (MK_STAMP == 4) us_ = (r2 - r1) * 10 / 2;
        if (MK_STAMP == 5 || MK_STAMP == 6) us_ = (c3 - c0) * 100 / (r3 - r0);
        (void)c2;
        if (us_ > 6000) us_ = 6000;
        const unsigned long long t0_ = __builtin_amdgcn_s_memrealtime();
        while (__builtin_amdgcn_s_memrealtime() - t0_ < us_ * 100) __builtin_amdgcn_s_sleep(16);
    }
#endif
#undef IN
#undef SEAM
#undef hbuf0
#undef vfirst
#undef y2
#undef wr_
#undef wss
#undef hin_l
#undef hcur
#undef xs
#undef rbuf
#undef kbuf
#undef vbuf
#undef l1
#undef lwbuf
#undef abuf
#undef gbuf
#undef yraw
#undef yg
#undef hn2
#undef hmid
#undef ug
#undef eb
#undef yact
#undef asg_pe
#undef asg_gate
#undef xsm
#undef rowslot
#undef rowgate
#undef hmidm
#undef blkcnt
#undef rowtok
#undef INP
#undef PHASE_BASE
}

extern "C" void kernel_launch(void* const* d_in, const int* in_sizes, int n_in, void* d_out, int out_size, void* d_ws, size_t ws_size, hipStream_t stream) {
    static int grid = 0;
    if (grid == 0) {
        if (n_in != 40 || out_size != M * D || ws_size < WS_END) { fprintf(stderr, "kernel_launch: unexpected shapes (n_in %d, out %d, ws %zu < %zu)\n", n_in, out_size, ws_size, (size_t)WS_END); grid = -1; return; }
        int dev = 0, cus = 0, per_cu = 0;
        if (hipGetDevice(&dev) != hipSuccess || hipDeviceGetAttribute(&cus, hipDeviceAttributeMultiprocessorCount, dev) != hipSuccess) { grid = -1; return; }
        if (hipFuncSetAttribute((const void*)mk_fwd, hipFuncAttributeMaxDynamicSharedMemorySize, LDS_BYTES) != hipSuccess) { fprintf(stderr, "kernel_launch: hipFuncSetAttribute failed\n"); grid = -1; return; }
        if (hipOccupancyMaxActiveBlocksPerMultiprocessor(&per_cu, (const void*)mk_fwd, NTHREADS, LDS_BYTES) != hipSuccess || per_cu < 1) fprintf(stderr, "kernel_launch: occupancy query says %d\n", per_cu);
        (void)hipGetLastError();
        grid = cus;
    }
    if (grid < 0) return;
    (void)in_sizes;
#ifdef MK_ZERO_WS
    if (hipMemsetAsync((char*)d_ws, 0, WS_END, stream) != hipSuccess) return;
    if (hipMemsetAsync((char*)d_out, 0, (size_t)M * D * 4, stream) != hipSuccess) return;
#endif
    if (hipMemsetAsync((char*)d_ws + WS_CTL, 0, CTL_BYTES, stream) != hipSuccess) return;
    Args a{};
    for (int i = 0; i < 40; ++i) a.in[i] = (const float*)d_in[i];
    a.out = (float*)d_out; a.ws = (unsigned char*)d_ws;
#if MK_N_LAUNCHES == 1
    a.ph_lo = 0; a.ph_hi = (MK_STOP_AFTER + 1 < NPH - 1) ? MK_STOP_AFTER + 1 : NPH;
    hipLaunchKernelGGL(mk_fwd, dim3(grid), dim3(NTHREADS), LDS_BYTES, stream, a);
#else
    for (int p = 0; p < NPH; ++p) { if (p > MK_STOP_AFTER && p != NPH - 1) continue; a.ph_lo = p; a.ph_hi = p + 1; hipLaunchKernelGGL(mk_fwd, dim3(grid), dim3(NTHREADS), LDS_BYTES, stream, a); }
#endif
}
```

```cpp
#include <hip/hip_runtime.h>
#include <cstdio>
#include <cstdint>

#ifndef MK_STOP_AFTER
#define MK_STOP_AFTER 38
#define MK_PROBE_SRC 1
#define MK_PROBE_Y2 1
#define MK_PROBE_OFF ((size_t)(WS_WR + WR_L2) - (size_t)WS_AR)
#define MK_PROBE_INP 9
#endif
#ifndef MK_CHUNKED
#define MK_CHUNKED 1
#endif
#ifndef MK_EPISKIP
#define MK_EPISKIP 0
#endif
#ifndef MK_STAMP
#define MK_STAMP 0
#endif
#ifndef MK_REPEAT
#define MK_REPEAT 0
#endif
#ifndef MK_N_LAUNCHES
#define MK_N_LAUNCHES 1
#endif

#define LAS __attribute__((address_space(3)))
#define GAS __attribute__((address_space(1)))
typedef unsigned short bf16_t;
typedef short bf16x8 __attribute__((ext_vector_type(8)));
typedef float f32x4 __attribute__((ext_vector_type(4)));
typedef float f32x2 __attribute__((ext_vector_type(2)));
typedef unsigned u32x4 __attribute__((ext_vector_type(4)));
typedef unsigned u32x2 __attribute__((ext_vector_type(2)));

constexpr int M = 16384, D = 1024, T = 2048, NH = 16, HD = 64;
constexpr int FF = 2816, FE = 3584, NEXP = 8, NASG = 2 * M, CAP = NASG + NEXP * 256;
constexpr int S5L = 32, NBC = M / S5L, S5K = 640;
constexpr float NORM_EPS = 1e-6f, LNX_EPS = 64e-5f;
constexpr int NTHREADS = 512, NWAVES = 8;

constexpr size_t MiB = (size_t)1 << 20;
constexpr size_t WS_CTL = 0, CTL_BYTES = 1 * MiB;
constexpr size_t WS_WR = 1 * MiB, WR_STRIDE = 29 * MiB;
constexpr size_t WR_RKV = 0, WR_L1 = 6 * MiB, WR_L2 = 8 * MiB, WR_WO = 10 * MiB, WR_GU = 12 * MiB, WR_WD = 23 * MiB;
constexpr size_t WS_WS = 59 * MiB, WSS_STRIDE = 60 * MiB;
constexpr size_t WSS_GLU = 0, WSS_TOEP = 4 * MiB, WSS_M1 = 44 * MiB;
constexpr size_t WS_WM = 179 * MiB, WM_GU = 0, WM_WD = 112 * MiB;
constexpr size_t WS_H0 = 347 * MiB, WS_VF = 411 * MiB, WS_Y2 = 443 * MiB, WS_AR = 507 * MiB, WS_Y2T = 847 * MiB, WS_TROW = 859 * MiB, WS_END = 860 * MiB;
constexpr size_t AR_XS = 0, AR_R = 192 * MiB, AR_K = 224 * MiB, AR_V = 256 * MiB, AR_L1 = 288 * MiB;
constexpr size_t AR_LW = 0, AR_A = 32 * MiB, AR_G = 64 * MiB, AR_YRAW = 96 * MiB, AR_YG = 160 * MiB;
constexpr size_t AR_HN2 = 0, AR_HMID = 32 * MiB;
constexpr size_t AR_UG = 0, AR_EB = 40 * MiB, AR_YACT = 56 * MiB;
constexpr size_t AR_ASG = 32 * MiB, AR_XSM = 33 * MiB, AR_ROWM = 101 * MiB, AR_HMIDM = 102 * MiB;
static_assert(AR_HMIDM + (size_t)CAP * FE * 2 <= WS_Y2T - WS_AR, "arena");
constexpr int MOE_MAIN_TILES = 128, MOE_TAIL_ROW0 = MOE_MAIN_TILES * 256;
static_assert(WR_WD + (size_t)D * FF * 2 <= WR_STRIDE, "wr");
constexpr int CW_BAR = 4096;
constexpr int CW_MOECNT = 16384;
constexpr int RING_BYTES = 131072, LDSCTL_OFF = RING_BYTES, MISC_OFF = LDSCTL_OFF + 320, PTAB_OFF = LDSCTL_OFF + 1024, LDS_BYTES = 147456;

constexpr int NPH = 40;

#define VM_WAIT() asm volatile("s_waitcnt vmcnt(0)" ::: "memory")
typedef __bf16 bf16x2_n __attribute__((ext_vector_type(2)));
__device__ __forceinline__ unsigned cvt_pk_bf16(float lo, float hi) { const f32x2 v = {lo, hi}; return __builtin_bit_cast(unsigned, __builtin_convertvector(v, bf16x2_n)); }
__device__ __forceinline__ float bf_lo(unsigned u) { return __uint_as_float(u << 16); }
__device__ __forceinline__ float bf_hi(unsigned u) { return __uint_as_float(u & 0xffff0000u); }
__device__ __forceinline__ float fsigmoid(float x) { return __builtin_amdgcn_rcpf(1.0f + __expf(-x)); }
__device__ __forceinline__ float ftanh(float x) { return 1.0f - 2.0f * __builtin_amdgcn_rcpf(__expf(2.0f * x) + 1.0f); }
__device__ __forceinline__ float fgelu(float x) { const float u = 0.7978845608f * (x + 0.044715f * x * x * x); return x * fsigmoid(2.0f * u); }
template <int CTRL> __device__ __forceinline__ float dpp_f(float x) { return __int_as_float(__builtin_amdgcn_update_dpp(0, __float_as_int(x), CTRL, 0xf, 0xf, true)); }
__device__ __forceinline__ float quad_sum(float x) { x += dpp_f<0xB1>(x); x += dpp_f<0x4E>(x); return x; }
__device__ __forceinline__ float row16_sum(float x) { x = quad_sum(x); x += dpp_f<0x141>(x); x += dpp_f<0x140>(x); return x; }
__device__ __forceinline__ float wave_sum(float v) {
    v = row16_sum(v);
    const float a = __int_as_float(__builtin_amdgcn_readlane(__float_as_int(v), 0)), b = __int_as_float(__builtin_amdgcn_readlane(__float_as_int(v), 16));
    const float c = __int_as_float(__builtin_amdgcn_readlane(__float_as_int(v), 32)), d = __int_as_float(__builtin_amdgcn_readlane(__float_as_int(v), 48));
    return (a + b) + (c + d);
}
__device__ __forceinline__ u32x4 pack8(const f32x4 a, const f32x4 b) { u32x4 w; w.x = cvt_pk_bf16(a[0], a[1]); w.y = cvt_pk_bf16(a[2], a[3]); w.z = cvt_pk_bf16(b[0], b[1]); w.w = cvt_pk_bf16(b[2], b[3]); return w; }
__device__ __forceinline__ void unpack8(const u32x4 w, f32x4& a, f32x4& b) { a = (f32x4){bf_lo(w.x), bf_hi(w.x), bf_lo(w.y), bf_hi(w.y)}; b = (f32x4){bf_lo(w.z), bf_hi(w.z), bf_lo(w.w), bf_hi(w.w)}; }

__device__ __forceinline__ const GAS float* inp_ptr(LAS unsigned long long* tab, int i) {
    const unsigned long long v = tab[i]; const unsigned lo = (unsigned)__builtin_amdgcn_readfirstlane((int)(unsigned)v), hi = (unsigned)__builtin_amdgcn_readfirstlane((int)(unsigned)(v >> 32));
    return (const GAS float*)(((unsigned long long)hi << 32) | lo);
}
#define XB_TMO      128
#define XB_XCNT(j)  (256  + 64 * (j))
#define XB_XSUB(j)  (1280 + 64 * (j))
#define XB_XGEN(j)  (2304 + 64 * (j))
#define XB_TOP      3328
#define XB_TOPGEN   3392
#define XCD_BAR_WORDS 3456
#define XB_SPIN_CAP (1u << 18)
__device__ __forceinline__ unsigned xb_ld(unsigned* p)              { return __hip_atomic_load(p, __ATOMIC_RELAXED, __HIP_MEMORY_SCOPE_AGENT); }
__device__ __forceinline__ unsigned xb_add(unsigned* p, unsigned v) { return __hip_atomic_fetch_add(p, v, __ATOMIC_RELAXED, __HIP_MEMORY_SCOPE_AGENT); }
__device__ __forceinline__ unsigned xb_xcc_id() { return (unsigned)__builtin_amdgcn_s_getreg((3 << 11) | 20) & 0xFu; }
#define XB_SPIN(cond, bar) do { unsigned _sp = 0; while (cond) { __builtin_amdgcn_s_sleep(1); \
    if ((++_sp & 255u) == 0u) { if (xb_ld(&(bar)[XB_TMO])) break; if (_sp > XB_SPIN_CAP) { atomicAdd(&(bar)[XB_TMO], 1u); break; } } } } while (0)
struct XcdBarrier { unsigned* bar; unsigned x; volatile LAS unsigned* st; };
__device__ __forceinline__ XcdBarrier xcd_barrier_post(unsigned* bar, volatile LAS unsigned* st) {
    XcdBarrier b; b.bar = bar; b.x = xb_xcc_id(); b.st = st;
    if (threadIdx.x == 0) (void)xb_add(&bar[XB_XCNT(b.x)], 1u);
    return b;
}
__device__ __forceinline__ void xcd_barrier_complete(unsigned* bar, unsigned x, unsigned& nloc, unsigned& nx) {
    const unsigned G = gridDim.x * gridDim.y * gridDim.z;
    unsigned sum, cnt, mine, sp = 0u;
    for (;;) {
        sum = 0u; cnt = 0u; mine = 0u;
#pragma unroll
        for (unsigned j = 0; j < 16; ++j) { const unsigned c = xb_ld(&bar[XB_XCNT(j)]); sum += c; cnt += (c > 0u) ? 1u : 0u; mine = (j == x) ? c : mine; }
        if (sum == G) break;
        __builtin_amdgcn_s_sleep(1);
        if ((++sp & 255u) == 0u) { if (xb_ld(&bar[XB_TMO])) break; if (sp > XB_SPIN_CAP) { atomicAdd(&bar[XB_TMO], 1u); break; } }
    }
    nloc = mine > 0u ? mine : 1u; nx = cnt > 0u ? cnt : 1u;
}
__device__ __forceinline__ void xcd_barrier(const XcdBarrier& b) {
    asm volatile("s_waitcnt vmcnt(0)" ::: "memory");
    __syncthreads();
    if (threadIdx.x == 0) {
        unsigned* bar = b.bar;
        __builtin_amdgcn_s_waitcnt(0);
        unsigned nloc = b.st[0], nx = b.st[1];
        if (nloc == 0u) { xcd_barrier_complete(bar, b.x, nloc, nx); b.st[0] = nloc; b.st[1] = nx; }
        const unsigned old = xb_add(&bar[XB_XSUB(b.x)], 1u);
        const unsigned gen = old / nloc;
        if (old + 1u == (gen + 1u) * nloc) {
            __builtin_amdgcn_fence(__ATOMIC_RELEASE, "agent");
            asm volatile("s_waitcnt vmcnt(0)" ::: "memory");
            const unsigned og = xb_add(&bar[XB_TOP], 1u);
            const unsigned tg = og / nx;
            if (og + 1u == (tg + 1u) * nx) xb_add(&bar[XB_TOPGEN], 1u);
            else XB_SPIN(xb_ld(&bar[XB_TOPGEN]) == tg, bar);
            __builtin_amdgcn_fence(__ATOMIC_ACQUIRE, "agent");
            xb_add(&bar[XB_XGEN(b.x)], 1u);
            asm volatile("s_waitcnt vmcnt(0)" ::: "memory");
        } else {
            XB_SPIN(xb_ld(&bar[XB_XGEN(b.x)]) == gen, bar);
            __builtin_amdgcn_fence(__ATOMIC_ACQUIRE, "agent");
            asm volatile("s_waitcnt vmcnt(0)" ::: "memory");
        }
    }
    __syncthreads();
}

struct GUnit { const GAS char* A; const GAS char* B; int pm, pn, kind, pad; };
__device__ __forceinline__ int perm32(int rho) { const int n = rho >> 4, i = rho & 15; return 8 * (i >> 2) + 4 * n + (i & 3); }
__device__ __forceinline__ int fdiv(int a, int b) {
    int q = (int)((float)a * __builtin_amdgcn_rcpf((float)b)); const int r = a - q * b; q += (r >= b) ? 1 : 0; q -= (r < 0) ? 1 : 0; return q;
}
__device__ __forceinline__ void tile_order(int L, int nM, int nN, int& pm, int& pn) {
    const int nwg = nM * nN; int wgid = L;
    { const int q = nwg >> 3, r = nwg & 7, xcd = wgid & 7, off = wgid >> 3; wgid = (xcd < r ? xcd * (q + 1) : r * (q + 1) + (xcd - r) * q) + off; }
    const int nig = 8 * nN, gid = fdiv(wgid, nig), rem = wgid - gid * nig, fm = gid * 8, gsz = (nM - fm) < 8 ? (nM - fm) : 8;
    pn = fdiv(rem, gsz); pm = fm + rem - pn * gsz;
}

template <class Epi, class Sched>
__device__ __forceinline__ void gemm_phase_simple(LAS unsigned char* lds, int K, int lda, int ldb, const Sched& S, const Epi& E) {
    (void)lds;
    const int tid = threadIdx.x, wid = __builtin_amdgcn_readfirstlane(tid >> 6), lane = tid & 63, wr = wid >> 2, wc = wid & 3, fr = lane & 15, fq = lane >> 4;
    for (int ui = 0;; ++ui) {
        GUnit u; if (!S.next(ui, u)) break;
        f32x4 acc[2][2][4][2];
#pragma unroll
        for (int a = 0; a < 2; ++a)
#pragma unroll
            for (int b = 0; b < 2; ++b)
#pragma unroll
                for (int m = 0; m < 4; ++m)
#pragma unroll
                    for (int n = 0; n < 2; ++n) acc[a][b][m][n] = (f32x4){0.f, 0.f, 0.f, 0.f};
        const GAS char* Ap = u.A + ((size_t)(wr * 64 + fr) * lda + fq * 8) * 2;
        const GAS char* Bp0 = u.B + ((size_t)(wc * 32 + perm32(fr)) * ldb + fq * 8) * 2;
        const GAS char* Bp1 = u.B + ((size_t)(wc * 32 + perm32(16 + fr)) * ldb + fq * 8) * 2;
#pragma unroll 1
        for (int k0 = 0; k0 < K; k0 += 32) {
            bf16x8 a[2][4], b[2][2];
#pragma unroll
            for (int ai = 0; ai < 2; ++ai)
#pragma unroll
                for (int m = 0; m < 4; ++m) a[ai][m] = *(const GAS bf16x8*)(Ap + ((size_t)(ai * 128 + m * 16) * lda + k0) * 2);
#pragma unroll
            for (int bj = 0; bj < 2; ++bj) { b[bj][0] = *(const GAS bf16x8*)(Bp0 + ((size_t)(bj * 128) * ldb + k0) * 2); b[bj][1] = *(const GAS bf16x8*)(Bp1 + ((size_t)(bj * 128) * ldb + k0) * 2); }
#pragma unroll
            for (int ai = 0; ai < 2; ++ai)
#pragma unroll
                for (int bj = 0; bj < 2; ++bj)
#pragma unroll
                    for (int m = 0; m < 4; ++m)
#pragma unroll
                        for (int n = 0; n < 2; ++n) acc[ai][bj][m][n] = __builtin_amdgcn_mfma_f32_16x16x32_bf16(b[bj][n], a[ai][m], acc[ai][bj][m][n], 0, 0, 0);
        }
        E(acc, u, wr, wc, fr, fq);
    }
}

constexpr int HTB = 128 * 64 * 2;
__device__ __forceinline__ int lds_byte(int r, int c) { const int st = (r >> 4) * 2 + (c >> 5), rr = r & 15, cc = c & 31, ob = rr * 64 + cc * 2; return st * 1024 + (ob ^ (((ob >> 9) & 1) << 5)); }
__device__ __forceinline__ void stage_rc(int b, int& R, int& C) { const int st = b / 1024, sb = b % 1024, swz = sb ^ (((sb >> 9) & 1) << 5); R = (st >> 1) * 16 + swz / 64; C = (st & 1) * 32 + (swz % 64) / 2; }
template <class S> struct sched_gather { static constexpr bool value = false; };
__device__ __forceinline__ const GAS char* uni_ptr(const GAS char* p) {
    const unsigned long long v = (unsigned long long)p; const unsigned lo = (unsigned)__builtin_amdgcn_readfirstlane((int)(unsigned)v), hi = (unsigned)__builtin_amdgcn_readfirstlane((int)(unsigned)(v >> 32));
    return (const GAS char*)(((unsigned long long)hi << 32) | lo);
}
#if MK_STAMP
#define STAMP_AT(slot_, cond_) do { if (tid == 0 && (cond_) && ((volatile LAS unsigned*)(lds + MISC_OFF))[40]) { \
        ((volatile LAS unsigned long long*)(lds + MISC_OFF + 256))[2 * (slot_)] = __builtin_amdgcn_s_memtime(); ((volatile LAS unsigned long long*)(lds + MISC_OFF + 256))[2 * (slot_) + 1] = __builtin_amdgcn_s_memrealtime(); } } while (0)
#else
#define STAMP_AT(slot_, cond_) do { } while (0)
#endif
template <class Epi, class Sched>
__device__ __forceinline__ void gemm_phase(LAS unsigned char* lds, int tid, int K, int lda, int ldb, const Sched& S, const Epi& E) {
    const int wid = __builtin_amdgcn_readfirstlane(tid >> 6), lane = tid & 63, wr = wid >> 2, wc = wid & 3, fr = lane & 15, fq = lane >> 4;
    const int nt = K / 64;
    constexpr bool GA = sched_gather<Sched>::value;
    unsigned voffA[2], voffB[2];
    unsigned voA[2][2], voN[2][2];
#pragma unroll
    for (int i = 0; i < 2; ++i) { int R, C; stage_rc(tid * 16 + i * 8192, R, C); const int Rb = (R & ~31) + perm32(R & 31);
        voffA[i] = (unsigned)(R * lda + C) * 2u; voffB[i] = (unsigned)(Rb * ldb + C) * 2u; }
#define PG8_STAGE_A(bufoff, base, half) do { if constexpr (GA) PG8_STAGE(bufoff, base, voA[half]); else PG8_STAGE(bufoff, (base) + (half) * hstepA, voffA); } while (0)
    const size_t kstep = 128;
    const size_t hstepA = (size_t)128 * lda * 2, hstepB = (size_t)128 * ldb * 2;
    const unsigned ldsw = (unsigned)wid * 1024u;
    const int aoff = lds_byte(wr * 64 + fr, fq * 8), boff = lds_byte(wc * 32 + fr, fq * 8);
#define PG8_SA(b, h) (((b) * 2 + (h)) * HTB)
#define PG8_SB(b, h) ((4 + (b) * 2 + (h)) * HTB)
#define PG8_STAGE(bufoff, gbase, voff) do { const GAS char* _b = uni_ptr(gbase); _Pragma("unroll") for (int _i = 0; _i < 2; ++_i) \
        __builtin_amdgcn_global_load_lds((const GAS unsigned*)(_b + (voff)[_i]), (LAS unsigned*)(lds + (bufoff) + ldsw + _i * 8192), 16, 0, 0); } while (0)
#define PG8_LDA(dst, b, h) do { _Pragma("unroll") for (int m = 0; m < 4; ++m) _Pragma("unroll") for (int k = 0; k < 2; ++k) dst[m][k] = *(const LAS bf16x8*)(lds + PG8_SA(b, h) + aoff + m * 2048 + k * 1024); } while (0)
#define PG8_LDB(dst, b, h) do { _Pragma("unroll") for (int n = 0; n < 2; ++n) _Pragma("unroll") for (int k = 0; k < 2; ++k) dst[n][k] = *(const LAS bf16x8*)(lds + PG8_SB(b, h) + boff + n * 2048 + k * 1024); } while (0)
#define PG8_MMA(ai, bj, At, Bt) do { __builtin_amdgcn_s_setprio(1); _Pragma("unroll") for (int m = 0; m < 4; ++m) _Pragma("unroll") for (int n = 0; n < 2; ++n) _Pragma("unroll") for (int k = 0; k < 2; ++k) \
        acc[ai][bj][m][n] = __builtin_amdgcn_mfma_f32_16x16x32_bf16(Bt[n][k], At[m][k], acc[ai][bj][m][n], 0, 0, 0); __builtin_amdgcn_s_setprio(0); } while (0)
#define PG8_MMA0(ai, bj, At, Bt) do { __builtin_amdgcn_s_setprio(1); _Pragma("unroll") for (int m = 0; m < 4; ++m) _Pragma("unroll") for (int n = 0; n < 2; ++n) { \
        acc[ai][bj][m][n] = __builtin_amdgcn_mfma_f32_16x16x32_bf16(Bt[n][0], At[m][0], (f32x4){0.f, 0.f, 0.f, 0.f}, 0, 0, 0); \
        acc[ai][bj][m][n] = __builtin_amdgcn_mfma_f32_16x16x32_bf16(Bt[n][1], At[m][1], acc[ai][bj][m][n], 0, 0, 0); } __builtin_amdgcn_s_setprio(0); } while (0)
#define PG8_WAIT_V(n) asm volatile("s_waitcnt vmcnt(" #n ")" ::: "memory")
#define PG8_WAIT_L(n) asm volatile("s_waitcnt lgkmcnt(" #n ")" ::: "memory")
#define PG8_BAR __builtin_amdgcn_s_barrier()
#define PG8_SCHED __builtin_amdgcn_sched_barrier(0)
    GUnit cur, nxt; int ui = 0;
    if (!S.next(0, cur)) return;
    f32x4 acc[2][2][4][2];
    bf16x8 At[4][2], B0[2][2], B1[2][2];
    const GAS char* cA = uni_ptr(cur.A); const GAS char* cB = uni_ptr(cur.B);
    if constexpr (GA) S.load_offs(cur.pm, tid, voA);
    PG8_STAGE(PG8_SB(0, 0), cB, voffB); PG8_STAGE(PG8_SB(0, 1), cB + hstepB, voffB); PG8_STAGE_A(PG8_SA(0, 0), cA, 0); PG8_STAGE_A(PG8_SA(0, 1), cA, 1);
    if (wr == 1) PG8_BAR;
    PG8_WAIT_V(2); PG8_BAR;
    PG8_STAGE(PG8_SB(1, 0), cB + kstep, voffB); PG8_STAGE_A(PG8_SA(1, 0), cA + kstep, 0); PG8_STAGE(PG8_SB(1, 1), cB + hstepB + kstep, voffB);
    PG8_WAIT_V(6); PG8_BAR;
    STAMP_AT(0, true);
#define PG8_KBODY(MM) { \
            const bool last = (t == nt - 2); \
            const GAS char* a1 = cA + (size_t)(t + 1) * kstep; \
            const GAS char* a2 = last ? nA : cA + (size_t)(t + 2) * kstep; const GAS char* b2 = last ? nB : cB + (size_t)(t + 2) * kstep; \
            const GAS char* a3 = a2 + kstep; const GAS char* b3 = b2 + kstep; \
              \
            PG8_LDB(B0, 0, 0); PG8_LDB(B1, 0, 1); PG8_SCHED; PG8_LDA(At, 0, 0); PG8_STAGE_A(PG8_SA(1, 1), a1, 1); \
            if constexpr (GA) { if (last) { \
                _Pragma("unroll") for (int h_ = 0; h_ < 2; ++h_) { voA[h_][0] = voN[h_][0]; voA[h_][1] = voN[h_][1]; } } }        \
            PG8_WAIT_V(8); PG8_WAIT_L(0); PG8_BAR; MM(0, 0, At, B0); MM(0, 1, At, B1); PG8_BAR; PG8_SCHED; \
              \
            PG8_LDA(At, 0, 1); PG8_STAGE(PG8_SB(0, 0), b2, voffB); PG8_STAGE(PG8_SB(0, 1), b2 + hstepB, voffB); PG8_STAGE_A(PG8_SA(0, 0), a2, 0); \
            PG8_WAIT_V(8); PG8_WAIT_L(0); PG8_BAR; MM(1, 0, At, B0); MM(1, 1, At, B1); PG8_BAR; PG8_SCHED; \
              \
            PG8_LDB(B0, 1, 0); PG8_LDB(B1, 1, 1); PG8_SCHED; PG8_LDA(At, 1, 0); PG8_STAGE_A(PG8_SA(0, 1), a2, 1); \
            PG8_WAIT_V(8); PG8_WAIT_L(0); PG8_BAR; PG8_MMA(0, 0, At, B0); PG8_MMA(0, 1, At, B1); PG8_BAR; PG8_SCHED; \
              \
            PG8_LDA(At, 1, 1); PG8_STAGE(PG8_SB(1, 0), b3, voffB); PG8_STAGE(PG8_SB(1, 1), b3 + hstepB, voffB); PG8_STAGE_A(PG8_SA(1, 0), a3, 0); \
            PG8_WAIT_V(8); PG8_WAIT_L(0); PG8_BAR; PG8_MMA(1, 0, At, B0); PG8_MMA(1, 1, At, B1); PG8_BAR; PG8_SCHED; }
    for (;;) {
        const bool has_next = S.next(ui + 1, nxt);
        const GAS char* nA = has_next ? uni_ptr(nxt.A) : cA; const GAS char* nB = has_next ? uni_ptr(nxt.B) : cB;
        if constexpr (GA) { if (has_next && nxt.pm != cur.pm) S.load_offs(nxt.pm, tid, voN); else {
#pragma unroll
            for (int h_ = 0; h_ < 2; ++h_) { voN[h_][0] = voA[h_][0]; voN[h_][1] = voA[h_][1]; } } }
        if (ui >= 0) {
#pragma unroll
    for (int a = 0; a < 2; ++a)
#pragma unroll
        for (int b = 0; b < 2; ++b)
#pragma unroll
            for (int m = 0; m < 4; ++m)
#pragma unroll
                for (int n = 0; n < 2; ++n) acc[a][b][m][n] = (f32x4){0.f, 0.f, 0.f, 0.f}; }
#pragma unroll 1
        for (int t = 0; t < nt; t += 2) PG8_KBODY(PG8_MMA)
        STAMP_AT(1, ui == 0);
        if (wr == 0) PG8_BAR;
        E(acc, cur, wr, wc, fr, fq);
        STAMP_AT(2, ui == 0);
        if (!has_next) break;
        cur = nxt; cA = nA; cB = nB; ++ui;
        if (wr == 1) PG8_BAR;
    }
#undef PG8_KBODY
    PG8_WAIT_V(0);
    PG8_BAR;
    STAMP_AT(3, true);
#undef PG8_SA
#undef PG8_SB
#undef PG8_STAGE
#undef PG8_STAGE_A
#undef PG8_LDA
#undef PG8_LDB
#undef PG8_MMA
#undef PG8_MMA0
#undef PG8_WAIT_V
#undef PG8_WAIT_L
#undef PG8_BAR
#undef PG8_SCHED
}

__device__ __forceinline__ int moe_expert(volatile LAS unsigned* tpre, int pm) {
    const u32x4 p0 = *(const LAS u32x4*)tpre, p1 = *(const LAS u32x4*)(tpre + 4);
    const int e = ((int)p0.y <= pm ? 1 : 0) + ((int)p0.z <= pm ? 1 : 0) + ((int)p0.w <= pm ? 1 : 0) + ((int)p1.x <= pm ? 1 : 0) + ((int)p1.y <= pm ? 1 : 0) + ((int)p1.z <= pm ? 1 : 0) + ((int)p1.w <= pm ? 1 : 0);
    return __builtin_amdgcn_readfirstlane(e);
}
struct SchedPlain {
    const GAS char* A; const GAS char* B; size_t tA, tB; int nM, nN, G, c;
    __device__ __forceinline__ bool next(int i, GUnit& u) const {
        const int L = i * G + c; if (L >= nM * nN) return false;
        int pm, pn; tile_order(L, nM, nN, pm, pn);
        u.A = A + (size_t)pm * tA; u.B = B + (size_t)pn * tB; u.pm = pm; u.pn = pn; u.kind = 0; u.pad = 0; return true;
    }
};
struct SchedR2 {
    const GAS char* xs; const GAS char* Wrkv; const GAS char* Wl1; int nvn, G, c;
    __device__ __forceinline__ bool next(int i, GUnit& u) const {
        const int L = i * G + c; if (L >= 64 * nvn) return false;
        int pm, vn; tile_order(L, 64, nvn, pm, vn);
        int kind, pn, s; const GAS char* B;
        if (vn < 12) { kind = vn >> 2; pn = vn & 3; s = kind; B = Wrkv + (size_t)kind * D * D * 2 + (size_t)pn * 256 * D * 2; }
        else { kind = vn - 9; pn = 0; s = (kind == 6) ? 2 : kind; B = Wl1 + (size_t)(kind - 3) * 256 * D * 2; }
        u.A = xs + (size_t)s * M * D * 2 + (size_t)pm * 256 * D * 2; u.B = B; u.pm = pm; u.pn = pn; u.kind = kind; u.pad = 0; return true;
    }
};
struct SchedR3 {
    const GAS char* l1; const GAS char* Wl2; int nvn, G, c;
    __device__ __forceinline__ bool next(int i, GUnit& u) const {
        const int L = i * G + c; if (L >= 64 * nvn) return false;
        int pm, vn; tile_order(L, 64, nvn, pm, vn);
        const int kind = vn >> 2, pn = vn & 3;
        u.A = l1 + (size_t)kind * M * 256 * 2 + (size_t)pm * 256 * 256 * 2; u.B = Wl2 + (size_t)kind * D * 256 * 2 + (size_t)pn * 256 * 256 * 2;
        u.pm = pm; u.pn = pn; u.kind = kind; u.pad = 0; return true;
    }
};
struct SchedGrp {
    const GAS char* A; const GAS char* B; size_t gA, tA, gB, tB; int nMg, nNg, ng, G, vcu;
    __device__ __forceinline__ bool next(int i, GUnit& u) const {
        const int L = i * G + vcu, per = nMg * nNg; if (L >= ng * per) return false;
        const int g = fdiv(L, per), r = L - g * per, pn = fdiv(r, nMg), pm = r - pn * nMg;
        u.A = A + (size_t)g * gA + (size_t)pm * tA; u.B = B + (size_t)g * gB + (size_t)pn * tB; u.pm = pm; u.pn = pn; u.kind = g; u.pad = 0; return true;
    }
};
struct SchedOne {
    GUnit u0;
    __device__ __forceinline__ bool next(int i, GUnit& u) const { if (i != 0) return false; u = u0; return true; }
};
struct SchedMoe {
    const GAS char* A; const GAS char* W; size_t tA, eW, tB; int nN, G, c; volatile LAS unsigned* tpre;
    __device__ __forceinline__ bool next(int i, GUnit& u) const {
        const int MT = (int)tpre[8]; const int L = i * G + c; if (L >= MT * nN) return false;
        int pm, pn; tile_order(L, MT, nN, pm, pn);
        const int e = moe_expert(tpre, pm);
        u.A = A + (size_t)pm * tA; u.B = W + (size_t)e * eW + (size_t)pn * tB; u.pm = pm; u.pn = pn; u.kind = e; u.pad = 0; return true;
    }
};

#define EPI_ARGS const f32x4 (&acc)[2][2][4][2], const GUnit& u, int wr, int wc, int fr, int fq
struct EpiR2 {
    GAS bf16_t* rk; GAS bf16_t* vdst; GAS bf16_t* l1;
    __device__ __forceinline__ void operator()(EPI_ARGS) const {
        const int kind = u.kind; GAS bf16_t* base; int ldc, act = 0;
        if (kind < 3) { base = (kind == 2) ? vdst : rk + (size_t)kind * M * D; ldc = D; }
        else { base = l1 + (size_t)(kind - 3) * M * 256; ldc = 256; act = (kind == 3) ? 1 : ((kind == 5) ? 2 : 0); }
        const int row0 = u.pm * 256 + wr * 64 + fr, col0 = u.pn * 256 + wc * 32 + 8 * fq;
#pragma unroll
        for (int ai = 0; ai < 2; ++ai)
#pragma unroll
            for (int m = 0; m < 4; ++m) { GAS bf16_t* rowp = base + (size_t)(row0 + ai * 128 + m * 16) * ldc + col0;
#pragma unroll
                for (int bj = 0; bj < 2; ++bj) { f32x4 v0 = acc[ai][bj][m][0], v1 = acc[ai][bj][m][1];
                    if (act == 1) {
#pragma unroll
                        for (int j = 0; j < 4; ++j) { v0[j] = ftanh(v0[j]); v1[j] = ftanh(v1[j]); } }
                    if (act == 2) {
#pragma unroll
                        for (int j = 0; j < 4; ++j) { v0[j] = fsigmoid(v0[j]); v1[j] = fsigmoid(v1[j]); } }
                    *(GAS u32x4*)(rowp + bj * 128) = pack8(v0, v1); } }
    }
};
struct EpiR3 {
    GAS unsigned char* wsl; LAS unsigned long long* ptab; int j;
    template <int KIND> __device__ __forceinline__ void run(EPI_ARGS) const {
        GAS unsigned char* ar = wsl + WS_AR;
        GAS bf16_t* vbuf = (j == 0) ? (GAS bf16_t*)(wsl + WS_VF) : (GAS bf16_t*)(ar + AR_V); const GAS bf16_t* vfirst = (const GAS bf16_t*)(wsl + WS_VF);
        const GAS float* bias = inp_ptr(ptab, KIND == 0 ? 6 : (KIND == 1 ? 9 : 20)) + (size_t)((KIND == 3) ? 0 : j) * D;
        GAS bf16_t* base = (KIND == 3) ? vbuf : (GAS bf16_t*)(ar + AR_LW) + (size_t)KIND * M * D;
        const int row0 = u.pm * 256 + wr * 64 + fr, col0 = u.pn * 256 + wc * 32 + 8 * fq;
        f32x4 bv[2][2];
#pragma unroll
        for (int bj = 0; bj < 2; ++bj) { if (KIND != 2) { bv[bj][0] = *(const GAS f32x4*)(bias + col0 + bj * 128); bv[bj][1] = *(const GAS f32x4*)(bias + col0 + bj * 128 + 4); } else { bv[bj][0] = (f32x4){0.f, 0.f, 0.f, 0.f}; bv[bj][1] = bv[bj][0]; } }
#pragma unroll
        for (int ai = 0; ai < 2; ++ai)
#pragma unroll
            for (int m = 0; m < 4; ++m) { const size_t off = (size_t)(row0 + ai * 128 + m * 16) * D + col0;
#pragma unroll
                for (int bj = 0; bj < 2; ++bj) { f32x4 x0 = acc[ai][bj][m][0] + bv[bj][0], x1 = acc[ai][bj][m][1] + bv[bj][1];
                    if (KIND == 0) {
#pragma unroll
                        for (int j = 0; j < 4; ++j) { x0[j] = -0.60653066f * fsigmoid(x0[j]); x1[j] = -0.60653066f * fsigmoid(x1[j]); } }
                    else if (KIND == 1) {
#pragma unroll
                        for (int j = 0; j < 4; ++j) { x0[j] = fsigmoid(x0[j]); x1[j] = fsigmoid(x1[j]); } }
                    else if (KIND == 3) {
                        f32x4 va, vb, fa, fb; unpack8(*(const GAS u32x4*)(vbuf + off + bj * 128), va, vb); unpack8(*(const GAS u32x4*)(vfirst + off + bj * 128), fa, fb);
#pragma unroll
                        for (int j = 0; j < 4; ++j) { x0[j] = va[j] + (fa[j] - va[j]) * fsigmoid(x0[j]); x1[j] = vb[j] + (fb[j] - vb[j]) * fsigmoid(x1[j]); } }
                    *(GAS u32x4*)(base + off + bj * 128) = pack8(x0, x1); } }
    }
    __device__ __forceinline__ void operator()(EPI_ARGS) const {
        const int kind = u.kind;
        if (kind == 0) run<0>(acc, u, wr, wc, fr, fq);
        else if (kind == 1) run<1>(acc, u, wr, wc, fr, fq);
        else if (kind == 2) run<2>(acc, u, wr, wc, fr, fq);
        else run<3>(acc, u, wr, wc, fr, fq);
    }
};
struct EpiRes {
    const GAS bf16_t* hin; GAS bf16_t* hout;
    __device__ __forceinline__ void operator()(EPI_ARGS) const {
        const int row0 = u.pm * 256 + wr * 64 + fr, col0 = u.pn * 256 + wc * 32 + 8 * fq;
#pragma unroll
        for (int ai = 0; ai < 2; ++ai) { u32x4 hw[4][2];
#pragma unroll
            for (int m = 0; m < 4; ++m)
#pragma unroll
                for (int bj = 0; bj < 2; ++bj) hw[m][bj] = *(const GAS u32x4*)(hin + (size_t)(row0 + ai * 128 + m * 16) * D + col0 + bj * 128);
#pragma unroll
            for (int m = 0; m < 4; ++m) { const size_t off = (size_t)(row0 + ai * 128 + m * 16) * D + col0;
#pragma unroll
                for (int bj = 0; bj < 2; ++bj) {
                    f32x4 h0, h1; unpack8(hw[m][bj], h0, h1);
                    *(GAS u32x4*)(hout + off + bj * 128) = pack8(h0 + acc[ai][bj][m][0], h1 + acc[ai][bj][m][1]); } } }
    }
};
struct EpiSwiglu {
    GAS bf16_t* out; int ldc;
#if MK_EPISKIP
    int skip;
#endif
    __device__ __forceinline__ void operator()(EPI_ARGS) const {
#if MK_EPISKIP == 1
        if (skip) return;
#endif
        const int row0 = u.pm * 256 + wr * 64 + fr, col0 = u.pn * 128 + wc * 32 + 8 * fq;
#pragma unroll
        for (int ai = 0; ai < 2; ++ai)
#pragma unroll
            for (int m = 0; m < 4; ++m) { f32x4 o0, o1;
#pragma unroll
                for (int j = 0; j < 4; ++j) { const float g0 = acc[ai][0][m][0][j], g1 = acc[ai][0][m][1][j]; o0[j] = g0 * fsigmoid(g0) * acc[ai][1][m][0][j]; o1[j] = g1 * fsigmoid(g1) * acc[ai][1][m][1][j]; }
                *(GAS u32x4*)(out + (size_t)(row0 + ai * 128 + m * 16) * ldc + col0) = pack8(o0, o1); }
    }
};
struct EpiGlu {
    GAS bf16_t* h; const GAS float* bglu;
    __device__ __forceinline__ void operator()(EPI_ARGS) const {
        const int row0 = u.pm * 256 + wr * 64 + fr, col0 = u.pn * 128 + wc * 32 + 8 * fq;
        const f32x4 bv0 = *(const GAS f32x4*)(bglu + col0), bv1 = *(const GAS f32x4*)(bglu + col0 + 4), bg0 = *(const GAS f32x4*)(bglu + D + col0), bg1 = *(const GAS f32x4*)(bglu + D + col0 + 4);
        u32x4 hw[2][4];
#pragma unroll
        for (int ai = 0; ai < 2; ++ai)
#pragma unroll
            for (int m = 0; m < 4; ++m) hw[ai][m] = *(const GAS u32x4*)(h + (size_t)(row0 + ai * 128 + m * 16) * D + col0);
#pragma unroll
        for (int ai = 0; ai < 2; ++ai)
#pragma unroll
            for (int m = 0; m < 4; ++m) { GAS bf16_t* p = h + (size_t)(row0 + ai * 128 + m * 16) * D + col0;
                f32x4 h0, h1; unpack8(hw[ai][m], h0, h1);
#pragma unroll
                for (int j = 0; j < 4; ++j) { h0[j] += (acc[ai][0][m][0][j] + bv0[j]) * fsigmoid(acc[ai][1][m][0][j] + bg0[j]); h1[j] += (acc[ai][0][m][1][j] + bv1[j]) * fsigmoid(acc[ai][1][m][1][j] + bg1[j]); }
                *(GAS u32x4*)p = pack8(h0, h1); }
    }
};
struct EpiS5E {
    GAS float* eb;
    __device__ __forceinline__ void operator()(EPI_ARGS) const {
        const int row0 = u.pm * 256 + wr * 64 + fr, col0 = wc * 32 + 8 * fq;
#pragma unroll
        for (int ai = 0; ai < 2; ++ai)
#pragma unroll
            for (int m = 0; m < 4; ++m) { GAS float* p = eb + ((size_t)u.kind * NBC + row0 + ai * 128 + m * 16) * 128 + col0;
                *(GAS f32x4*)p = acc[ai][0][m][0]; *(GAS f32x4*)(p + 4) = acc[ai][0][m][1]; }
    }
};
struct EpiS5Y {
    GAS bf16_t* yact; const GAS bf16_t* ug; const GAS float* dskip;
    __device__ __forceinline__ void operator()(EPI_ARGS) const {
        const int g = u.kind; const int row0 = u.pm * 256 + wr * 64 + fr, col0 = u.pn * 256 + wc * 32 + 8 * fq;
        u32x4 xw[2][2][4];
#pragma unroll
        for (int bj = 0; bj < 2; ++bj)
#pragma unroll
            for (int ai = 0; ai < 2; ++ai)
#pragma unroll
                for (int m = 0; m < 4; ++m) xw[bj][ai][m] = *(const GAS u32x4*)(ug + ((size_t)g * NBC + row0 + ai * 128 + m * 16) * S5K + col0 + bj * 128);
#pragma unroll
        for (int bj = 0; bj < 2; ++bj) { const int n = col0 + bj * 128, tl = n >> 4, ch = n & 15;
            const f32x4 d0 = *(const GAS f32x4*)(dskip + 16 * g + ch), d1 = *(const GAS f32x4*)(dskip + 16 * g + ch + 4);
#pragma unroll
            for (int ai = 0; ai < 2; ++ai)
#pragma unroll
                for (int m = 0; m < 4; ++m) { const int bc = row0 + ai * 128 + m * 16;
                    f32x4 x0, x1; unpack8(xw[bj][ai][m], x0, x1);
                    f32x4 y0 = acc[ai][bj][m][0] + d0 * x0, y1 = acc[ai][bj][m][1] + d1 * x1;
#pragma unroll
                    for (int j = 0; j < 4; ++j) { y0[j] = fgelu(y0[j]); y1[j] = fgelu(y1[j]); }
                    *(GAS u32x4*)(yact + ((size_t)bc * S5L + tl) * D + 16 * g + ch) = pack8(y0, y1); } }
    }
};
struct SchedMoeG {
    const GAS char* A; const GAS char* W; size_t eW, tB; int nN, G, c; volatile LAS unsigned* tpre; const GAS int* rowtok;
    __device__ __forceinline__ bool next(int i, GUnit& u) const {
        const int MT = (int)tpre[8]; const int L = i * G + c; if (L >= MT * nN) return false;
        int pm, pn; tile_order(L, MT, nN, pm, pn);
        const int e = moe_expert(tpre, pm);
        u.A = A; u.B = W + (size_t)e * eW + (size_t)pn * tB; u.pm = pm; u.pn = pn; u.kind = e; u.pad = 0; return true;
    }
    __device__ __forceinline__ void load_offs(int pm, int tid, unsigned (&vo)[2][2]) const {
#pragma unroll
        for (int i = 0; i < 2; ++i) { int R, C; stage_rc(tid * 16 + i * 8192, R, C);
#pragma unroll
            for (int h = 0; h < 2; ++h) { const int tok = rowtok[pm * 256 + 128 * h + R]; vo[h][i] = (unsigned)(tok * D + C) * 2u; } }
    }
};
template <> struct sched_gather<SchedMoeG> { static constexpr bool value = true; };
struct SchedMoeMain {
    const GAS char* A; const GAS char* W; size_t tA, eW, tB; int nN, G, c; volatile LAS unsigned* tpre;
    __device__ __forceinline__ bool next(int i, GUnit& u) const {
        int MT = (int)tpre[8]; MT = MT < MOE_MAIN_TILES ? MT : MOE_MAIN_TILES; const int L = i * G + c; if (L >= MT * nN) return false;
        int pm, pn; tile_order(L, MT, nN, pm, pn);
        const int e = moe_expert(tpre, pm);
        u.A = A + (size_t)pm * tA; u.B = W + (size_t)e * eW + (size_t)pn * tB; u.pm = pm; u.pn = pn; u.kind = e; u.pad = 0; return true;
    }
};
struct SchedMoeTail {
    const GAS char* A; const GAS char* W; size_t tA, eW, tB, kq_bytes; int G, c; volatile LAS unsigned* tpre;
    __device__ __forceinline__ bool next(int i, GUnit& u) const {
        const int MT = (int)tpre[8]; const int ntail = MT - MOE_MAIN_TILES; const int L = i * G + c; if (ntail <= 0 || L >= ntail * 16) return false;
        const int pm = MOE_MAIN_TILES + (L >> 4), pn = (L >> 2) & 3, kq = L & 3;
        const int e = moe_expert(tpre, pm);
        u.A = A + (size_t)pm * tA + (size_t)kq * kq_bytes; u.B = W + (size_t)e * eW + (size_t)pn * tB + (size_t)kq * kq_bytes; u.pm = pm; u.pn = pn; u.kind = e; u.pad = kq; return true;
    }
};
struct EpiMoeDown {
    GAS bf16_t* y2; const GAS int* rowslot; const GAS float* rowgate; GAS bf16_t* y2t;
    __device__ __forceinline__ void operator()(EPI_ARGS) const {
        const int row0 = u.pm * 256 + wr * 64 + fr, col0 = u.pn * 256 + wc * 32 + 8 * fq; const int kq = u.pad;
        int sl[2][4]; float gtv[2][4];
#pragma unroll
        for (int ai = 0; ai < 2; ++ai)
#pragma unroll
            for (int m = 0; m < 4; ++m) { sl[ai][m] = rowslot[row0 + ai * 128 + m * 16]; gtv[ai][m] = rowgate[row0 + ai * 128 + m * 16]; }
#pragma unroll
        for (int ai = 0; ai < 2; ++ai)
#pragma unroll
            for (int m = 0; m < 4; ++m) { const int row = row0 + ai * 128 + m * 16; const int slot = sl[ai][m]; const float gt = gtv[ai][m];
                if (slot >= 0) { GAS bf16_t* dst = (kq == 0) ? y2 + (size_t)slot * D : y2t + ((size_t)(kq - 1) * 2048 + (row - MOE_TAIL_ROW0)) * D;
#pragma unroll
                    for (int bj = 0; bj < 2; ++bj) *(GAS u32x4*)(dst + col0 + bj * 128) = pack8(acc[ai][bj][m][0] * gt, acc[ai][bj][m][1] * gt); } }
    }
};

struct CvtEnt { unsigned long long W, dst; int Ks, Ns, lds_, nblk, ldt, mode, row_off, first; };
constexpr int CVT_TAB_OFF = 102400, CVT_SCR_OFF = 32768, CVT_SCR_WAVE = 8704, CVT_MAX = 80;
__device__ __forceinline__ void cvt_add(LAS CvtEnt* tab, int& n, int& total, const GAS float* W, int Ks, int Ns, int lds_, int Kp, int Np, GAS bf16_t* dst, int ldt, int mode, int row_off) {
    LAS CvtEnt* e = tab + n; e->W = (unsigned long long)W; e->dst = (unsigned long long)dst; e->Ks = Ks; e->Ns = Ns; e->lds_ = lds_; e->nblk = Np / 32; e->ldt = ldt; e->mode = mode; e->row_off = row_off; e->first = total;
    total += (Kp / 64) * (Np / 32); ++n; tab[n].first = total;
}
__device__ __forceinline__ void cvt_fetch(const LAS CvtEnt* tab, int& ti, int f, CvtEnt& e) {
    while (f >= __builtin_amdgcn_readfirstlane(tab[ti + 1].first)) ++ti;
    const LAS CvtEnt* t = tab + ti;
    const unsigned long long w = t->W, d = t->dst;
    e.W = ((unsigned long long)(unsigned)__builtin_amdgcn_readfirstlane((int)(w >> 32)) << 32) | (unsigned)__builtin_amdgcn_readfirstlane((int)w);
    e.dst = ((unsigned long long)(unsigned)__builtin_amdgcn_readfirstlane((int)(d >> 32)) << 32) | (unsigned)__builtin_amdgcn_readfirstlane((int)d);
    e.Ks = __builtin_amdgcn_readfirstlane(t->Ks); e.Ns = __builtin_amdgcn_readfirstlane(t->Ns); e.lds_ = __builtin_amdgcn_readfirstlane(t->lds_); e.nblk = __builtin_amdgcn_readfirstlane(t->nblk);
    e.ldt = __builtin_amdgcn_readfirstlane(t->ldt); e.mode = __builtin_amdgcn_readfirstlane(t->mode); e.row_off = __builtin_amdgcn_readfirstlane(t->row_off); e.first = __builtin_amdgcn_readfirstlane(t->first);
}
__device__ __forceinline__ void cvt_load(const CvtEnt& t, int f, int lane, f32x4 (&v)[8]) {
    const int item = f - t.first, kb = fdiv(item, t.nblk), nb = item - kb * t.nblk, k0 = 64 * kb, n0 = 32 * nb;
    const int r = lane >> 3, c4 = lane & 7; const GAS float* W = (const GAS float*)t.W;
#pragma unroll
    for (int i = 0; i < 8; ++i) { const int k = k0 + 8 * i + r, n = n0 + 4 * c4;
        v[i] = (f32x4){0.f, 0.f, 0.f, 0.f}; if (k < t.Ks && n < t.Ns) v[i] = *(const GAS f32x4*)(W + (size_t)k * t.lds_ + n); }
}
__device__ __forceinline__ void cvt_store(const CvtEnt& t, LAS float* scr, int f, int lane, const f32x4 (&v)[8]) {
    const int item = f - t.first, kb = fdiv(item, t.nblk), nb = item - kb * t.nblk, k0 = 64 * kb, n0 = 32 * nb;
    const int r = lane >> 3, c4 = lane & 7; GAS bf16_t* dst = (GAS bf16_t*)t.dst;
#pragma unroll
    for (int i = 0; i < 8; ++i) { LAS float* d = scr + (8 * i + r) * 33 + 4 * c4; d[0] = v[i][0]; d[1] = v[i][1]; d[2] = v[i][2]; d[3] = v[i][3]; }
    asm volatile("s_waitcnt lgkmcnt(0)" ::: "memory");
#pragma unroll
    for (int j = 0; j < 4; ++j) { const int idx = lane + 64 * j, nn = idx >> 3, c = idx & 7; const LAS float* s_ = scr + (8 * c) * 33 + nn;
        u32x4 o; o.x = cvt_pk_bf16(s_[0 * 33], s_[1 * 33]); o.y = cvt_pk_bf16(s_[2 * 33], s_[3 * 33]); o.z = cvt_pk_bf16(s_[4 * 33], s_[5 * 33]); o.w = cvt_pk_bf16(s_[6 * 33], s_[7 * 33]);
        const int n = n0 + nn; const int drow = (t.mode == 1) ? (256 * (n >> 7) + (n & 127) + t.row_off) : (n + t.row_off);
        *(GAS u32x4*)(dst + (size_t)drow * t.ldt + k0 + 8 * c) = o; }
    asm volatile("s_waitcnt lgkmcnt(0)" ::: "memory");
}
__device__ __forceinline__ void cvt_pipe(const LAS CvtEnt* tab, int ntasks, LAS float* scr, int s0, int stepA, int stepB, int lane) {
    const int total = __builtin_amdgcn_readfirstlane(tab[ntasks].first);
    int ti = 0, fl = s0, st = 0;
    CvtEnt e0, e1, e2, e3; f32x4 v0[8], v1[8], v2[8], v3[8]; int f0 = 0, f1 = 0, f2 = 0, f3 = 0; bool m0, m1, m2, m3;
#define CVT_LD(k) do { m##k = fl < total; if (m##k) { f##k = fl; cvt_fetch(tab, ti, fl, e##k); cvt_load(e##k, fl, lane, v##k); fl += st ? stepB : stepA; st ^= 1; } } while (0)
#define CVT_ST(k) do { if (!m##k) return; cvt_store(e##k, scr, f##k, lane, v##k); } while (0)
    CVT_LD(0); CVT_LD(1); CVT_LD(2);
    for (;;) { CVT_LD(3); CVT_ST(0); CVT_LD(0); CVT_ST(1); CVT_LD(1); CVT_ST(2); CVT_LD(2); CVT_ST(3); }
#undef CVT_LD
#undef CVT_ST
}

struct Args { const float* in[40]; float* out; unsigned char* ws; int ph_lo, ph_hi; };

__global__ void __launch_bounds__(NTHREADS, 2) mk_fwd(Args args) {
    extern __shared__ __attribute__((aligned(16))) unsigned char lds_raw[];
    LAS unsigned char* lds = (LAS unsigned char*)lds_raw;
    volatile LAS unsigned* MISC = (volatile LAS unsigned*)(lds + MISC_OFF);
    const int tid0 = threadIdx.x;
    const int G0 = gridDim.x, bx0 = blockIdx.x;
    GAS unsigned char* ws = (GAS unsigned char*)args.ws;
    for (int u = tid0; u < (LDS_BYTES - LDSCTL_OFF) / 4; u += NTHREADS) ((LAS unsigned*)(lds + LDSCTL_OFF))[u] = 0u;
    __syncthreads();
    LAS unsigned long long* PTAB = (LAS unsigned long long*)(lds + PTAB_OFF);
    if (tid0 < 40) PTAB[tid0] = (unsigned long long)args.in[tid0];
    __syncthreads();
#define INP(i) inp_ptr(PTAB, (i))
#define Y2T_ADD(v_, tok_, q_) do { _Pragma("unroll") for (int k2_ = 0; k2_ < 2; ++k2_) { const int tr_ = __builtin_amdgcn_readfirstlane(((const GAS int*)(wsl + WS_TROW))[2 * (tok_) + k2_]); \
        if (tr_ >= 0) { _Pragma("unroll") for (int kq_ = 0; kq_ < 3; ++kq_) { const u32x2 yt_ = *(const GAS u32x2*)((const GAS bf16_t*)(wsl + WS_Y2T) + ((size_t)kq_ * 2048 + tr_) * D + 4 * lane + 256 * (q_)); \
            v_[0] += bf_lo(yt_.x); v_[1] += bf_hi(yt_.x); v_[2] += bf_lo(yt_.y); v_[3] += bf_hi(yt_.y); } } } } while (0)
#define PHASE_BASE() GAS unsigned char* wsl = ws; int G = G0, bx = bx0, tid = tid0; asm volatile("" : "+s"(wsl), "+s"(G), "+s"(bx), "+v"(tid)); \
    const int lane = tid & 63, wave = __builtin_amdgcn_readfirstlane(tid >> 6); GAS unsigned* ctl = (GAS unsigned*)(wsl + WS_CTL); (void)ctl; (void)lane; \
    const int vcu = (G % 8 == 0) ? (bx % 8) * (G / 8) + bx / 8 : bx; const int gw = bx * NWAVES + wave, NGW = G * NWAVES; GAS unsigned char* ar = wsl + WS_AR; (void)ar; (void)vcu; (void)gw; (void)NGW
    XcdBarrier bar = xcd_barrier_post((unsigned*)args.ws + WS_CTL / 4 + CW_BAR, MISC + 8);
    const int lo = args.ph_lo, hi = args.ph_hi;
#define IN(k) ((lo <= (k) && (k) < hi) || ((k) == NPH - 1 && MK_N_LAUNCHES == 1))
#define SEAM(k) do { if (IN(k) && IN((k) + 1)) xcd_barrier(bar); } while (0)

#define hbuf0 ((GAS bf16_t*)(wsl + WS_H0))
#define hbuf1 ((GAS bf16_t*)(wsl + WS_H0 + (size_t)32 * 1024 * 1024))
#define vfirst ((GAS bf16_t*)(wsl + WS_VF))
#define y2 ((GAS bf16_t*)(wsl + WS_Y2))

    for (int rep_ = 0; rep_ <= ((MK_REPEAT >> 18) & 1); ++rep_) if (IN(0)) {
        PHASE_BASE();
        for (int item = bx; item < 128; item += G) {
            const int jl = item >> 6, g = item & 63;
            LAS float* pw_re = (LAS float*)lds;
            LAS float* pw_im = pw_re + 33 * 64;
            LAS float* bb_re = pw_im + 33 * 64;
            LAS float* bb_im = bb_re + 1024;
            LAS float* cc_re = bb_im + 1024;
            LAS float* cc_im = cc_re + 1024;
            LAS float* kt = cc_im + 1024;
            LAS float* sdr = kt + 8192;
            LAS float* sdi = sdr + 64;
            const GAS float* lam_re = INP(23) + ((size_t)jl * 64 + g) * 64; const GAS float* lam_im = INP(24) + ((size_t)jl * 64 + g) * 64;
            const float dt = __expf(INP(25)[jl * 64 + g]);
            if (tid < 64) { const int p = tid;
                const float lr = fminf(lam_re[p], -1e-4f), li = lam_im[p]; const float dr = lr * dt, di = li * dt;
                sdr[p] = dr; sdi[p] = di;
                const float ed = expf(dr), cd = cosf(di), sd = sinf(di), sh = sinf(0.5f * di);
                const float abar_im = ed * sd; const float num_re = expm1f(dr) * cd - 2.0f * sh * sh; const float den = lr * lr + li * li;
                const float cre = (num_re * lr + abar_im * li) / den, cim = (abar_im * lr - num_re * li) / den;
                const GAS float* bre = INP(26) + (((size_t)jl * 64 + g) * 64 + p) * 16; const GAS float* bim = INP(27) + (((size_t)jl * 64 + g) * 64 + p) * 16;
#pragma unroll
                for (int c = 0; c < 16; ++c) { const float br = bre[c], bi = bim[c]; bb_re[p * 16 + c] = cre * br - cim * bi; bb_im[p * 16 + c] = cre * bi + cim * br; }
            }
            for (int i = tid; i < 1024; i += NTHREADS) { cc_re[i] = INP(28)[((size_t)jl * 64 + g) * 1024 + i]; cc_im[i] = INP(29)[((size_t)jl * 64 + g) * 1024 + i]; }
            __syncthreads();
            for (int i = tid; i < 33 * 64; i += NTHREADS) { const int tau = i >> 6, p = i & 63;
                const float mag = expf((float)tau * sdr[p]); float rev = (float)tau * sdi[p] * 0.15915494309189535f; rev -= floorf(rev);
                const float ang = (rev > 0.5f ? rev - 1.0f : rev) * 6.283185307179586f;
                pw_re[i] = mag * cosf(ang); pw_im[i] = mag * sinf(ang); }
            __syncthreads();
            for (int i = tid; i < 8192; i += NTHREADS) { const int tau = i >> 8, co = (i >> 4) & 15, ci = i & 15; float s = 0.f;
                for (int p = 0; p < 64; ++p) { const float cr = cc_re[co * 64 + p], cm = cc_im[co * 64 + p], pr = pw_re[tau * 64 + p], pi = pw_im[tau * 64 + p];
                    const float abr = cr * pr - cm * pi, abi = cr * pi + cm * pr; s += abr * bb_re[p * 16 + ci] - abi * bb_im[p * 16 + ci]; }
                kt[i] = s; }
            __syncthreads();
            GAS bf16_t* toep = (GAS bf16_t*)(wsl + WS_WS + (size_t)jl * WSS_STRIDE + WSS_TOEP) + (size_t)g * 512 * S5K;
            for (int id = tid; id < 512 * 80; id += NTHREADS) { const int n = id / 80, kc = id % 80, k0 = kc * 8, tlo = n >> 4, co = n & 15;
                float v[8];
                if (k0 < 512) { const int tli = k0 >> 4, ci0 = k0 & 15;
#pragma unroll
                    for (int q = 0; q < 8; ++q) v[q] = (tlo >= tli) ? kt[((tlo - tli) * 16 + co) * 16 + ci0 + q] : 0.f; }
                else { const int p0 = k0 - 512; const bool im = p0 >= 64; const int pb = im ? p0 - 64 : p0; const int tau = tlo + 1;
#pragma unroll
                    for (int q = 0; q < 8; ++q) { const int p = pb + q; const float cr = cc_re[co * 64 + p], cm = cc_im[co * 64 + p], pr = pw_re[tau * 64 + p], pi = pw_im[tau * 64 + p];
                        v[q] = im ? -(cr * pi + cm * pr) : (cr * pr - cm * pi); } }
                u32x4 o; o.x = cvt_pk_bf16(v[0], v[1]); o.y = cvt_pk_bf16(v[2], v[3]); o.z = cvt_pk_bf16(v[4], v[5]); o.w = cvt_pk_bf16(v[6], v[7]);
                *(GAS u32x4*)(toep + (size_t)n * S5K + k0) = o; }
            GAS bf16_t* m1 = (GAS bf16_t*)(wsl + WS_WS + (size_t)jl * WSS_STRIDE + WSS_M1) + (size_t)g * 256 * 512;
            for (int id = tid; id < 256 * 64; id += NTHREADS) { const int n = id >> 6, kc = id & 63, k0 = kc * 8, tli = k0 >> 4, ci0 = k0 & 15;
                float v[8];
                if (n < 128) { const bool im = n >= 64; const int p = im ? n - 64 : n; const int tau = 31 - tli; const float pr = pw_re[tau * 64 + p], pi = pw_im[tau * 64 + p];
#pragma unroll
                    for (int q = 0; q < 8; ++q) { const float br = bb_re[p * 16 + ci0 + q], bi = bb_im[p * 16 + ci0 + q]; v[q] = im ? (pr * bi + pi * br) : (pr * br - pi * bi); } }
                else {
#pragma unroll
                    for (int q = 0; q < 8; ++q) v[q] = 0.f; }
                u32x4 o; o.x = cvt_pk_bf16(v[0], v[1]); o.y = cvt_pk_bf16(v[2], v[3]); o.z = cvt_pk_bf16(v[4], v[5]); o.w = cvt_pk_bf16(v[6], v[7]);
                *(GAS u32x4*)(m1 + (size_t)n * 512 + k0) = o; }
            __syncthreads();
        }
            LAS float* scr = (LAS float*)(lds + CVT_SCR_OFF + wave * CVT_SCR_WAVE);
        LAS CvtEnt* ctab = (LAS CvtEnt*)(lds + CVT_TAB_OFF);
        if (tid == 0) { int cn = 0, ctot = 0;
#pragma unroll 1
        for (int j = 0; j < 2; ++j) {
            GAS unsigned char* wr_ = wsl + WS_WR + (size_t)j * WR_STRIDE;
#pragma unroll 1
            for (int s = 0; s < 3; ++s) cvt_add(ctab, cn, ctot, INP(5) + ((size_t)j * 3 + s) * D * D, D, D, D, D, D, (GAS bf16_t*)(wr_ + WR_RKV) + (size_t)s * D * D, D, 0, 0);
            cvt_add(ctab, cn, ctot, INP(7) + (size_t)j * D * 64, D, 64, 64, D, 256, (GAS bf16_t*)(wr_ + WR_L1), D, 0, 0);
            cvt_add(ctab, cn, ctot, INP(10) + (size_t)j * D * 64, D, 64, 64, D, 256, (GAS bf16_t*)(wr_ + WR_L1) + (size_t)256 * D, D, 0, 0);
            cvt_add(ctab, cn, ctot, INP(12) + (size_t)j * D * 160, D, 160, 160, D, 256, (GAS bf16_t*)(wr_ + WR_L1) + (size_t)2 * 256 * D, D, 0, 0);
            if (j == 1) cvt_add(ctab, cn, ctot, INP(21), D, 32, 32, D, 256, (GAS bf16_t*)(wr_ + WR_L1) + (size_t)3 * 256 * D, D, 0, 0);
            cvt_add(ctab, cn, ctot, INP(8) + (size_t)j * 64 * D, 64, D, D, 256, D, (GAS bf16_t*)(wr_ + WR_L2), 256, 0, 0);
            cvt_add(ctab, cn, ctot, INP(11) + (size_t)j * 64 * D, 64, D, D, 256, D, (GAS bf16_t*)(wr_ + WR_L2) + (size_t)D * 256, 256, 0, 0);
            cvt_add(ctab, cn, ctot, INP(13) + (size_t)j * 160 * D, 160, D, D, 256, D, (GAS bf16_t*)(wr_ + WR_L2) + (size_t)2 * D * 256, 256, 0, 0);
            if (j == 1) cvt_add(ctab, cn, ctot, INP(22), 32, D, D, 256, D, (GAS bf16_t*)(wr_ + WR_L2) + (size_t)3 * D * 256, 256, 0, 0);
            cvt_add(ctab, cn, ctot, INP(19) + (size_t)j * D * D, D, D, D, D, D, (GAS bf16_t*)(wr_ + WR_WO), D, 0, 0);
            cvt_add(ctab, cn, ctot, INP(33) + (size_t)j * D * FF, D, FF, FF, D, FF, (GAS bf16_t*)(wr_ + WR_GU), D, 1, 0);
            cvt_add(ctab, cn, ctot, INP(34) + (size_t)j * D * FF, D, FF, FF, D, FF, (GAS bf16_t*)(wr_ + WR_GU), D, 1, 128);
            cvt_add(ctab, cn, ctot, INP(35) + (size_t)j * FF * D, FF, D, D, FF, D, (GAS bf16_t*)(wr_ + WR_WD), FF, 0, 0);
            GAS unsigned char* wss = wsl + WS_WS + (size_t)j * WSS_STRIDE;
            cvt_add(ctab, cn, ctot, INP(31) + (size_t)j * D * 2 * D, D, D, 2 * D, D, D, (GAS bf16_t*)(wss + WSS_GLU), D, 1, 0);
            cvt_add(ctab, cn, ctot, INP(31) + (size_t)j * D * 2 * D + D, D, D, 2 * D, D, D, (GAS bf16_t*)(wss + WSS_GLU), D, 1, 128);
        }
#pragma unroll 1
        for (int e = 0; e < NEXP; ++e) {
            cvt_add(ctab, cn, ctot, INP(37) + (size_t)e * D * FE, D, FE, FE, D, FE, (GAS bf16_t*)(wsl + WS_WM + WM_GU) + (size_t)e * 2 * FE * D, D, 1, 0);
            cvt_add(ctab, cn, ctot, INP(38) + (size_t)e * D * FE, D, FE, FE, D, FE, (GAS bf16_t*)(wsl + WS_WM + WM_GU) + (size_t)e * 2 * FE * D, D, 1, 128);
            cvt_add(ctab, cn, ctot, INP(39) + (size_t)e * FE * D, FE, D, D, FE, D, (GAS bf16_t*)(wsl + WS_WM + WM_WD) + (size_t)e * D * FE, FE, 0, 0);
        }
        MISC[41] = (unsigned)cn; }
        __syncthreads();
        {
            const int npre = (G < 128 ? G : 128) * NWAVES, NV = npre + 2 * (NGW - npre); const bool two = gw >= npre;
            cvt_pipe(ctab, (int)MISC[41], scr, two ? npre + 2 * (gw - npre) : gw, two ? 1 : NV, two ? NV - 1 : NV, lane); }
        __syncthreads();
}
    SEAM(0);

    for (int j = 0; j < 2; ++j) {
        const int pb = 1 + 19 * j;
#define wr_ (wsl + WS_WR + (size_t)j * WR_STRIDE)
#define wss (wsl + WS_WS + (size_t)j * WSS_STRIDE)
#define hcur ((j == 0) ? hbuf0 : hbuf1)
#define xs ((GAS bf16_t*)(ar + AR_XS))
#define rbuf ((GAS bf16_t*)(ar + AR_R))
#define kbuf ((GAS bf16_t*)(ar + AR_K))
#define vbuf ((j == 0) ? vfirst : (GAS bf16_t*)(ar + AR_V))
#define l1 ((GAS bf16_t*)(ar + AR_L1))
#define lwbuf ((GAS bf16_t*)(ar + AR_LW))
#define abuf ((GAS bf16_t*)(ar + AR_A))
#define gbuf ((GAS bf16_t*)(ar + AR_G))
#define yraw ((GAS float*)(ar + AR_YRAW))
#define yg ((GAS bf16_t*)(ar + AR_YG))
#define hn2 ((GAS bf16_t*)(ar + AR_HN2))
#define hmid ((GAS bf16_t*)(ar + AR_HMID))
#define ug ((GAS bf16_t*)(ar + AR_UG))
#define eb ((GAS float*)(ar + AR_EB))
#define yact ((GAS bf16_t*)(ar + AR_YACT))
#define asg_pe ((GAS unsigned*)(ar + AR_ASG))
#define asg_gate ((GAS float*)(ar + AR_ASG + 256 * 1024))
#define xsm ((GAS bf16_t*)(ar + AR_XSM))
#define rowslot ((GAS int*)(ar + AR_ROWM))
#define rowgate ((GAS float*)(ar + AR_ROWM + 512 * 1024))
#define rowtok ((GAS int*)(ar + AR_ROWM + 256 * 1024))
#define hmidm ((GAS bf16_t*)(ar + AR_HMIDM))
#define blkcnt ((GAS unsigned*)(ar + AR_ASG + 512 * 1024))

        for (int rep_ = 0; rep_ <= ((MK_REPEAT >> 0) & 1); ++rep_) if (IN(pb + 0)) {
            PHASE_BASE();
            LAS float* smu = (LAS float*)lds;
            LAS float* sg = smu + 6 * 1024;
            {   f32x4 mw[3]; float gw_[2];
#pragma unroll
                for (int u = 0; u < 3; ++u) mw[u] = *(const GAS f32x4*)(INP(4) + (size_t)j * 6 * 1024 + 4 * (tid + NTHREADS * u));
#pragma unroll
                for (int u = 0; u < 2; ++u) gw_[u] = INP(1)[(size_t)(2 * j) * 1024 + tid + NTHREADS * u];
#pragma unroll
                for (int u = 0; u < 3; ++u) *(LAS f32x4*)(smu + 4 * (tid + NTHREADS * u)) = mw[u];
#pragma unroll
                for (int u = 0; u < 2; ++u) sg[tid + NTHREADS * u] = gw_[u]; }
            __syncthreads();
#define Y2T_ADD2(v_, tr_, q_) do { if ((tr_) >= 0) { _Pragma("unroll") for (int kq_ = 0; kq_ < 3; ++kq_) { const u32x2 yt_ = *(const GAS u32x2*)((const GAS bf16_t*)(wsl + WS_Y2T) + ((size_t)kq_ * 2048 + (tr_)) * D + 4 * lane + 256 * (q_)); \
            v_[0] += bf_lo(yt_.x); v_[1] += bf_hi(yt_.x); v_[2] += bf_lo(yt_.y); v_[3] += bf_hi(yt_.y); } } } while (0)
#define R1_LOAD(S_, tok_) do { _Pragma("unroll") for (int q = 0; q < 4; ++q) { \
                if (R1_COMB) { lh[S_][q] = *(const GAS u32x2*)(hbuf0 + (size_t)(tok_) * D + 4 * lane + 256 * q); la[S_][q] = *(const GAS u32x2*)(y2 + (size_t)(2 * (tok_)) * D + 4 * lane + 256 * q); \
                    lb[S_][q] = *(const GAS u32x2*)(y2 + (size_t)(2 * (tok_) + 1) * D + 4 * lane + 256 * q); } \
                else lx[S_][q] = *(const GAS f32x4*)(INP(0) + (size_t)(tok_) * D + 4 * lane + 256 * q); } \
            if (R1_COMB) ltr[S_] = *(const GAS u32x2*)((const GAS int*)(wsl + WS_TROW) + 2 * (tok_)); } while (0)
#define R1_TOKENS() do { \
            for (int blk = bx; blk < M / 64; blk += G) { \
                const int t0 = blk * 64 + wave * 8; const bool seq0 = (t0 % T) == 0; \
                f32x4 prev[4], cur[4]; f32x4 lx[2][4]; u32x2 lh[2][4], la[2][4], lb[2][4], ltr[2]; \
                R1_LOAD(0, seq0 ? t0 : t0 - 1); \
                _Pragma("unroll") for (int tt = -1; tt < 8; ++tt) { \
                    const int tok = t0 + tt; const int S = (tt + 1) & 1; \
                    if (tt < 7) R1_LOAD(S ^ 1, tok + 1); \
                    float ss = 0.f; \
                    int tr0 = -1, tr1 = -1; if (R1_COMB) { tr0 = __builtin_amdgcn_readfirstlane((int)ltr[S].x); tr1 = __builtin_amdgcn_readfirstlane((int)ltr[S].y); } \
                    _Pragma("unroll") for (int q = 0; q < 4; ++q) { f32x4 v; \
                        if (!R1_COMB) v = lx[S][q]; \
                        else { const u32x2 hw = lh[S][q], ya = la[S][q], yb = lb[S][q]; \
                            v = (f32x4){bf_lo(hw.x) + (bf_lo(ya.x) + bf_lo(yb.x)), bf_hi(hw.x) + (bf_hi(ya.x) + bf_hi(yb.x)), bf_lo(hw.y) + (bf_lo(ya.y) + bf_lo(yb.y)), bf_hi(hw.y) + (bf_hi(ya.y) + bf_hi(yb.y))}; \
                            Y2T_ADD2(v, tr0, q); Y2T_ADD2(v, tr1, q); } \
                        if (tt >= 0) { u32x2 hw2; hw2.x = cvt_pk_bf16(v[0], v[1]); hw2.y = cvt_pk_bf16(v[2], v[3]); *(GAS u32x2*)(hcur + (size_t)tok * D + 4 * lane + 256 * q) = hw2; } \
                        cur[q] = v; ss += v[0] * v[0] + v[1] * v[1] + v[2] * v[2] + v[3] * v[3]; } \
                    const float rs = rsqrtf(wave_sum(ss) * (1.0f / D) + NORM_EPS); \
                    _Pragma("unroll") for (int q = 0; q < 4; ++q) cur[q] = cur[q] * rs * *(const LAS f32x4*)(sg + 4 * lane + 256 * q); \
                    if (tt == -1 && seq0) { _Pragma("unroll") for (int q = 0; q < 4; ++q) cur[q] = (f32x4){0.f, 0.f, 0.f, 0.f}; }          \
                    if (tt >= 0) { \
                        _Pragma("unroll") for (int s = 0; s < 6; ++s) \
                            _Pragma("unroll") for (int q = 0; q < 4; ++q) { const f32x4 mu = *(const LAS f32x4*)(smu + s * 1024 + 4 * lane + 256 * q); const f32x4 o = cur[q] + (prev[q] - cur[q]) * mu; \
                                u32x2 w; w.x = cvt_pk_bf16(o[0], o[1]); w.y = cvt_pk_bf16(o[2], o[3]); \
                                *(GAS u32x2*)(xs + (size_t)s * M * D + (size_t)tok * D + 4 * lane + 256 * q) = w; } } \
                    _Pragma("unroll") for (int q = 0; q < 4; ++q) prev[q] = cur[q]; \
                } \
            } } while (0)
            if (j == 0) {
#define R1_COMB false
                R1_TOKENS();
#undef R1_COMB
            } else {
#define R1_COMB true
                R1_TOKENS();
#undef R1_COMB
            }
#undef R1_TOKENS
#undef R1_LOAD
            if (j == 1) {
                __syncthreads();
                LAS float* scr = (LAS float*)(lds + CVT_SCR_OFF + wave * CVT_SCR_WAVE);
                LAS CvtEnt* ctab = (LAS CvtEnt*)(lds + CVT_TAB_OFF);
                if (tid == 0) { int cn = 0, ctot = 0;
                int dD = D, dFE = FE; asm volatile("" : "+s"(dD), "+s"(dFE));
#pragma unroll 1
                for (int e = 0; e < NEXP; ++e) {
                    cvt_add(ctab, cn, ctot, INP(37) + ((size_t)NEXP + e) * D * FE, dD, dFE, dFE, dD, dFE, (GAS bf16_t*)(wsl + WS_WM + WM_GU) + (size_t)e * 2 * FE * D, dD, 1, 0);
                    cvt_add(ctab, cn, ctot, INP(38) + ((size_t)NEXP + e) * D * FE, dD, dFE, dFE, dD, dFE, (GAS bf16_t*)(wsl + WS_WM + WM_GU) + (size_t)e * 2 * FE * D, dD, 1, 128);
                    cvt_add(ctab, cn, ctot, INP(39) + ((size_t)NEXP + e) * FE * D, dFE, dD, dD, dFE, dD, (GAS bf16_t*)(wsl + WS_WM + WM_WD) + (size_t)e * D * FE, dFE, 0, 0);
                }
                MISC[41] = (unsigned)cn; }
                __syncthreads();
                cvt_pipe(ctab, (int)MISC[41], scr, gw, NGW, NGW, lane);
            }
            __syncthreads();
        }
        SEAM(pb + 0);

        for (int rep_ = 0; rep_ <= ((MK_REPEAT >> 1) & 1); ++rep_) if (IN(pb + 1)) {
            PHASE_BASE();
            SchedR2 S{uni_ptr((const GAS char*)xs), uni_ptr((const GAS char*)(wr_ + WR_RKV)), uni_ptr((const GAS char*)(wr_ + WR_L1)), (j == 0) ? 15 : 16, G, bx};
            EpiR2 E{rbuf, vbuf, l1};
            gemm_phase(lds, tid, D, D, D, S, E);
        }
        SEAM(pb + 1);

        for (int rep_ = 0; rep_ <= ((MK_REPEAT >> 2) & 1); ++rep_) if (IN(pb + 2)) {
            PHASE_BASE();
            SchedR3 S{uni_ptr((const GAS char*)l1), uni_ptr((const GAS char*)(wr_ + WR_L2)), (j == 0) ? 12 : 16, G, bx};
            EpiR3 E{wsl, PTAB, j};
            gemm_phase(lds, tid, 256, 256, 256, S, E);
        }
        SEAM(pb + 2);

#if MK_CHUNKED
#define cqb ((GAS bf16_t*)(wsl + WS_Y2))
#define cnb ((GAS bf16_t*)(wsl + WS_Y2 + 32 * MiB))
#define czb ((GAS bf16_t*)(ar + 96 * MiB))
#define cyl ((GAS bf16_t*)(ar + 128 * MiB))
#define csb ((GAS bf16_t*)(ar + 288 * MiB))
#define cbon ((GAS float*)(ar + 320 * MiB))
        for (int rep_ = 0; rep_ <= ((MK_REPEAT >> 3) & 1); ++rep_) if (IN(pb + 3)) {
            PHASE_BASE();
#if MK_STAMP == 6
            if (j == 0 && tid == 0) MISC[40] = 1u;
            __syncthreads();
            STAMP_AT(0, true);
#endif
            constexpr int LD = 72;
            LAS bf16_t* T_ABAR = (LAS bf16_t*)(lds + 0); LAS bf16_t* T_RBAR = (LAS bf16_t*)(lds + 9216); LAS bf16_t* T_BT = (LAS bf16_t*)(lds + 18432); LAS bf16_t* T_KT = (LAS bf16_t*)(lds + 27648);
            LAS bf16_t* T_BTT = (LAS bf16_t*)(lds + 36864); LAS bf16_t* T_KTT = (LAS bf16_t*)(lds + 46080); LAS bf16_t* T_VT = (LAS bf16_t*)(lds + 55296);
            LAS bf16_t* T_AAB = (LAS bf16_t*)(lds + 64512);
            LAS float* F_DIAG = (LAS float*)(lds + 73728);
            LAS float* F_G = (LAS float*)(lds + 64512);
            LAS bf16_t* T_AAK = (LAS bf16_t*)(lds + 81920); LAS bf16_t* T_ABR = (LAS bf16_t*)(lds + 91136); LAS bf16_t* T_AKR = (LAS bf16_t*)(lds + 100352);
            LAS float* F_W = (LAS float*)(lds + 109568);
            LAS bf16_t* T_V = (LAS bf16_t*)(lds + 109568);
            LAS float* F_SEG = (LAS float*)(lds + 125952);
            LAS float* F_TI = (LAS float*)(lds + 125952);
            LAS float* F_PL = (LAS float*)(lds + 130816);
            LAS bf16_t* T_MTT = T_BT; LAS bf16_t* T_X1T = T_KT;
            const int r = lane & 15, q = lane >> 4;
            const GAS float* k_k = INP(14) + (size_t)j * D; const GAS float* k_a = INP(15) + (size_t)j * D; const GAS float* r_k = INP(16) + (size_t)j * D;
#define TILE_MMA(acc_, At_, arow_, Bt_, brow_) do { _Pragma("unroll") for (int ks_ = 0; ks_ < 2; ++ks_) { \
                const bf16x8 a_ = *(const LAS bf16x8*)((At_) + ((arow_) + r) * LD + 32 * ks_ + 8 * q), b_ = *(const LAS bf16x8*)((Bt_) + ((brow_) + r) * LD + 32 * ks_ + 8 * q); \
                acc_ = __builtin_amdgcn_mfma_f32_16x16x32_bf16(a_, b_, acc_, 0, 0, 0); } } while (0)
            u32x4 pf_r, pf_k, pf_v, pf_l, pf_a;
#define W1_LOAD(it_) do { const int hd_ = (it_) >> 5, c_ = (it_) & 31; const size_t go_ = ((size_t)(hd_ >> 4) * T + c_ * 64 + (tid >> 3)) * D + (hd_ & 15) * 64 + 8 * (tid & 7); \
                pf_r = *(const GAS u32x4*)(rbuf + go_); pf_k = *(const GAS u32x4*)(kbuf + go_); pf_v = *(const GAS u32x4*)(vbuf + go_); pf_l = *(const GAS u32x4*)(lwbuf + go_); pf_a = *(const GAS u32x4*)(abuf + go_); } while (0)
            for (int it = bx; it < 4096; it += G) {
                W1_LOAD(it);
                const int hd = it >> 5, c = it & 31, b = hd >> 4, h = hd & 15;
                const size_t tok0 = (size_t)b * T + c * 64;
                const int t = tid >> 3, c8 = tid & 7;
                f32x4 al0, al1, be0, be1, km0, km1, r0, r1, lq0, lq1;
                {
                    f32x4 k0, k1, v0, v1, a0, a1;
                    unpack8(pf_r, r0, r1); unpack8(pf_k, k0, k1); unpack8(pf_v, v0, v1); unpack8(pf_l, lq0, lq1); unpack8(pf_a, a0, a1);
                    const int co = h * 64 + 8 * c8;
                    const f32x4 kk0w = *(const GAS f32x4*)(k_k + co), kk1w = *(const GAS f32x4*)(k_k + co + 4), ka0 = *(const GAS f32x4*)(k_a + co), ka1 = *(const GAS f32x4*)(k_a + co + 4);
                    const f32x4 rk0 = *(const GAS f32x4*)(r_k + co), rk1 = *(const GAS f32x4*)(r_k + co + 4);
                    f32x4 kk0 = k0 * kk0w, kk1 = k1 * kk1w; float n2 = 0.f, bon = 0.f;
#pragma unroll
                    for (int e = 0; e < 4; ++e) { n2 += kk0[e] * kk0[e] + kk1[e] * kk1[e]; km0[e] = k0[e] * (1.0f + (a0[e] - 1.0f) * ka0[e]); km1[e] = k1[e] * (1.0f + (a1[e] - 1.0f) * ka1[e]);
                        bon += r0[e] * km0[e] * rk0[e] + r1[e] * km1[e] * rk1[e]; }
                    n2 = quad_sum(n2); n2 += dpp_f<0x141>(n2); bon = quad_sum(bon); bon += dpp_f<0x141>(bon);
                    const float inv = 1.0f / fmaxf(sqrtf(n2), 1e-12f); kk0 = kk0 * inv; kk1 = kk1 * inv;
                    al0 = -kk0; al1 = -kk1; be0 = kk0 * a0; be1 = kk1 * a1;
                    if (c8 == 0) cbon[(tok0 + t) * 16 + h] = bon;
                    *(LAS f32x4*)(F_G + t * 64 + 8 * c8) = lq0; *(LAS f32x4*)(F_G + t * 64 + 8 * c8 + 4) = lq1;
                    *(LAS u32x4*)(T_V + t * LD + 8 * c8) = pack8(v0, v1);
                }
                __syncthreads();
                {
                    const int jj = tid & 63, seg = tid >> 6; float pv[8]; float run = 0.f;
#pragma unroll
                    for (int e = 0; e < 8; ++e) { run += F_G[(8 * seg + e) * 64 + jj]; pv[e] = run; }
                    F_SEG[seg * 64 + jj] = run;
                    __syncthreads();
                    float offs = 0.f;
#pragma unroll
                    for (int s_ = 0; s_ < 7; ++s_) offs += (s_ < seg) ? F_SEG[s_ * 64 + jj] : 0.f;
#pragma unroll
                    for (int e = 0; e < 8; ++e) F_G[(8 * seg + e) * 64 + jj] = pv[e] + offs;
                    if (seg == 7) F_PL[jj] = __expf(pv[7] + offs);
                }
                __syncthreads();
                {
                    const f32x4 g0 = *(const LAS f32x4*)(F_G + t * 64 + 8 * c8), g1 = *(const LAS f32x4*)(F_G + t * 64 + 8 * c8 + 4);
                    f32x4 ab0, ab1, rb0, rb1, bt0, bt1, kt0, kt1;
#pragma unroll
                    for (int e = 0; e < 4; ++e) { const float eg0 = __expf(g0[e]), eg1 = __expf(g1[e]), em0 = __expf(g0[e] - lq0[e]), em1 = __expf(g1[e] - lq1[e]), ei0 = __expf(-g0[e]), ei1 = __expf(-g1[e]);
                        ab0[e] = al0[e] * em0; ab1[e] = al1[e] * em1; rb0[e] = r0[e] * eg0; rb1[e] = r1[e] * eg1; bt0[e] = be0[e] * ei0; bt1[e] = be1[e] * ei1; kt0[e] = km0[e] * ei0; kt1[e] = km1[e] * ei1; }
                    *(LAS u32x4*)(T_ABAR + t * LD + 8 * c8) = pack8(ab0, ab1); *(LAS u32x4*)(T_RBAR + t * LD + 8 * c8) = pack8(rb0, rb1);
                    *(LAS u32x4*)(T_BT + t * LD + 8 * c8) = pack8(bt0, bt1); *(LAS u32x4*)(T_KT + t * LD + 8 * c8) = pack8(kt0, kt1);
                }
                __syncthreads();
                {
                    const int jj = tid & 63, seg = tid >> 6;
                    unsigned wb[4], wk_[4], wv_[4];
#pragma unroll
                    for (int e = 0; e < 4; ++e) { const int s0 = 8 * seg + 2 * e;
                        wb[e] = (unsigned)T_BT[s0 * LD + jj] | ((unsigned)T_BT[(s0 + 1) * LD + jj] << 16); wk_[e] = (unsigned)T_KT[s0 * LD + jj] | ((unsigned)T_KT[(s0 + 1) * LD + jj] << 16);
                        wv_[e] = (unsigned)T_V[s0 * LD + jj] | ((unsigned)T_V[(s0 + 1) * LD + jj] << 16); }
                    *(LAS u32x4*)(T_BTT + jj * LD + 8 * seg) = (u32x4){wb[0], wb[1], wb[2], wb[3]}; *(LAS u32x4*)(T_KTT + jj * LD + 8 * seg) = (u32x4){wk_[0], wk_[1], wk_[2], wk_[3]};
                    *(LAS u32x4*)(T_VT + jj * LD + 8 * seg) = (u32x4){wv_[0], wv_[1], wv_[2], wv_[3]};
                }
                __syncthreads();
                {
                    const int pidx = wave >> 1, mh = wave & 1;
                    const LAS bf16_t* At_ = (pidx < 2) ? T_ABAR : T_RBAR; const LAS bf16_t* Bt_ = (pidx & 1) ? T_KT : T_BT;
                    LAS bf16_t* Ot = (pidx == 0) ? T_AAB : ((pidx == 1) ? T_AAK : ((pidx == 2) ? T_ABR : T_AKR));
#pragma unroll
                    for (int mi = 0; mi < 2; ++mi)
#pragma unroll
                        for (int nt = 0; nt < 4; ++nt) { const int mt = 2 * mh + mi; f32x4 acc = (f32x4){0.f, 0.f, 0.f, 0.f};
                            TILE_MMA(acc, At_, 16 * mt, Bt_, 16 * nt);
                            const int s_ = 16 * nt + r;
#pragma unroll
                            for (int e = 0; e < 4; ++e) { const int tt = 16 * mt + 4 * q + e; const bool keep = (pidx < 2) ? (s_ < tt) : (s_ <= tt); const float v_ = keep ? acc[e] : 0.f;
                                Ot[tt * LD + s_] = (bf16_t)(cvt_pk_bf16(v_, 0.f) & 0xffffu);
                                if (pidx == 0 && (mt == nt)) F_DIAG[(mt * 16 + 4 * q + e) * 20 + r] = v_; } }
                }
                __syncthreads();
                {
                    const int mt = wave >> 1;
#pragma unroll
                    for (int nn = 0; nn < 2; ++nn) { const int nt = 2 * (wave & 1) + nn; f32x4 acc = (f32x4){0.f, 0.f, 0.f, 0.f};
                        TILE_MMA(acc, T_AAK, 16 * mt, T_VT, 16 * nt);
#pragma unroll
                        for (int e = 0; e < 4; ++e) F_W[(16 * mt + 4 * q + e) * 64 + 16 * nt + r] = acc[e]; }
                    if (wave == 7) {
                        const int blk = lane >> 4, cc = lane & 15; float x[16];
#pragma unroll
                        for (int tl = 0; tl < 16; ++tl) { float acc = (tl == cc) ? 1.0f : 0.0f;
#pragma unroll
                            for (int s4 = 0; s4 < (tl + 3) / 4; ++s4) { const f32x4 cf = *(const LAS f32x4*)(F_DIAG + (blk * 16 + tl) * 20 + 4 * s4);
#pragma unroll
                                for (int e = 0; e < 4; ++e) if (4 * s4 + e < tl) acc += cf[e] * x[4 * s4 + e]; }
                            x[tl] = acc; F_TI[(blk * 16 + tl) * 16 + cc] = acc; }
                    }
                }
                __syncthreads();
                {
                    const int sub = wave >> 2, ct = wave & 3;
                    LAS bf16_t* OT = (sub == 0) ? T_MTT : T_X1T;
                    { unsigned z_; asm volatile("v_mov_b32 %0, 0" : "=v"(z_)); LAS bf16_t* zr = OT + (16 * ct + r) * LD + 16 * q; *(LAS u32x4*)zr = (u32x4){z_, z_, z_, z_}; *(LAS u32x4*)(zr + 8) = (u32x4){z_, z_, z_, z_}; }
                    asm volatile("s_waitcnt lgkmcnt(0)" ::: "memory");
                    for (int bk = 0; bk < 4; ++bk) {
                        f32x4 d = (f32x4){0.f, 0.f, 0.f, 0.f};
                        if (bk > 0) TILE_MMA(d, T_AAB, 16 * bk, OT, 16 * ct);
#pragma unroll
                        for (int e = 0; e < 4; ++e) { const int tt = 16 * bk + 4 * q + e; d[e] += (sub == 0) ? __uint_as_float((unsigned)T_ABAR[tt * LD + 16 * ct + r] << 16) : F_W[tt * 64 + 16 * ct + r]; }
                        const f32x4 ti4 = *(const LAS f32x4*)(F_TI + (bk * 16 + r) * 16 + 4 * q);
                        f32x4 o = (f32x4){0.f, 0.f, 0.f, 0.f};
#pragma unroll
                        for (int kk = 0; kk < 4; ++kk) o = __builtin_amdgcn_mfma_f32_16x16x4f32(d[kk], ti4[kk], o, 0, 0, 0);
#pragma unroll
                        for (int e = 0; e < 4; ++e) OT[(16 * ct + 4 * q + e) * LD + 16 * bk + r] = (bf16_t)(cvt_pk_bf16(o[e], 0.f) & 0xffffu);
                        asm volatile("s_waitcnt lgkmcnt(0)" ::: "memory");
                    }
                }
                __syncthreads();
                {
                    const int mt = wave >> 1; const int row4 = 16 * mt + 4 * q;
                    GAS bf16_t* nb_it = cnb + (size_t)it * 4096; GAS bf16_t* qb_it = cqb + (size_t)it * 4096; GAS bf16_t* zb_it = czb + (size_t)it * 4096; GAS bf16_t* yl_it = cyl + (size_t)it * 4096;
#pragma unroll
                    for (int nn = 0; nn < 2; ++nn) { const int nt = 2 * (wave & 1) + nn; const int col = 16 * nt + r;
                        {
                            f32x4 acc = (f32x4){0.f, 0.f, 0.f, 0.f}; TILE_MMA(acc, T_MTT, 16 * mt, T_ABR, 16 * nt);
                            const u32x2 rb = *(const LAS u32x2*)(T_RBAR + col * LD + row4);
                            acc[0] += bf_lo(rb.x); acc[1] += bf_hi(rb.x); acc[2] += bf_lo(rb.y); acc[3] += bf_hi(rb.y);
                            u32x2 o; o.x = cvt_pk_bf16(acc[0], acc[1]); o.y = cvt_pk_bf16(acc[2], acc[3]); *(GAS u32x2*)(nb_it + col * 64 + row4) = o; } __builtin_amdgcn_sched_barrier(0);
                        {
                            f32x4 acc = (f32x4){0.f, 0.f, 0.f, 0.f}; TILE_MMA(acc, T_X1T, 16 * mt, T_ABR, 16 * nt); TILE_MMA(acc, T_VT, 16 * mt, T_AKR, 16 * nt);
                            u32x2 o; o.x = cvt_pk_bf16(acc[0], acc[1]); o.y = cvt_pk_bf16(acc[2], acc[3]); *(GAS u32x2*)(yl_it + ((mt * 4 + nt) * 64 + lane) * 4) = o; } __builtin_amdgcn_sched_barrier(0);
                        {
                            f32x4 acc = (f32x4){0.f, 0.f, 0.f, 0.f}; TILE_MMA(acc, T_MTT, 16 * mt, T_BTT, 16 * nt);
                            const float pl = F_PL[col];
#pragma unroll
                            for (int e = 0; e < 4; ++e) acc[e] = pl * (acc[e] + ((row4 + e == col) ? 1.0f : 0.0f));
                            u32x2 o; o.x = cvt_pk_bf16(acc[0], acc[1]); o.y = cvt_pk_bf16(acc[2], acc[3]); *(GAS u32x2*)(qb_it + col * 64 + 32 * (mt >> 1) + 8 * q + 4 * (mt & 1)) = o; } __builtin_amdgcn_sched_barrier(0);
                        {
                            f32x4 acc = (f32x4){0.f, 0.f, 0.f, 0.f}; TILE_MMA(acc, T_BTT, 16 * mt, T_X1T, 16 * nt); TILE_MMA(acc, T_KTT, 16 * mt, T_VT, 16 * nt);
                            const f32x4 pl = *(const LAS f32x4*)(F_PL + row4);
                            u32x2 o; o.x = cvt_pk_bf16(acc[0] * pl[0], acc[1] * pl[1]); o.y = cvt_pk_bf16(acc[2] * pl[2], acc[3] * pl[3]); *(GAS u32x2*)(zb_it + col * 64 + row4) = o; } __builtin_amdgcn_sched_barrier(0);
                    }
                }
                __syncthreads();
            }
#undef TILE_MMA
#undef W1_LOAD
        #if MK_STAMP == 6
            __syncthreads(); STAMP_AT(3, true); __syncthreads(); if (tid == 0) MISC[40] = 0u;
#endif
        }
        SEAM(pb + 3);

        for (int rep_ = 0; rep_ <= ((MK_REPEAT >> 4) & 1); ++rep_) if (IN(pb + 4)) {
            PHASE_BASE();
            const int r = lane & 15, q = lane >> 4;
            for (int wi = 2 * vcu + wave; wave < 2 && wi < 512; wi += 2 * G) {
                const int hd = wi >> 2, iq = wi & 3, i = 16 * iq + r;
                f32x4 Dt[4];
#pragma unroll
                for (int mt = 0; mt < 4; ++mt) Dt[mt] = (f32x4){0.f, 0.f, 0.f, 0.f};
                u32x4 qa0[4][2], qa1[4][2], qa2[4][2], qa3[4][2]; u32x2 za0[4], za1[4], za2[4], za3[4];
#define W2_LOAD(qa, za, c_) do { const GAS bf16_t* qb_ = cqb + ((size_t)hd * 32 + (c_)) * 4096; const GAS bf16_t* zb_ = czb + ((size_t)hd * 32 + (c_)) * 4096; \
                    _Pragma("unroll") for (int mt = 0; mt < 4; ++mt) { za[mt] = *(const GAS u32x2*)(zb_ + i * 64 + 16 * mt + 4 * q); \
                        _Pragma("unroll") for (int ks = 0; ks < 2; ++ks) qa[mt][ks] = *(const GAS u32x4*)(qb_ + (16 * mt + r) * 64 + 32 * ks + 8 * q); } } while (0)
#define W2_STEP(qa, za, c_) do { GAS bf16_t* sb_ = csb + ((size_t)hd * 32 + (c_)) * 4096 + i * 64 + 4 * q; u32x2 pk[4]; \
                    _Pragma("unroll") for (int mt = 0; mt < 4; ++mt) { pk[mt].x = cvt_pk_bf16(Dt[mt][0], Dt[mt][1]); pk[mt].y = cvt_pk_bf16(Dt[mt][2], Dt[mt][3]); *(GAS u32x2*)(sb_ + 16 * mt) = pk[mt]; } \
                    _Pragma("unroll") for (int mt = 0; mt < 4; ++mt) { f32x4 acc = (f32x4){bf_lo(za[mt].x), bf_hi(za[mt].x), bf_lo(za[mt].y), bf_hi(za[mt].y)}; \
                        _Pragma("unroll") for (int ks = 0; ks < 2; ++ks) { const u32x4 aw = qa[mt][ks]; const u32x4 bw = (u32x4){pk[2 * ks].x, pk[2 * ks].y, pk[2 * ks + 1].x, pk[2 * ks + 1].y}; \
                            acc = __builtin_amdgcn_mfma_f32_16x16x32_bf16(__builtin_bit_cast(bf16x8, aw), __builtin_bit_cast(bf16x8, bw), acc, 0, 0, 0); } \
                        Dt[mt] = acc; } } while (0)
                W2_LOAD(qa0, za0, 0); W2_LOAD(qa1, za1, 1); W2_LOAD(qa2, za2, 2); W2_LOAD(qa3, za3, 3);
                for (int c = 0; c < 32; c += 4) {
                    W2_STEP(qa0, za0, c);     if (c + 4 < 32) W2_LOAD(qa0, za0, c + 4);
                    W2_STEP(qa1, za1, c + 1); if (c + 5 < 32) W2_LOAD(qa1, za1, c + 5);
                    W2_STEP(qa2, za2, c + 2); if (c + 6 < 32) W2_LOAD(qa2, za2, c + 6);
                    W2_STEP(qa3, za3, c + 3); if (c + 7 < 32) W2_LOAD(qa3, za3, c + 7);
                }
#undef W2_LOAD
#undef W2_STEP
            }
        }
        SEAM(pb + 4);

        for (int rep_ = 0; rep_ <= ((MK_REPEAT >> 5) & 1); ++rep_) if (IN(pb + 5)) {
            PHASE_BASE();
            const int r = lane & 15, q = lane >> 4;
            const GAS float* lnw = INP(17) + (size_t)j * D; const GAS float* lnb = INP(18) + (size_t)j * D;
            for (int it = gw; it < 4096; it += NGW) {
                const int hd = it >> 5, c = it & 31, b = hd >> 4, h = hd & 15;
                const size_t tok0 = (size_t)b * T + c * 64;
                const GAS bf16_t* sb_ = csb + (size_t)it * 4096; const GAS bf16_t* nb_ = cnb + (size_t)it * 4096; const GAS bf16_t* yl_ = cyl + (size_t)it * 4096;
                bf16x8 af[4][2], bfm[4][2];
#pragma unroll
                for (int mt = 0; mt < 4; ++mt)
#pragma unroll
                    for (int ks = 0; ks < 2; ++ks) { af[mt][ks] = *(const GAS bf16x8*)(sb_ + (16 * mt + r) * 64 + 32 * ks + 8 * q); bfm[mt][ks] = *(const GAS bf16x8*)(nb_ + (16 * mt + r) * 64 + 32 * ks + 8 * q); }
                u32x2 ylr[4][4], vr[4][4], gr[4][4]; float bonr[4]; f32x4 lw4[4], lb4[4];
#pragma unroll
                for (int nt = 0; nt < 4; ++nt) { const size_t tok = tok0 + 16 * nt + r; bonr[nt] = cbon[tok * 16 + h];
#pragma unroll
                    for (int mt = 0; mt < 4; ++mt) { const int ch = h * 64 + 16 * mt + 4 * q;
                        ylr[nt][mt] = *(const GAS u32x2*)(yl_ + ((mt * 4 + nt) * 64 + lane) * 4); vr[nt][mt] = *(const GAS u32x2*)(vbuf + tok * D + ch); gr[nt][mt] = *(const GAS u32x2*)(gbuf + tok * D + ch); } }
#pragma unroll
                for (int mt = 0; mt < 4; ++mt) { const int ch = h * 64 + 16 * mt + 4 * q; lw4[mt] = *(const GAS f32x4*)(lnw + ch); lb4[mt] = *(const GAS f32x4*)(lnb + ch); }
                asm volatile("" ::: "memory");
                u32x2 wout[4][4];
#pragma unroll
                for (int nt = 0; nt < 4; ++nt) {
                    f32x4 acc[4]; float sum = 0.f;
#pragma unroll
                    for (int mt = 0; mt < 4; ++mt) { const u32x2 yl2 = ylr[nt][mt];
                        acc[mt] = (f32x4){bf_lo(yl2.x), bf_hi(yl2.x), bf_lo(yl2.y), bf_hi(yl2.y)};
#pragma unroll
                        for (int ks = 0; ks < 2; ++ks) acc[mt] = __builtin_amdgcn_mfma_f32_16x16x32_bf16(af[mt][ks], bfm[nt][ks], acc[mt], 0, 0, 0);
                        sum += (acc[mt][0] + acc[mt][1]) + (acc[mt][2] + acc[mt][3]); }
                    sum += __int_as_float(__builtin_amdgcn_ds_bpermute(4 * (lane ^ 16), __float_as_int(sum))); sum += __int_as_float(__builtin_amdgcn_ds_bpermute(4 * (lane ^ 32), __float_as_int(sum)));
                    const float mean = sum * (1.0f / 64.0f); float sq = 0.f;
#pragma unroll
                    for (int mt = 0; mt < 4; ++mt)
#pragma unroll
                        for (int e = 0; e < 4; ++e) { const float d_ = acc[mt][e] - mean; sq += d_ * d_; }
                    sq += __int_as_float(__builtin_amdgcn_ds_bpermute(4 * (lane ^ 16), __float_as_int(sq))); sq += __int_as_float(__builtin_amdgcn_ds_bpermute(4 * (lane ^ 32), __float_as_int(sq)));
                    const float rstd = rsqrtf(sq * (1.0f / 64.0f) + LNX_EPS);
                    const float bon = bonr[nt];
#pragma unroll
                    for (int mt = 0; mt < 4; ++mt) {
                        const u32x2 v2 = vr[nt][mt], g2 = gr[nt][mt];
                        const f32x4 v4 = (f32x4){bf_lo(v2.x), bf_hi(v2.x), bf_lo(v2.y), bf_hi(v2.y)}, g4 = (f32x4){bf_lo(g2.x), bf_hi(g2.x), bf_lo(g2.y), bf_hi(g2.y)};
                        f32x4 o;
#pragma unroll
                        for (int e = 0; e < 4; ++e) o[e] = (((acc[mt][e] - mean) * rstd) * lw4[mt][e] + lb4[mt][e] + bon * v4[e]) * g4[e];
                        wout[nt][mt].x = cvt_pk_bf16(o[0], o[1]); wout[nt][mt].y = cvt_pk_bf16(o[2], o[3]); }
                }
#pragma unroll
                for (int nt = 0; nt < 4; ++nt) { const size_t tok = tok0 + 16 * nt + r;
#pragma unroll
                    for (int mt = 0; mt < 4; ++mt) *(GAS u32x2*)(yg + tok * D + h * 64 + 16 * mt + 4 * q) = wout[nt][mt]; }
            }
        }
        SEAM(pb + 5);
#undef cqb
#undef cnb
#undef czb
#undef cyl
#undef csb
#undef cbon
#else
        for (int rep_ = 0; rep_ <= ((MK_REPEAT >> 3) & 1); ++rep_) if (IN(pb + 3)) {
            PHASE_BASE();
            constexpr int VB = 5 * 2048 + 1024 + 64;
            LAS float* sbuf = (LAS float*)lds;
            LAS float* syb = sbuf + 2 * VB;
            const GAS float* k_k = INP(14) + (size_t)j * D; const GAS float* k_a = INP(15) + (size_t)j * D;
            constexpr int NBLK = T / 32;
            for (int item = bx; item < 256; item += G) {
                const int b = item >> 5, h = (item >> 1) & 15, half = item & 1;
                const int pt = tid >> 4, pc = tid & 15;
                const int ch0 = h * 64 + 4 * pc;
                const f32x4 kkw = *(const GAS f32x4*)(k_k + ch0), kaw = *(const GAS f32x4*)(k_a + ch0);
                const int srow = wave * 4 + (lane >> 4), sc = lane & 15;
                const GAS bf16_t* rp = rbuf + ((size_t)b * T + pt) * D + ch0; const GAS bf16_t* kp = kbuf + ((size_t)b * T + pt) * D + ch0; const GAS bf16_t* vp = vbuf + ((size_t)b * T + pt) * D + ch0;
                const GAS bf16_t* lp = lwbuf + ((size_t)b * T + pt) * D + ch0; const GAS bf16_t* ap = abuf + ((size_t)b * T + pt) * D + ch0;
                GAS float* yp = yraw + ((size_t)b * T + pt) * D + h * 64 + half * 32 + 2 * pc;
                u32x2 pr_, pk_, pv_, pl_, pa_;
#define SCAN_LOAD(blk_) do { const size_t o_ = (size_t)(blk_) * 32 * D; pr_ = *(const GAS u32x2*)(rp + o_); pk_ = *(const GAS u32x2*)(kp + o_); pv_ = *(const GAS u32x2*)(vp + o_); pl_ = *(const GAS u32x2*)(lp + o_); pa_ = *(const GAS u32x2*)(ap + o_); } while (0)
#define SCAN_PREP(buf_) do { LAS float* B_ = sbuf + (buf_) * VB; \
                    const f32x4 r4 = (f32x4){bf_lo(pr_.x), bf_hi(pr_.x), bf_lo(pr_.y), bf_hi(pr_.y)}, k4 = (f32x4){bf_lo(pk_.x), bf_hi(pk_.x), bf_lo(pk_.y), bf_hi(pk_.y)}; \
                    const f32x4 v4 = (f32x4){bf_lo(pv_.x), bf_hi(pv_.x), bf_lo(pv_.y), bf_hi(pv_.y)}, l4 = (f32x4){bf_lo(pl_.x), bf_hi(pl_.x), bf_lo(pl_.y), bf_hi(pl_.y)}; \
                    const f32x4 a4 = (f32x4){bf_lo(pa_.x), bf_hi(pa_.x), bf_lo(pa_.y), bf_hi(pa_.y)}; \
                    f32x4 kk = k4 * kkw; float n2 = kk[0] * kk[0] + kk[1] * kk[1] + kk[2] * kk[2] + kk[3] * kk[3]; n2 = row16_sum(n2); \
                    const float inv = 1.0f / fmaxf(sqrtf(n2), 1e-12f); kk = kk * inv; f32x4 wv, km; \
                    _Pragma("unroll") for (int q = 0; q < 4; ++q) { wv[q] = __expf(l4[q]); km[q] = k4[q] * (1.0f + (a4[q] - 1.0f) * kaw[q]); } \
                    *(LAS f32x4*)(B_ + pt * 64 + 4 * pc) = -kk; *(LAS f32x4*)(B_ + 2048 + pt * 64 + 4 * pc) = wv; *(LAS f32x4*)(B_ + 4096 + pt * 64 + 4 * pc) = kk * a4; \
                    *(LAS f32x4*)(B_ + 6144 + pt * 64 + 4 * pc) = km; *(LAS f32x4*)(B_ + 8192 + pt * 64 + 4 * pc) = wv * r4; \
                    { const f32x4 bb_ = kk * a4; float br_ = bb_[0] * r4[0] + bb_[1] * r4[1] + bb_[2] * r4[2] + bb_[3] * r4[3], kr_ = km[0] * r4[0] + km[1] * r4[1] + km[2] * r4[2] + km[3] * r4[3]; \
                      br_ = row16_sum(br_); kr_ = row16_sum(kr_); if (pc == 0) *(LAS f32x2*)(B_ + 11264 + 2 * pt) = (f32x2){br_, kr_}; } \
                    if ((pc >> 3) == half) *(LAS f32x4*)(B_ + 10240 + pt * 32 + 4 * (pc & 7)) = v4; } while (0)
                f32x2 s01 = {0.f, 0.f}, s23 = {0.f, 0.f};
                SCAN_LOAD(0); SCAN_PREP(0); SCAN_LOAD(1);
                __syncthreads();
                for (int blk = 0; blk < NBLK; ++blk) {
                    if (blk + 1 < NBLK) SCAN_PREP((blk + 1) & 1);
                    if (blk + 2 < NBLK) SCAN_LOAD(blk + 2);
                    if (blk > 0) *(GAS f32x2*)(yp + (size_t)(blk - 1) * 32 * D) = *(const LAS f32x2*)(syb + ((blk - 1) & 1) * 1024 + pt * 32 + 2 * pc);
                    const LAS float* B_ = sbuf + (blk & 1) * VB + 4 * sc; const LAS float* V_ = sbuf + (blk & 1) * VB + 10240 + srow;
                    LAS float* yb = syb + (blk & 1) * 1024 + srow;
                    const LAS float* C_ = sbuf + (blk & 1) * VB + 11264;
                    f32x4 al = *(const LAS f32x4*)(B_), w4 = *(const LAS f32x4*)(B_ + 2048), be = *(const LAS f32x4*)(B_ + 4096), km = *(const LAS f32x4*)(B_ + 6144), wr4 = *(const LAS f32x4*)(B_ + 8192);
                    float vi = V_[0]; f32x2 sc2 = *(const LAS f32x2*)(C_);
#pragma unroll 8
                    for (int t = 0; t < 32; ++t) {
                        const int tn = (t + 1) & 31;
                        const f32x4 al_n = *(const LAS f32x4*)(B_ + tn * 64), w4_n = *(const LAS f32x4*)(B_ + 2048 + tn * 64), be_n = *(const LAS f32x4*)(B_ + 4096 + tn * 64);
                        const f32x4 km_n = *(const LAS f32x4*)(B_ + 6144 + tn * 64), wr_n = *(const LAS f32x4*)(B_ + 8192 + tn * 64); const float vi_n = V_[tn * 32]; const f32x2 sc2_n = *(const LAS f32x2*)(C_ + 2 * tn);
                        const f32x2 p = s01 * (f32x2){al[0], al[1]} + s23 * (f32x2){al[2], al[3]};
                        const f32x2 q = s01 * (f32x2){wr4[0], wr4[1]} + s23 * (f32x2){wr4[2], wr4[3]};
                        float sa = p.x + p.y, yo = q.x + q.y;
                        sa += dpp_f<0xB1>(sa); yo += dpp_f<0xB1>(yo); sa += dpp_f<0x4E>(sa); yo += dpp_f<0x4E>(yo);
                        sa += dpp_f<0x141>(sa); yo += dpp_f<0x141>(yo); sa += dpp_f<0x140>(sa); yo += dpp_f<0x140>(yo);
                        const f32x2 u01 = (f32x2){be[0], be[1]} * sa + (f32x2){km[0], km[1]} * vi, u23 = (f32x2){be[2], be[3]} * sa + (f32x2){km[2], km[3]} * vi;
                        s01 = s01 * (f32x2){w4[0], w4[1]} + u01; s23 = s23 * (f32x2){w4[2], w4[3]} + u23;
                        const float y = yo + sa * sc2.x + vi * sc2.y;
                        if (sc == 0) yb[t * 32] = y;
                        al = al_n; w4 = w4_n; be = be_n; km = km_n; wr4 = wr_n; vi = vi_n; sc2 = sc2_n;
                    }
                    __syncthreads();
                }
                *(GAS f32x2*)(yp + (size_t)(NBLK - 1) * 32 * D) = *(const LAS f32x2*)(syb + ((NBLK - 1) & 1) * 1024 + pt * 32 + 2 * pc);
                __syncthreads();
#undef SCAN_LOAD
#undef SCAN_PREP
            }
        }
        SEAM(pb + 3);

        for (int rep_ = 0; rep_ <= ((MK_REPEAT >> 4) & 1); ++rep_) if (IN(pb + 4)) {
            PHASE_BASE();
            const int c0 = 16 * lane;
            f32x4 ka[4], rk[4], lw_[4], lb_[4];
#pragma unroll
            for (int q = 0; q < 4; ++q) { ka[q] = *(const GAS f32x4*)(INP(15) + (size_t)j * D + c0 + 4 * q); rk[q] = *(const GAS f32x4*)(INP(16) + (size_t)j * D + c0 + 4 * q);
                lw_[q] = *(const GAS f32x4*)(INP(17) + (size_t)j * D + c0 + 4 * q); lb_[q] = *(const GAS f32x4*)(INP(18) + (size_t)j * D + c0 + 4 * q); }
            for (int tok = gw; tok < M; tok += NGW) {
                const size_t off = (size_t)tok * D + c0;
                f32x4 y[4], r[4], k[4], v[4], a[4], g[4];
#pragma unroll
                for (int q = 0; q < 4; ++q) y[q] = *(const GAS f32x4*)(yraw + off + 4 * q);
                unpack8(*(const GAS u32x4*)(rbuf + off), r[0], r[1]); unpack8(*(const GAS u32x4*)(rbuf + off + 8), r[2], r[3]);
                unpack8(*(const GAS u32x4*)(kbuf + off), k[0], k[1]); unpack8(*(const GAS u32x4*)(kbuf + off + 8), k[2], k[3]);
                unpack8(*(const GAS u32x4*)(vbuf + off), v[0], v[1]); unpack8(*(const GAS u32x4*)(vbuf + off + 8), v[2], v[3]);
                unpack8(*(const GAS u32x4*)(abuf + off), a[0], a[1]); unpack8(*(const GAS u32x4*)(abuf + off + 8), a[2], a[3]);
                unpack8(*(const GAS u32x4*)(gbuf + off), g[0], g[1]); unpack8(*(const GAS u32x4*)(gbuf + off + 8), g[2], g[3]);
                float dot = 0.f, sy = 0.f;
#pragma unroll
                for (int q = 0; q < 4; ++q)
#pragma unroll
                    for (int e = 0; e < 4; ++e) { const float km = k[q][e] * (1.0f + (a[q][e] - 1.0f) * ka[q][e]); dot += r[q][e] * km * rk[q][e]; sy += y[q][e]; }
                dot = quad_sum(dot); sy = quad_sum(sy);
                const float mean = sy * (1.0f / 64.0f); float sq = 0.f;
#pragma unroll
                for (int q = 0; q < 4; ++q)
#pragma unroll
                    for (int e = 0; e < 4; ++e) { const float d = y[q][e] - mean; sq += d * d; }
                sq = quad_sum(sq);
                const float rstd = rsqrtf(sq * (1.0f / 64.0f) + LNX_EPS);
                f32x4 o[4];
#pragma unroll
                for (int q = 0; q < 4; ++q)
#pragma unroll
                    for (int e = 0; e < 4; ++e) o[q][e] = (((y[q][e] - mean) * rstd) * lw_[q][e] + lb_[q][e] + dot * v[q][e]) * g[q][e];
                *(GAS u32x4*)(yg + off) = pack8(o[0], o[1]); *(GAS u32x4*)(yg + off + 8) = pack8(o[2], o[3]);
            }
        }
        SEAM(pb + 4);

        SEAM(pb + 5);
#endif

        for (int rep_ = 0; rep_ <= ((MK_REPEAT >> 5) & 1); ++rep_) if (IN(pb + 6)) {
            PHASE_BASE();
            SchedPlain S{uni_ptr((const GAS char*)yg), uni_ptr((const GAS char*)(wr_ + WR_WO)), (size_t)256 * D * 2, (size_t)256 * D * 2, 64, 4, G, bx};
            EpiRes E{hcur, hcur};
            gemm_phase(lds, tid, D, D, D, S, E);
        }
        SEAM(pb + 6);

        for (int rep_ = 0; rep_ <= ((MK_REPEAT >> 6) & 1); ++rep_) if (IN(pb + 7)) {
            PHASE_BASE();
            const GAS float* gn = INP(2) + (size_t)(2 * j) * D;
            f32x4 gq[4];
#pragma unroll
            for (int q = 0; q < 4; ++q) gq[q] = *(const GAS f32x4*)(gn + 4 * lane + 256 * q);
            u32x2 hwn[4];
#pragma unroll
            for (int q = 0; q < 4; ++q) hwn[q] = *(const GAS u32x2*)(hcur + (size_t)gw * D + 4 * lane + 256 * q);
            for (int tok = gw; tok < M; tok += NGW) {
                f32x4 v[4]; float ss = 0.f; u32x2 hwc[4]; const int tn = (tok + NGW < M) ? tok + NGW : tok;
#pragma unroll
                for (int q = 0; q < 4; ++q) hwc[q] = hwn[q];
#pragma unroll
                for (int q = 0; q < 4; ++q) hwn[q] = *(const GAS u32x2*)(hcur + (size_t)tn * D + 4 * lane + 256 * q);
#pragma unroll
                for (int q = 0; q < 4; ++q) { const u32x2 hw = hwc[q]; v[q] = (f32x4){bf_lo(hw.x), bf_hi(hw.x), bf_lo(hw.y), bf_hi(hw.y)}; ss += v[q][0] * v[q][0] + v[q][1] * v[q][1] + v[q][2] * v[q][2] + v[q][3] * v[q][3]; }
                const float rs = rsqrtf(wave_sum(ss) * (1.0f / D) + NORM_EPS);
#pragma unroll
                for (int q = 0; q < 4; ++q) { const f32x4 o = v[q] * rs * gq[q]; u32x2 w; w.x = cvt_pk_bf16(o[0], o[1]); w.y = cvt_pk_bf16(o[2], o[3]); *(GAS u32x2*)(hn2 + (size_t)tok * D + 4 * lane + 256 * q) = w; }
            }
        }
        SEAM(pb + 7);

        for (int rep_ = 0; rep_ <= ((MK_REPEAT >> 7) & 1); ++rep_) if (IN(pb + 8)) {
            PHASE_BASE();
            SchedPlain S{uni_ptr((const GAS char*)hn2), uni_ptr((const GAS char*)(wr_ + WR_GU)), (size_t)256 * D * 2, (size_t)256 * D * 2, 64, FF / 128, G, bx};
            EpiSwiglu E{hmid, FF};
            gemm_phase(lds, tid, D, D, D, S, E);
        }
        SEAM(pb + 8);

        for (int rep_ = 0; rep_ <= ((MK_REPEAT >> 8) & 1); ++rep_) if (IN(pb + 9)) {
            PHASE_BASE();
            SchedPlain S{uni_ptr((const GAS char*)hmid), uni_ptr((const GAS char*)(wr_ + WR_WD)), (size_t)256 * FF * 2, (size_t)256 * FF * 2, 64, 4, G, bx};
            EpiRes E{hcur, hcur};
            gemm_phase(lds, tid, FF, FF, FF, S, E);
        }
        SEAM(pb + 9);

        for (int rep_ = 0; rep_ <= ((MK_REPEAT >> 9) & 1); ++rep_) if (IN(pb + 10)) {
            PHASE_BASE();
            const GAS float* gn = INP(1) + (size_t)(2 * j + 1) * D;
            f32x4 gq[4];
#pragma unroll
            for (int q = 0; q < 4; ++q) gq[q] = *(const GAS f32x4*)(gn + 16 * lane + 4 * q);
            for (int blk = bx; blk < M / 64; blk += G) {
                u32x4 hn0 = *(const GAS u32x4*)(hcur + (size_t)(blk * 64 + wave * 8) * D + 16 * lane), hn1 = *(const GAS u32x4*)(hcur + (size_t)(blk * 64 + wave * 8) * D + 16 * lane + 8);
                for (int tt = 0; tt < 8; ++tt) { const int tok = blk * 64 + wave * 8 + tt; const int tn = tt < 7 ? tok + 1 : tok;
                    f32x4 v[4]; float ss = 0.f;
                    const u32x4 hc0 = hn0, hc1 = hn1;
                    hn0 = *(const GAS u32x4*)(hcur + (size_t)tn * D + 16 * lane); hn1 = *(const GAS u32x4*)(hcur + (size_t)tn * D + 16 * lane + 8);
                    unpack8(hc0, v[0], v[1]); unpack8(hc1, v[2], v[3]);
#pragma unroll
                    for (int q = 0; q < 4; ++q) { ss += v[q][0] * v[q][0] + v[q][1] * v[q][1] + v[q][2] * v[q][2] + v[q][3] * v[q][3]; }
                    const float rs = rsqrtf(wave_sum(ss) * (1.0f / D) + NORM_EPS);
#pragma unroll
                    for (int q = 0; q < 4; ++q) v[q] = v[q] * rs * gq[q];
                    GAS bf16_t* dst = ug + ((size_t)lane * NBC + (tok >> 5)) * S5K + (tok & 31) * 16;
                    *(GAS u32x4*)dst = pack8(v[0], v[1]); *(GAS u32x4*)(dst + 8) = pack8(v[2], v[3]); } }
        }
        SEAM(pb + 10);

#define WG_REREAD_FENCE() do { asm volatile("s_waitcnt vmcnt(0)" ::: "memory"); __syncthreads(); if (tid == 0) { __builtin_amdgcn_fence(__ATOMIC_ACQUIRE, "agent"); asm volatile("s_waitcnt vmcnt(0)" ::: "memory"); } __syncthreads(); } while (0)
        for (int rep_ = 0; rep_ <= ((MK_REPEAT >> 10) & 1); ++rep_) if (IN(pb + 11)) {
            PHASE_BASE();
            for (int mu = vcu; mu < 256; mu += G) {
                const int g = mu >> 2, pm = (mu >> 1) & 1, pn = mu & 1;
                {   SchedOne S{GUnit{uni_ptr((const GAS char*)ug + (size_t)g * NBC * S5K * 2 + (size_t)pm * 256 * S5K * 2), uni_ptr((const GAS char*)(wss + WSS_M1) + (size_t)g * 256 * 512 * 2), pm, 0, g, 0}};
                    EpiS5E E{eb};
                    gemm_phase(lds, tid, 512, S5K, 512, S, E); }
                WG_REREAD_FENCE();
                if (tid < 256) { const int bq = tid >> 6, p = tid & 63, b = 4 * pm + bq;
                    const float lr = fminf(INP(23)[((size_t)j * 64 + g) * 64 + p], -1e-4f), li = INP(24)[((size_t)j * 64 + g) * 64 + p]; const float dt = __expf(INP(25)[j * 64 + g]);
                    const float mag = expf(32.0f * lr * dt); float rev = 32.0f * (li * dt) * 0.15915494309189535f; rev -= floorf(rev);
                    const float ang = (rev > 0.5f ? rev - 1.0f : rev) * 6.283185307179586f; const float are = mag * cosf(ang), aim = mag * sinf(ang);
                    float hre = 0.f, him = 0.f;
#pragma unroll 1
                    for (int c0 = 0; c0 < 64; c0 += 16) {
                        float ere[16], eim[16];
                        const GAS float* ep = eb + ((size_t)g * NBC + b * 64 + c0) * 128 + p;
#pragma unroll
                        for (int q = 0; q < 16; ++q) { ere[q] = ep[q * 128]; eim[q] = ep[q * 128 + 64]; }
                        GAS bf16_t* dst = ug + ((size_t)g * NBC + b * 64 + c0) * S5K + 512 + p;
#pragma unroll
                        for (int q = 0; q < 16; ++q) {
                            dst[(size_t)q * S5K] = (bf16_t)(cvt_pk_bf16(hre, 0.f) & 0xffffu); dst[(size_t)q * S5K + 64] = (bf16_t)(cvt_pk_bf16(him, 0.f) & 0xffffu);
                            const float nre = are * hre - aim * him + ere[q], nim = are * him + aim * hre + eim[q]; hre = nre; him = nim; }
                    }
                }
                WG_REREAD_FENCE();
                {   SchedOne S{GUnit{uni_ptr((const GAS char*)ug + (size_t)g * NBC * S5K * 2 + (size_t)pm * 256 * S5K * 2), uni_ptr((const GAS char*)(wss + WSS_TOEP) + (size_t)g * 512 * S5K * 2 + (size_t)pn * 256 * S5K * 2), pm, pn, g, 0}};
                    EpiS5Y E{yact, ug, INP(30) + (size_t)j * D};
                    gemm_phase(lds, tid, S5K, S5K, S5K, S, E); }
            }
        }
        SEAM(pb + 11);
#undef WG_REREAD_FENCE

        for (int rep_ = 0; rep_ <= ((MK_REPEAT >> 13) & 1); ++rep_) if (IN(pb + 14)) {
            PHASE_BASE();
            SchedPlain S{uni_ptr((const GAS char*)yact), uni_ptr((const GAS char*)(wss + WSS_GLU)), (size_t)256 * D * 2, (size_t)256 * D * 2, 64, 8, G, bx};
            EpiGlu E{hcur, INP(32) + (size_t)j * 2 * D};
            gemm_phase(lds, tid, D, D, D, S, E);
        }
        SEAM(pb + 14);

        for (int rep_ = 0; rep_ <= ((MK_REPEAT >> 14) & 1); ++rep_) if (IN(pb + 15)) {
            PHASE_BASE();
            LAS float* srt = (LAS float*)lds;
            LAS unsigned* stg = (LAS unsigned*)(srt + 8192);
            {   f32x4 rw[4];
#pragma unroll
                for (int u = 0; u < 4; ++u) rw[u] = *(const GAS f32x4*)(INP(36) + (size_t)j * 8192 + 4 * (tid + NTHREADS * u));
#pragma unroll
                for (int u = 0; u < 4; ++u) { const int i = 4 * (tid + NTHREADS * u);
#pragma unroll
                    for (int z = 0; z < 4; ++z) srt[((i + z) & 7) * 1024 + ((i + z) >> 3)] = rw[u][z]; } }
            const GAS float* gn = INP(2) + (size_t)(2 * j + 1) * D;
            f32x4 gq[4];
#pragma unroll
            for (int q = 0; q < 4; ++q) gq[q] = *(const GAS f32x4*)(gn + 4 * lane + 256 * q);
            __syncthreads();
            for (int blk = bx; blk < M / 64; blk += G) {
                u32x2 hwn[4];
#pragma unroll
                for (int q = 0; q < 4; ++q) hwn[q] = *(const GAS u32x2*)(hcur + (size_t)(blk * 64 + wave * 8) * D + 4 * lane + 256 * q);
                for (int tt = 0; tt < 8; ++tt) { const int tok = blk * 64 + wave * 8 + tt; const int tn = tt < 7 ? tok + 1 : tok;
                    f32x4 v[4]; float ss = 0.f; u32x2 hwc[4];
#pragma unroll
                    for (int q = 0; q < 4; ++q) hwc[q] = hwn[q];
#pragma unroll
                    for (int q = 0; q < 4; ++q) hwn[q] = *(const GAS u32x2*)(hcur + (size_t)tn * D + 4 * lane + 256 * q);
#pragma unroll
                    for (int q = 0; q < 4; ++q) { const u32x2 hw = hwc[q]; v[q] = (f32x4){bf_lo(hw.x), bf_hi(hw.x), bf_lo(hw.y), bf_hi(hw.y)}; ss += v[q][0] * v[q][0] + v[q][1] * v[q][1] + v[q][2] * v[q][2] + v[q][3] * v[q][3]; }
                    const float rs = rsqrtf(wave_sum(ss) * (1.0f / D) + NORM_EPS);
                    float lg[8];
#pragma unroll
                    for (int e = 0; e < 8; ++e) lg[e] = 0.f;
#pragma unroll
                    for (int q = 0; q < 4; ++q) { const f32x4 o = v[q] * rs * gq[q]; u32x2 w; w.x = cvt_pk_bf16(o[0], o[1]); w.y = cvt_pk_bf16(o[2], o[3]); *(GAS u32x2*)(hn2 + (size_t)tok * D + 4 * lane + 256 * q) = w;
#pragma unroll
                        for (int e = 0; e < 8; ++e) { const f32x4 rr = *(const LAS f32x4*)(srt + e * 1024 + 4 * lane + 256 * q);
                            lg[e] += o[0] * rr[0]; lg[e] += o[1] * rr[1]; lg[e] += o[2] * rr[2]; lg[e] += o[3] * rr[3]; } }
#pragma unroll
                    for (int e = 0; e < 8; ++e) lg[e] = wave_sum(lg[e]);
                    int e0 = 0; float v0 = lg[0];
#pragma unroll
                    for (int e = 1; e < 8; ++e) if (lg[e] > v0) { v0 = lg[e]; e0 = e; }
                    int e1 = -1; float v1 = -3.0e38f;
#pragma unroll
                    for (int e = 0; e < 8; ++e) if (e != e0 && lg[e] > v1) { v1 = lg[e]; e1 = e; }
                    const float g0 = 1.0f / (1.0f + expf(v1 - v0)), g1 = 1.0f - g0;
                    if (lane == 0) { const int lt = wave * 8 + tt; stg[lt * 4 + 0] = (unsigned)e0; stg[lt * 4 + 1] = (unsigned)e1; stg[lt * 4 + 2] = __float_as_uint(g0); stg[lt * 4 + 3] = __float_as_uint(g1); }
                }
                __syncthreads();
                if (wave == 0) { const int tok = blk * 64 + lane;
                    const int e0 = (int)stg[lane * 4 + 0], e1 = (int)stg[lane * 4 + 1]; const float g0 = __uint_as_float(stg[lane * 4 + 2]), g1 = __uint_as_float(stg[lane * 4 + 3]);
                    const unsigned long long lt_mask = (lane == 0) ? 0ull : (~0ull >> (64 - lane));
                    unsigned pos0 = 0, pos1 = 0;
#pragma unroll
                    for (int e = 0; e < 8; ++e) { const unsigned long long m0 = __ballot(e0 == e), m1 = __ballot(e1 == e); const unsigned n0 = (unsigned)__popcll(m0), n1 = (unsigned)__popcll(m1);
                        if (lane == 0) blkcnt[blk * 8 + e] = n0 + n1;
                        if (e0 == e) pos0 = (unsigned)__popcll(m0 & lt_mask);
                        if (e1 == e) pos1 = n0 + (unsigned)__popcll(m1 & lt_mask); }
                    asg_pe[2 * tok] = ((unsigned)e0 << 24) | pos0; asg_pe[2 * tok + 1] = ((unsigned)e1 << 24) | pos1; asg_gate[2 * tok] = g0; asg_gate[2 * tok + 1] = g1; }
                __syncthreads();
            }
        }
        SEAM(pb + 15);

        if (IN(pb + 16) || IN(pb + 17) || IN(pb + 18)) {
            PHASE_BASE();
            LAS unsigned* sbase = (LAS unsigned*)(lds + 65536);
            { const int e = wave; unsigned c[4]; unsigned tot = 0;
#pragma unroll
              for (int i = 0; i < 4; ++i) { c[i] = blkcnt[(4 * lane + i) * 8 + e]; }
              unsigned run = c[0] + c[1] + c[2] + c[3], incl = run;
#pragma unroll
              for (int o = 1; o < 64; o <<= 1) { const unsigned t_ = (unsigned)__builtin_amdgcn_ds_bpermute(4 * (lane - o), (int)incl); if (lane >= o) incl += t_; }
              unsigned ex = incl - run;
#pragma unroll
              for (int i = 0; i < 4; ++i) { sbase[(4 * lane + i) * 8 + e] = ex; ex += c[i]; }
              tot = (unsigned)__builtin_amdgcn_readlane((int)incl, 63);
              if (lane == 0) MISC[32 + e] = tot; }
            __syncthreads();
            if (tid == 0) { unsigned acc_ = 0; MISC[16] = 0u;
                for (int e = 0; e < 8; ++e) { const unsigned c = MISC[32 + e]; acc_ += (c + 255u) >> 8; MISC[17 + e] = acc_; } }
            __syncthreads();
        }
        for (int rep_ = 0; rep_ <= ((MK_REPEAT >> 15) & 1); ++rep_) if (IN(pb + 16)) {
            PHASE_BASE();
            unsigned cnt[8], pst[8];
#pragma unroll
            for (int e = 0; e < 8; ++e) { cnt[e] = MISC[32 + e]; pst[e] = MISC[16 + e] * 256u; }
            const LAS unsigned* sbase = (const LAS unsigned*)(lds + 65536);
            for (int a = gw * 64 + lane; a < NASG; a += NGW * 64) { const unsigned pe = asg_pe[a]; const int e = (int)(pe >> 24); const unsigned pos = pe & 0xffffffu;
                unsigned ps = 0;
#pragma unroll
                for (int q = 0; q < 8; ++q) ps = (q == e) ? pst[q] : ps;
                const int tok = a >> 1; const unsigned row = ps + sbase[(tok >> 6) * 8 + e] + pos;
                rowslot[row] = a; rowgate[row] = asg_gate[a]; rowtok[row] = tok; ((GAS int*)(wsl + WS_TROW))[a] = ((int)row >= MOE_TAIL_ROW0) ? (int)row - MOE_TAIL_ROW0 : -1; }
            if (bx < 8) {
#pragma unroll
                for (int e = 0; e < 8; ++e) if (e == bx) { const unsigned padded = ((cnt[e] + 255u) >> 8) << 8;
                    for (unsigned r = cnt[e] + tid; r < padded; r += NTHREADS) { rowslot[pst[e] + r] = -1; rowgate[pst[e] + r] = 0.f; rowtok[pst[e] + r] = 0; } }
            }
        }
        SEAM(pb + 16);

        for (int rep_ = 0; rep_ <= ((MK_REPEAT >> 16) & 1); ++rep_) if (IN(pb + 17)) {
            PHASE_BASE();
            SchedMoeG S{uni_ptr((const GAS char*)hn2), uni_ptr((const GAS char*)(wsl + WS_WM + WM_GU)), (size_t)2 * FE * D * 2, (size_t)256 * D * 2, FE / 128, G, bx, MISC + 16, rowtok};
#if MK_EPISKIP
            EpiSwiglu E{hmidm, FE, rep_};
#else
            EpiSwiglu E{hmidm, FE};
#endif
#if MK_STAMP && MK_STAMP != 6
            if (j == 0 && tid == 0) MISC[40] = 1u;
            __syncthreads();
#endif
            gemm_phase(lds, tid, D, D, D, S, E);
#if MK_STAMP
            __syncthreads();
            if (tid == 0) MISC[40] = 0u;
#endif
        }
        SEAM(pb + 17);

        for (int rep_ = 0; rep_ <= ((MK_REPEAT >> 17) & 1); ++rep_) if (IN(pb + 18)) {
            PHASE_BASE();
            EpiMoeDown E{y2, rowslot, rowgate, (GAS bf16_t*)(wsl + WS_Y2T)};
            {   SchedMoeMain S{uni_ptr((const GAS char*)hmidm), uni_ptr((const GAS char*)(wsl + WS_WM + WM_WD)), (size_t)256 * FE * 2, (size_t)D * FE * 2, (size_t)256 * FE * 2, 4, G, bx, MISC + 16};
                gemm_phase(lds, tid, FE, FE, FE, S, E); }
            {   SchedMoeTail S{uni_ptr((const GAS char*)hmidm), uni_ptr((const GAS char*)(wsl + WS_WM + WM_WD)), (size_t)256 * FE * 2, (size_t)D * FE * 2, (size_t)256 * FE * 2, (size_t)(FE / 4) * 2, G, vcu, MISC + 16};
                gemm_phase(lds, tid, FE / 4, FE, FE, S, E); }
        }
        SEAM(pb + 18);
    }

    if (MK_N_LAUNCHES == 1 && hi < NPH - 1) xcd_barrier(bar);
#if MK_PROBE_SRC >= 2
    if (IN(NPH - 1)) {
        PHASE_BASE();
        for (int tok = gw; tok < M; tok += NGW) {
#pragma unroll
            for (int q = 0; q < 4; ++q) { f32x4 x;
                if (MK_PROBE_SRC == 2) { const u32x2 w = *(const GAS u32x2*)((const GAS bf16_t*)(ar + MK_PROBE_OFF) + (size_t)tok * D + 4 * lane + 256 * q); x = (f32x4){bf_lo(w.x), bf_hi(w.x), bf_lo(w.y), bf_hi(w.y)}; }
                else if (MK_PROBE_SRC == 5) { x = *(const GAS f32x4*)(INP(MK_PROBE_INP) + 4 * lane + 256 * q); }
                else if (MK_PROBE_SRC == 4) { x = (f32x4){0.f, 0.f, 0.f, 0.f}; const size_t offs[5] = {AR_R, AR_K, (size_t)WS_VF - (size_t)WS_AR, AR_A, AR_G};
#pragma unroll
                    for (int z = 0; z < 5; ++z) { const u32x2 w = *(const GAS u32x2*)((const GAS bf16_t*)(ar + offs[z]) + (size_t)tok * D + 4 * lane + 256 * q); x += (f32x4){bf_lo(w.x), bf_hi(w.x), bf_lo(w.y), bf_hi(w.y)}; } }
                else x = *(const GAS f32x4*)((const GAS float*)(ar + MK_PROBE_OFF) + (size_t)tok * D + 4 * lane + 256 * q);
                *(GAS f32x4*)((GAS float*)args.out + (size_t)tok * D + 4 * lane + 256 * q) = x; }
        }
    }
#else
    if (IN(NPH - 1)) {
        PHASE_BASE();
        f32x4 gq[4];
#pragma unroll
        for (int q = 0; q < 4; ++q) gq[q] = *(const GAS f32x4*)(INP(3) + 4 * lane + 256 * q);
        u32x2 hwn[4], yan[4], ybn[4];
        u32x2 trn = *(const GAS u32x2*)((const GAS int*)(wsl + WS_TROW) + 2 * gw);
#pragma unroll
        for (int q = 0; q < 4; ++q) { hwn[q] = *(const GAS u32x2*)((MK_PROBE_SRC ? hbuf1 : hbuf0) + (size_t)gw * D + 4 * lane + 256 * q);
            yan[q] = *(const GAS u32x2*)(y2 + (size_t)(2 * gw) * D + 4 * lane + 256 * q); ybn[q] = *(const GAS u32x2*)(y2 + (size_t)(2 * gw + 1) * D + 4 * lane + 256 * q); }
        for (int tok = gw; tok < M; tok += NGW) {
            f32x4 v[4]; float ss = 0.f; u32x2 hwc[4], yac[4], ybc[4]; const int tn = (tok + NGW < M) ? tok + NGW : tok;
#pragma unroll
            for (int q = 0; q < 4; ++q) { hwc[q] = hwn[q]; yac[q] = yan[q]; ybc[q] = ybn[q]; }
            const u32x2 trc = trn; trn = *(const GAS u32x2*)((const GAS int*)(wsl + WS_TROW) + 2 * tn);
            const int tr0 = __builtin_amdgcn_readfirstlane((int)trc.x), tr1 = __builtin_amdgcn_readfirstlane((int)trc.y);
#pragma unroll
            for (int q = 0; q < 4; ++q) { hwn[q] = *(const GAS u32x2*)((MK_PROBE_SRC ? hbuf1 : hbuf0) + (size_t)tn * D + 4 * lane + 256 * q);
                yan[q] = *(const GAS u32x2*)(y2 + (size_t)(2 * tn) * D + 4 * lane + 256 * q); ybn[q] = *(const GAS u32x2*)(y2 + (size_t)(2 * tn + 1) * D + 4 * lane + 256 * q); }
#pragma unroll
            for (int q = 0; q < 4; ++q) { const u32x2 hw = hwc[q];
                f32x4 x = (f32x4){bf_lo(hw.x), bf_hi(hw.x), bf_lo(hw.y), bf_hi(hw.y)};
                if (MK_PROBE_Y2) { const u32x2 ya = yac[q], yb = ybc[q];
                x[0] += bf_lo(ya.x) + bf_lo(yb.x); x[1] += bf_hi(ya.x) + bf_hi(yb.x); x[2] += bf_lo(ya.y) + bf_lo(yb.y); x[3] += bf_hi(ya.y) + bf_hi(yb.y);
                Y2T_ADD2(x, tr0, q); Y2T_ADD2(x, tr1, q); }
                v[q] = x; ss += x[0] * x[0] + x[1] * x[1] + x[2] * x[2] + x[3] * x[3]; }
            const float rs = rsqrtf(wave_sum(ss) * (1.0f / D) + NORM_EPS);
#pragma unroll
            for (int q = 0; q < 4; ++q) *(GAS f32x4*)((GAS float*)args.out + (size_t)tok * D + 4 * lane + 256 * q) = v[q] * rs * gq[q];
        }
    }
#endif
#if MK_STAMP
    if (bx0 == 0 && tid0 == 0) {
        volatile LAS unsigned long long* st_ = (volatile LAS unsigned long long*)(lds + MISC_OFF + 256);
        const unsigned long long c0 = st_[0], r0 = st_[1], c1 = st_[2], r1 = st_[3], c2 = st_[4], r2 = st_[5], c3 = st_[6], r3 = st_[7];
        unsigned long long us_ = 0;
        if (MK_STAMP == 1) us_ = (c1 - c0) / 16;
        if (MK_STAMP == 2) us_ = (r1 - r0) * 10 / 16;
        if (MK_STAMP == 3) us_ = (r3 - r0) / 20;
        if (MK_STAMP == 4) us_ = (r2 - r1) * 10 / 2;
        if (MK_STAMP == 5 || MK_STAMP == 6) us_ = (c3 - c0) * 100 / (r3 - r0);
        (void)c2;
        if (us_ > 6000) us_ = 6000;
        const unsigned long long t0_ = __builtin_amdgcn_s_memrealtime();
        while (__builtin_amdgcn_s_memrealtime() - t0_ < us_ * 100) __builtin_amdgcn_s_sleep(16);
    }
#endif
#undef IN
#undef SEAM
#undef hbuf0
#undef vfirst
#undef y2
#undef wr_
#undef wss
#undef hin_l
#undef hcur
#undef xs
#undef rbuf
#undef kbuf
#undef vbuf
#undef l1
#undef lwbuf
#undef abuf
#undef gbuf
#undef yraw
#undef yg
#undef hn2
#undef hmid
#undef ug
#undef eb
#undef yact
#undef asg_pe
#undef asg_gate
#undef xsm
#undef rowslot
#undef rowgate
#undef hmidm
#undef blkcnt
#undef rowtok
#undef INP
#undef PHASE_BASE
}

extern "C" void kernel_launch(void* const* d_in, const int* in_sizes, int n_in, void* d_out, int out_size, void* d_ws, size_t ws_size, hipStream_t stream) {
    static int grid = 0;
    if (grid == 0) {
        if (n_in != 40 || out_size != M * D || ws_size < WS_END) { fprintf(stderr, "kernel_launch: unexpected shapes (n_in %d, out %d, ws %zu < %zu)\n", n_in, out_size, ws_size, (size_t)WS_END); grid = -1; return; }
        int dev = 0, cus = 0, per_cu = 0;
        if (hipGetDevice(&dev) != hipSuccess || hipDeviceGetAttribute(&cus, hipDeviceAttributeMultiprocessorCount, dev) != hipSuccess) { grid = -1; return; }
        if (hipFuncSetAttribute((const void*)mk_fwd, hipFuncAttributeMaxDynamicSharedMemorySize, LDS_BYTES) != hipSuccess) { fprintf(stderr, "kernel_launch: hipFuncSetAttribute failed\n"); grid = -1; return; }
        if (hipOccupancyMaxActiveBlocksPerMultiprocessor(&per_cu, (const void*)mk_fwd, NTHREADS, LDS_BYTES) != hipSuccess || per_cu < 1) fprintf(stderr, "kernel_launch: occupancy query says %d\n", per_cu);
        (void)hipGetLastError();
        grid = cus;
    }
    if (grid < 0) return;
    (void)in_sizes;
#ifdef MK_ZERO_WS
    if (hipMemsetAsync((char*)d_ws, 0, WS_END, stream) != hipSuccess) return;
    if (hipMemsetAsync((char*)d_out, 0, (size_t)M * D * 4, stream) != hipSuccess) return;
#endif
    if (hipMemsetAsync((char*)d_ws + WS_CTL, 0, CTL_BYTES, stream) != hipSuccess) return;
    Args a{};
    for (int i = 0; i < 40; ++i) a.in[i] = (const float*)d_in[i];
    a.out = (float*)d_out; a.ws = (unsigned char*)d_ws;
#if MK_N_LAUNCHES == 1
    a.ph_lo = 0; a.ph_hi = (MK_STOP_AFTER + 1 < NPH - 1) ? MK_STOP_AFTER + 1 : NPH;
    hipLaunchKernelGGL(mk_fwd, dim3(grid), dim3(NTHREADS), LDS_BYTES, stream, a);
#else
    for (int p = 0; p < NPH; ++p) { if (p > MK_STOP_AFTER && p != NPH - 1) continue; a.ph_lo = p; a.ph_hi = p + 1; hipLaunchKernelGGL(mk_fwd, dim3(grid), dim3(NTHREADS), LDS_BYTES, stream, a); }
#endif
}
```

```cpp
#include <hip/hip_runtime.h>
#include <cstdio>
#include <cstdint>

#ifndef MK_STOP_AFTER
#define MK_STOP_AFTER 38
#define MK_PROBE_SRC 1
#define MK_PROBE_Y2 1
#define MK_PROBE_OFF ((size_t)(WS_WR + WR_L2) - (size_t)WS_AR)
#define MK_PROBE_INP 9
#endif
#ifndef MK_CHUNKED
#define MK_CHUNKED 1
#endif
#ifndef MK_EPISKIP
#define MK_EPISKIP 0
#endif
#ifndef MK_STAMP
#define MK_STAMP 0
#endif
#ifndef MK_REPEAT
#define MK_REPEAT 0
#endif
#ifndef MK_N_LAUNCHES
#define MK_N_LAUNCHES 1
#endif

#define LAS __attribute__((address_space(3)))
#define GAS __attribute__((address_space(1)))
typedef unsigned short bf16_t;
typedef short bf16x8 __attribute__((ext_vector_type(8)));
typedef float f32x4 __attribute__((ext_vector_type(4)));
typedef float f32x2 __attribute__((ext_vector_type(2)));
typedef unsigned u32x4 __attribute__((ext_vector_type(4)));
typedef unsigned u32x2 __attribute__((ext_vector_type(2)));

constexpr int M = 16384, D = 1024, T = 2048, NH = 16, HD = 64;
constexpr int FF = 2816, FE = 3584, NEXP = 8, NASG = 2 * M, CAP = NASG + NEXP * 256;
constexpr int S5L = 32, NBC = M / S5L, S5K = 640;
constexpr float NORM_EPS = 1e-6f, LNX_EPS = 64e-5f;
constexpr int NTHREADS = 512, NWAVES = 8;

constexpr size_t MiB = (size_t)1 << 20;
constexpr size_t WS_CTL = 0, CTL_BYTES = 1 * MiB;
constexpr size_t WS_WR = 1 * MiB, WR_STRIDE = 29 * MiB;
constexpr size_t WR_RKV = 0, WR_L1 = 6 * MiB, WR_L2 = 8 * MiB, WR_WO = 10 * MiB, WR_GU = 12 * MiB, WR_WD = 23 * MiB;
constexpr size_t WS_WS = 59 * MiB, WSS_STRIDE = 60 * MiB;
constexpr size_t WSS_GLU = 0, WSS_TOEP = 4 * MiB, WSS_M1 = 44 * MiB;
constexpr size_t WS_WM = 179 * MiB, WM_GU = 0, WM_WD = 112 * MiB;
constexpr size_t WS_H0 = 347 * MiB, WS_VF = 411 * MiB, WS_Y2 = 443 * MiB, WS_AR = 507 * MiB, WS_Y2T = 847 * MiB, WS_TROW = 859 * MiB, WS_END = 860 * MiB;
constexpr size_t AR_XS = 0, AR_R = 192 * MiB, AR_K = 224 * MiB, AR_V = 256 * MiB, AR_L1 = 288 * MiB;
constexpr size_t AR_LW = 0, AR_A = 32 * MiB, AR_G = 64 * MiB, AR_YRAW = 96 * MiB, AR_YG = 160 * MiB;
constexpr size_t AR_HN2 = 0, AR_HMID = 32 * MiB;
constexpr size_t AR_UG = 0, AR_EB = 40 * MiB, AR_YACT = 56 * MiB;
constexpr size_t AR_ASG = 32 * MiB, AR_XSM = 33 * MiB, AR_ROWM = 101 * MiB, AR_HMIDM = 102 * MiB;
static_assert(AR_HMIDM + (size_t)CAP * FE * 2 <= WS_Y2T - WS_AR, "arena");
constexpr int MOE_MAIN_TILES = 128, MOE_TAIL_ROW0 = MOE_MAIN_TILES * 256;
static_assert(WR_WD + (size_t)D * FF * 2 <= WR_STRIDE, "wr");
constexpr int CW_BAR = 4096;
constexpr int CW_MOECNT = 16384;
constexpr int RING_BYTES = 131072, LDSCTL_OFF = RING_BYTES, MISC_OFF = LDSCTL_OFF + 320, PTAB_OFF = LDSCTL_OFF + 1024, LDS_BYTES = 147456;

constexpr int NPH = 40;

#define VM_WAIT() asm volatile("s_waitcnt vmcnt(0)" ::: "memory")
typedef __bf16 bf16x2_n __attribute__((ext_vector_type(2)));
__device__ __forceinline__ unsigned cvt_pk_bf16(float lo, float hi) { const f32x2 v = {lo, hi}; return __builtin_bit_cast(unsigned, __builtin_convertvector(v, bf16x2_n)); }
__device__ __forceinline__ float bf_lo(unsigned u) { return __uint_as_float(u << 16); }
__device__ __forceinline__ float bf_hi(unsigned u) { return __uint_as_float(u & 0xffff0000u); }
__device__ __forceinline__ float fsigmoid(float x) { return __builtin_amdgcn_rcpf(1.0f + __expf(-x)); }
__device__ __forceinline__ float ftanh(float x) { return 1.0f - 2.0f * __builtin_amdgcn_rcpf(__expf(2.0f * x) + 1.0f); }
__device__ __forceinline__ float fgelu(float x) { const float u = 0.7978845608f * (x + 0.044715f * x * x * x); return x * fsigmoid(2.0f * u); }
template <int CTRL> __device__ __forceinline__ float dpp_f(float x) { return __int_as_float(__builtin_amdgcn_update_dpp(0, __float_as_int(x), CTRL, 0xf, 0xf, true)); }
__device__ __forceinline__ float quad_sum(float x) { x += dpp_f<0xB1>(x); x += dpp_f<0x4E>(x); return x; }
__device__ __forceinline__ float row16_sum(float x) { x = quad_sum(x); x += dpp_f<0x141>(x); x += dpp_f<0x140>(x); return x; }
__device__ __forceinline__ float wave_sum(float v) {
    v = row16_sum(v);
    const float a = __int_as_float(__builtin_amdgcn_readlane(__float_as_int(v), 0)), b = __int_as_float(__builtin_amdgcn_readlane(__float_as_int(v), 16));
    const float c = __int_as_float(__builtin_amdgcn_readlane(__float_as_int(v), 32)), d = __int_as_float(__builtin_amdgcn_readlane(__float_as_int(v), 48));
    return (a + b) + (c + d);
}
__device__ __forceinline__ u32x4 pack8(const f32x4 a, const f32x4 b) { u32x4 w; w.x = cvt_pk_bf16(a[0], a[1]); w.y = cvt_pk_bf16(a[2], a[3]); w.z = cvt_pk_bf16(b[0], b[1]); w.w = cvt_pk_bf16(b[2], b[3]); return w; }
__device__ __forceinline__ void unpack8(const u32x4 w, f32x4& a, f32x4& b) { a = (f32x4){bf_lo(w.x), bf_hi(w.x), bf_lo(w.y), bf_hi(w.y)}; b = (f32x4){bf_lo(w.z), bf_hi(w.z), bf_lo(w.w), bf_hi(w.w)}; }

__device__ __forceinline__ const GAS float* inp_ptr(LAS unsigned long long* tab, int i) {
    const unsigned long long v = tab[i]; const unsigned lo = (unsigned)__builtin_amdgcn_readfirstlane((int)(unsigned)v), hi = (unsigned)__builtin_amdgcn_readfirstlane((int)(unsigned)(v >> 32));
    return (const GAS float*)(((unsigned long long)hi << 32) | lo);
}
#define XB_TMO      128
#define XB_XCNT(j)  (256  + 64 * (j))
#define XB_XSUB(j)  (1280 + 64 * (j))
#define XB_XGEN(j)  (2304 + 64 * (j))
#define XB_TOP      3328
#define XB_TOPGEN   3392
#define XCD_BAR_WORDS 3456
#define XB_SPIN_CAP (1u << 18)
__device__ __forceinline__ unsigned xb_ld(unsigned* p)              { return __hip_atomic_load(p, __ATOMIC_RELAXED, __HIP_MEMORY_SCOPE_AGENT); }
__device__ __forceinline__ unsigned xb_add(unsigned* p, unsigned v) { return __hip_atomic_fetch_add(p, v, __ATOMIC_RELAXED, __HIP_MEMORY_SCOPE_AGENT); }
__device__ __forceinline__ unsigned xb_xcc_id() { return (unsigned)__builtin_amdgcn_s_getreg((3 << 11) | 20) & 0xFu; }
#define XB_SPIN(cond, bar) do { unsigned _sp = 0; while (cond) { __builtin_amdgcn_s_sleep(1); \
    if ((++_sp & 255u) == 0u) { if (xb_ld(&(bar)[XB_TMO])) break; if (_sp > XB_SPIN_CAP) { atomicAdd(&(bar)[XB_TMO], 1u); break; } } } } while (0)
struct XcdBarrier { unsigned* bar; unsigned x; volatile LAS unsigned* st; };
__device__ __forceinline__ XcdBarrier xcd_barrier_post(unsigned* bar, volatile LAS unsigned* st) {
    XcdBarrier b; b.bar = bar; b.x = xb_xcc_id(); b.st = st;
    if (threadIdx.x == 0) (void)xb_add(&bar[XB_XCNT(b.x)], 1u);
    return b;
}
__device__ __forceinline__ void xcd_barrier_complete(unsigned* bar, unsigned x, unsigned& nloc, unsigned& nx) {
    const unsigned G = gridDim.x * gridDim.y * gridDim.z;
    unsigned sum, cnt, mine, sp = 0u;
    for (;;) {
        sum = 0u; cnt = 0u; mine = 0u;
#pragma unroll
        for (unsigned j = 0; j < 16; ++j) { const unsigned c = xb_ld(&bar[XB_XCNT(j)]); sum += c; cnt += (c > 0u) ? 1u : 0u; mine = (j == x) ? c : mine; }
        if (sum == G) break;
        __builtin_amdgcn_s_sleep(1);
        if ((++sp & 255u) == 0u) { if (xb_ld(&bar[XB_TMO])) break; if (sp > XB_SPIN_CAP) { atomicAdd(&bar[XB_TMO], 1u); break; } }
    }
    nloc = mine > 0u ? mine : 1u; nx = cnt > 0u ? cnt : 1u;
}
__device__ __forceinline__ void xcd_barrier(const XcdBarrier& b) {
    asm volatile("s_waitcnt vmcnt(0)" ::: "memory");
    __syncthreads();
    if (threadIdx.x == 0) {
        unsigned* bar = b.bar;
        __builtin_amdgcn_s_waitcnt(0);
        unsigned nloc = b.st[0], nx = b.st[1];
        if (nloc == 0u) { xcd_barrier_complete(bar, b.x, nloc, nx); b.st[0] = nloc; b.st[1] = nx; }
        const unsigned old = xb_add(&bar[XB_XSUB(b.x)], 1u);
        const unsigned gen = old / nloc;
        if (old + 1u == (gen + 1u) * nloc) {
            __builtin_amdgcn_fence(__ATOMIC_RELEASE, "agent");
            asm volatile("s_waitcnt vmcnt(0)" ::: "memory");
            const unsigned og = xb_add(&bar[XB_TOP], 1u);
            const unsigned tg = og / nx;
            if (og + 1u == (tg + 1u) * nx) xb_add(&bar[XB_TOPGEN], 1u);
            else XB_SPIN(xb_ld(&bar[XB_TOPGEN]) == tg, bar);
            __builtin_amdgcn_fence(__ATOMIC_ACQUIRE, "agent");
            xb_add(&bar[XB_XGEN(b.x)], 1u);
            asm volatile("s_waitcnt vmcnt(0)" ::: "memory");
        } else {
            XB_SPIN(xb_ld(&bar[XB_XGEN(b.x)]) == gen, bar);
            __builtin_amdgcn_fence(__ATOMIC_ACQUIRE, "agent");
            asm volatile("s_waitcnt vmcnt(0)" ::: "memory");
        }
    }
    __syncthreads();
}

struct GUnit { const GAS char* A; const GAS char* B; int pm, pn, kind, pad; };
__device__ __forceinline__ int perm32(int rho) { const int n = rho >> 4, i = rho & 15; return 8 * (i >> 2) + 4 * n + (i & 3); }
__device__ __forceinline__ int fdiv(int a, int b) {
    int q = (int)((float)a * __builtin_amdgcn_rcpf((float)b)); const int r = a - q * b; q += (r >= b) ? 1 : 0; q -= (r < 0) ? 1 : 0; return q;
}
__device__ __forceinline__ void tile_order(int L, int nM, int nN, int& pm, int& pn) {
    const int nwg = nM * nN; int wgid = L;
    { const int q = nwg >> 3, r = nwg & 7, xcd = wgid & 7, off = wgid >> 3; wgid = (xcd < r ? xcd * (q + 1) : r * (q + 1) + (xcd - r) * q) + off; }
    const int nig = 8 * nN, gid = fdiv(wgid, nig), rem = wgid - gid * nig, fm = gid * 8, gsz = (nM - fm) < 8 ? (nM - fm) : 8;
    pn = fdiv(rem, gsz); pm = fm + rem - pn * gsz;
}

template <class Epi, class Sched>
__device__ __forceinline__ void gemm_phase_simple(LAS unsigned char* lds, int K, int lda, int ldb, const Sched& S, const Epi& E) {
    (void)lds;
    const int tid = threadIdx.x, wid = __builtin_amdgcn_readfirstlane(tid >> 6), lane = tid & 63, wr = wid >> 2, wc = wid & 3, fr = lane & 15, fq = lane >> 4;
    for (int ui = 0;; ++ui) {
        GUnit u; if (!S.next(ui, u)) break;
        f32x4 acc[2][2][4][2];
#pragma unroll
        for (int a = 0; a < 2; ++a)
#pragma unroll
            for (int b = 0; b < 2; ++b)
#pragma unroll
                for (int m = 0; m < 4; ++m)
#pragma unroll
                    for (int n = 0; n < 2; ++n) acc[a][b][m][n] = (f32x4){0.f, 0.f, 0.f, 0.f};
        const GAS char* Ap = u.A + ((size_t)(wr * 64 + fr) * lda + fq * 8) * 2;
        const GAS char* Bp0 = u.B + ((size_t)(wc * 32 + perm32(fr)) * ldb + fq * 8) * 2;
        const GAS char* Bp1 = u.B + ((size_t)(wc * 32 + perm32(16 + fr)) * ldb + fq * 8) * 2;
#pragma unroll 1
        for (int k0 = 0; k0 < K; k0 += 32) {
            bf16x8 a[2][4], b[2][2];
#pragma unroll
            for (int ai = 0; ai < 2; ++ai)
#pragma unroll
                for (int m = 0; m < 4; ++m) a[ai][m] = *(const GAS bf16x8*)(Ap + ((size_t)(ai * 128 + m * 16) * lda + k0) * 2);
#pragma unroll
            for (int bj = 0; bj < 2; ++bj) { b[bj][0] = *(const GAS bf16x8*)(Bp0 + ((size_t)(bj * 128) * ldb + k0) * 2); b[bj][1] = *(const GAS bf16x8*)(Bp1 + ((size_t)(bj * 128) * ldb + k0) * 2); }
#pragma unroll
            for (int ai = 0; ai < 2; ++ai)
#pragma unroll
                for (int bj = 0; bj < 2; ++bj)
#pragma unroll
                    for (int m = 0; m < 4; ++m)
#pragma unroll
                        for (int n = 0; n < 2; ++n) acc[ai][bj][m][n] = __builtin_amdgcn_mfma_f32_16x16x32_bf16(b[bj][n], a[ai][m], acc[ai][bj][m][n], 0, 0, 0);
        }
        E(acc, u, wr, wc, fr, fq);
    }
}

constexpr int HTB = 128 * 64 * 2;
__device__ __forceinline__ int lds_byte(int r, int c) { const int st = (r >> 4) * 2 + (c >> 5), rr = r & 15, cc = c & 31, ob = rr * 64 + cc * 2; return st * 1024 + (ob ^ (((ob >> 9) & 1) << 5)); }
__device__ __forceinline__ void stage_rc(int b, int& R, int& C) { const int st = b / 1024, sb = b % 1024, swz = sb ^ (((sb >> 9) & 1) << 5); R = (st >> 1) * 16 + swz / 64; C = (st & 1) * 32 + (swz % 64) / 2; }
template <class S> struct sched_gather { static constexpr bool value = false; };
template <class S> struct sched_vark { static constexpr bool value = false; };
__device__ __forceinline__ const GAS char* uni_ptr(const GAS char* p) {
    const unsigned long long v = (unsigned long long)p; const unsigned lo = (unsigned)__builtin_amdgcn_readfirstlane((int)(unsigned)v), hi = (unsigned)__builtin_amdgcn_readfirstlane((int)(unsigned)(v >> 32));
    return (const GAS char*)(((unsigned long long)hi << 32) | lo);
}
#if MK_STAMP
#define STAMP_AT(slot_, cond_) do { if (tid == 0 && (cond_) && ((volatile LAS unsigned*)(lds + MISC_OFF))[40]) { \
        ((volatile LAS unsigned long long*)(lds + MISC_OFF + 256))[2 * (slot_)] = __builtin_amdgcn_s_memtime(); ((volatile LAS unsigned long long*)(lds + MISC_OFF + 256))[2 * (slot_) + 1] = __builtin_amdgcn_s_memrealtime(); } } while (0)
#else
#define STAMP_AT(slot_, cond_) do { } while (0)
#endif
template <class Epi, class Sched>
__device__ __forceinline__ void gemm_phase(LAS unsigned char* lds, int tid, int K, int lda, int ldb, const Sched& S, const Epi& E) {
    const int wid = __builtin_amdgcn_readfirstlane(tid >> 6), lane = tid & 63, wr = wid >> 2, wc = wid & 3, fr = lane & 15, fq = lane >> 4;
    const int nt = K / 64;
    constexpr bool GA = sched_gather<Sched>::value;
    unsigned voffA[2], voffB[2];
    unsigned voA[2][2], voN[2][2];
#pragma unroll
    for (int i = 0; i < 2; ++i) { int R, C; stage_rc(tid * 16 + i * 8192, R, C); const int Rb = (R & ~31) + perm32(R & 31);
        voffA[i] = (unsigned)(R * lda + C) * 2u; voffB[i] = (unsigned)(Rb * ldb + C) * 2u; }
#define PG8_STAGE_A(bufoff, base, half) do { if constexpr (GA) PG8_STAGE(bufoff, base, voA[half]); else PG8_STAGE(bufoff, (base) + (half) * hstepA, voffA); } while (0)
    const size_t kstep = 128;
    const size_t hstepA = (size_t)128 * lda * 2, hstepB = (size_t)128 * ldb * 2;
    const unsigned ldsw = (unsigned)wid * 1024u;
    const int aoff = lds_byte(wr * 64 + fr, fq * 8), boff = lds_byte(wc * 32 + fr, fq * 8);
#define PG8_SA(b, h) (((b) * 2 + (h)) * HTB)
#define PG8_SB(b, h) ((4 + (b) * 2 + (h)) * HTB)
#define PG8_STAGE(bufoff, gbase, voff) do { const GAS char* _b = uni_ptr(gbase); _Pragma("unroll") for (int _i = 0; _i < 2; ++_i) \
        __builtin_amdgcn_global_load_lds((const GAS unsigned*)(_b + (voff)[_i]), (LAS unsigned*)(lds + (bufoff) + ldsw + _i * 8192), 16, 0, 0); } while (0)
#define PG8_LDA(dst, b, h) do { _Pragma("unroll") for (int m = 0; m < 4; ++m) _Pragma("unroll") for (int k = 0; k < 2; ++k) dst[m][k] = *(const LAS bf16x8*)(lds + PG8_SA(b, h) + aoff + m * 2048 + k * 1024); } while (0)
#define PG8_LDB(dst, b, h) do { _Pragma("unroll") for (int n = 0; n < 2; ++n) _Pragma("unroll") for (int k = 0; k < 2; ++k) dst[n][k] = *(const LAS bf16x8*)(lds + PG8_SB(b, h) + boff + n * 2048 + k * 1024); } while (0)
#define PG8_MMA(ai, bj, At, Bt) do { __builtin_amdgcn_s_setprio(1); _Pragma("unroll") for (int m = 0; m < 4; ++m) _Pragma("unroll") for (int n = 0; n < 2; ++n) _Pragma("unroll") for (int k = 0; k < 2; ++k) \
        acc[ai][bj][m][n] = __builtin_amdgcn_mfma_f32_16x16x32_bf16(Bt[n][k], At[m][k], acc[ai][bj][m][n], 0, 0, 0); __builtin_amdgcn_s_setprio(0); } while (0)
#define PG8_MMA0(ai, bj, At, Bt) do { __builtin_amdgcn_s_setprio(1); _Pragma("unroll") for (int m = 0; m < 4; ++m) _Pragma("unroll") for (int n = 0; n < 2; ++n) { \
        acc[ai][bj][m][n] = __builtin_amdgcn_mfma_f32_16x16x32_bf16(Bt[n][0], At[m][0], (f32x4){0.f, 0.f, 0.f, 0.f}, 0, 0, 0); \
        acc[ai][bj][m][n] = __builtin_amdgcn_mfma_f32_16x16x32_bf16(Bt[n][1], At[m][1], acc[ai][bj][m][n], 0, 0, 0); } __builtin_amdgcn_s_setprio(0); } while (0)
#define PG8_WAIT_V(n) asm volatile("s_waitcnt vmcnt(" #n ")" ::: "memory")
#define PG8_WAIT_L(n) asm volatile("s_waitcnt lgkmcnt(" #n ")" ::: "memory")
#define PG8_BAR __builtin_amdgcn_s_barrier()
#define PG8_SCHED __builtin_amdgcn_sched_barrier(0)
    GUnit cur, nxt; int ui = 0;
    if (!S.next(0, cur)) return;
    f32x4 acc[2][2][4][2];
    bf16x8 At[4][2], B0[2][2], B1[2][2];
    const GAS char* cA = uni_ptr(cur.A); const GAS char* cB = uni_ptr(cur.B);
    if constexpr (GA) S.load_offs(cur.pm, tid, voA);
    PG8_STAGE(PG8_SB(0, 0), cB, voffB); PG8_STAGE(PG8_SB(0, 1), cB + hstepB, voffB); PG8_STAGE_A(PG8_SA(0, 0), cA, 0); PG8_STAGE_A(PG8_SA(0, 1), cA, 1);
    if (wr == 1) PG8_BAR;
    PG8_WAIT_V(2); PG8_BAR;
    PG8_STAGE(PG8_SB(1, 0), cB + kstep, voffB); PG8_STAGE_A(PG8_SA(1, 0), cA + kstep, 0); PG8_STAGE(PG8_SB(1, 1), cB + hstepB + kstep, voffB);
    PG8_WAIT_V(6); PG8_BAR;
    STAMP_AT(0, true);
#define PG8_KBODY(MM) { \
            const bool last = (t == ntu - 2); \
            const GAS char* a1 = cA + (size_t)(t + 1) * kstep; \
            const GAS char* a2 = last ? nA : cA + (size_t)(t + 2) * kstep; const GAS char* b2 = last ? nB : cB + (size_t)(t + 2) * kstep; \
            const GAS char* a3 = a2 + kstep; const GAS char* b3 = b2 + kstep; \
              \
            PG8_LDB(B0, 0, 0); PG8_LDB(B1, 0, 1); PG8_SCHED; PG8_LDA(At, 0, 0); PG8_STAGE_A(PG8_SA(1, 1), a1, 1); \
            if constexpr (GA) { if (last) { \
                _Pragma("unroll") for (int h_ = 0; h_ < 2; ++h_) { voA[h_][0] = voN[h_][0]; voA[h_][1] = voN[h_][1]; } } }        \
            PG8_WAIT_V(8); PG8_WAIT_L(0); PG8_BAR; MM(0, 0, At, B0); MM(0, 1, At, B1); PG8_BAR; PG8_SCHED; \
              \
            PG8_LDA(At, 0, 1); PG8_STAGE(PG8_SB(0, 0), b2, voffB); PG8_STAGE(PG8_SB(0, 1), b2 + hstepB, voffB); PG8_STAGE_A(PG8_SA(0, 0), a2, 0); \
            PG8_WAIT_V(8); PG8_WAIT_L(0); PG8_BAR; MM(1, 0, At, B0); MM(1, 1, At, B1); PG8_BAR; PG8_SCHED; \
              \
            PG8_LDB(B0, 1, 0); PG8_LDB(B1, 1, 1); PG8_SCHED; PG8_LDA(At, 1, 0); PG8_STAGE_A(PG8_SA(0, 1), a2, 1); \
            PG8_WAIT_V(8); PG8_WAIT_L(0); PG8_BAR; PG8_MMA(0, 0, At, B0); PG8_MMA(0, 1, At, B1); PG8_BAR; PG8_SCHED; \
              \
            PG8_LDA(At, 1, 1); PG8_STAGE(PG8_SB(1, 0), b3, voffB); PG8_STAGE(PG8_SB(1, 1), b3 + hstepB, voffB); PG8_STAGE_A(PG8_SA(1, 0), a3, 0); \
            PG8_WAIT_V(8); PG8_WAIT_L(0); PG8_BAR; PG8_MMA(1, 0, At, B0); PG8_MMA(1, 1, At, B1); PG8_BAR; PG8_SCHED; }
    for (;;) {
        const bool has_next = S.next(ui + 1, nxt);
        const GAS char* nA = has_next ? uni_ptr(nxt.A) : cA; const GAS char* nB = has_next ? uni_ptr(nxt.B) : cB;
        if constexpr (GA) { if (has_next && nxt.pm != cur.pm) S.load_offs(nxt.pm, tid, voN); else {
#pragma unroll
            for (int h_ = 0; h_ < 2; ++h_) { voN[h_][0] = voA[h_][0]; voN[h_][1] = voA[h_][1]; } } }
        {   typedef double f64x2_ __attribute__((ext_vector_type(2)));
#pragma unroll
    for (int a = 0; a < 2; ++a)
#pragma unroll
        for (int b = 0; b < 2; ++b)
#pragma unroll
            for (int m = 0; m < 4; ++m)
#pragma unroll
                for (int n = 0; n < 2; ++n) { double d0_, d1_; asm volatile("v_pk_mov_b32 %0, 0, 0\n\tv_pk_mov_b32 %1, 0, 0" : "=v"(d0_), "=v"(d1_)); acc[a][b][m][n] = __builtin_bit_cast(f32x4, (f64x2_){d0_, d1_}); } }
        const int ntu = sched_vark<Sched>::value ? cur.pad : nt;
#pragma unroll 1
        for (int t = 0; t < ntu; t += 2) PG8_KBODY(PG8_MMA)
        STAMP_AT(1, ui == 0);
        if (wr == 0) PG8_BAR;
        E(acc, cur, wr, wc, fr, fq);
        STAMP_AT(2, ui == 0);
        if (!has_next) break;
        cur = nxt; cA = nA; cB = nB; ++ui;
        if (wr == 1) PG8_BAR;
    }
#undef PG8_KBODY
    PG8_WAIT_V(0);
    PG8_BAR;
    STAMP_AT(3, true);
#undef PG8_SA
#undef PG8_SB
#undef PG8_STAGE
#undef PG8_STAGE_A
#undef PG8_LDA
#undef PG8_LDB
#undef PG8_MMA
#undef PG8_MMA0
#undef PG8_WAIT_V
#undef PG8_WAIT_L
#undef PG8_BAR
#undef PG8_SCHED
}

__device__ __forceinline__ int moe_expert(volatile LAS unsigned* tpre, int pm) {
    const u32x4 p0 = *(const LAS u32x4*)tpre, p1 = *(const LAS u32x4*)(tpre + 4);
    const int e = ((int)p0.y <= pm ? 1 : 0) + ((int)p0.z <= pm ? 1 : 0) + ((int)p0.w <= pm ? 1 : 0) + ((int)p1.x <= pm ? 1 : 0) + ((int)p1.y <= pm ? 1 : 0) + ((int)p1.z <= pm ? 1 : 0) + ((int)p1.w <= pm ? 1 : 0);
    return __builtin_amdgcn_readfirstlane(e);
}
struct SchedPlain {
    const GAS char* A; const GAS char* B; size_t tA, tB; int nM, nN, G, c;
    __device__ __forceinline__ bool next(int i, GUnit& u) const {
        const int L = i * G + c; if (L >= nM * nN) return false;
        int pm, pn; tile_order(L, nM, nN, pm, pn);
        u.A = A + (size_t)pm * tA; u.B = B + (size_t)pn * tB; u.pm = pm; u.pn = pn; u.kind = 0; u.pad = 0; return true;
    }
};
struct SchedR2 {
    const GAS char* xs; const GAS char* Wrkv; const GAS char* Wl1; int nvn, G, c;
    __device__ __forceinline__ bool next(int i, GUnit& u) const {
        const int L = i * G + c; if (L >= 64 * nvn) return false;
        int pm, vn; tile_order(L, 64, nvn, pm, vn);
        int kind, pn, s; const GAS char* B;
        if (vn < 12) { kind = vn >> 2; pn = vn & 3; s = kind; B = Wrkv + (size_t)kind * D * D * 2 + (size_t)pn * 256 * D * 2; }
        else { kind = vn - 9; pn = 0; s = (kind == 6) ? 2 : kind; B = Wl1 + (size_t)(kind - 3) * 256 * D * 2; }
        u.A = xs + (size_t)s * M * D * 2 + (size_t)pm * 256 * D * 2; u.B = B; u.pm = pm; u.pn = pn; u.kind = kind; u.pad = 0; return true;
    }
};
struct SchedR3 {
    const GAS char* l1; const GAS char* Wl2; int nvn, G, c;
    __device__ __forceinline__ bool next(int i, GUnit& u) const {
        const int L = i * G + c; if (L >= 64 * nvn) return false;
        int pm, vn; tile_order(L, 64, nvn, pm, vn);
        const int kind = vn >> 2, pn = vn & 3;
        u.A = l1 + (size_t)kind * M * 256 * 2 + (size_t)pm * 256 * 256 * 2; u.B = Wl2 + (size_t)kind * D * 256 * 2 + (size_t)pn * 256 * 256 * 2;
        u.pm = pm; u.pn = pn; u.kind = kind; u.pad = (kind == 2) ? 4 : 2; return true;
    }
};
template <> struct sched_vark<SchedR3> { static constexpr bool value = true; };
struct SchedGrp {
    const GAS char* A; const GAS char* B; size_t gA, tA, gB, tB; int nMg, nNg, ng, G, vcu;
    __device__ __forceinline__ bool next(int i, GUnit& u) const {
        const int L = i * G + vcu, per = nMg * nNg; if (L >= ng * per) return false;
        const int g = fdiv(L, per), r = L - g * per, pn = fdiv(r, nMg), pm = r - pn * nMg;
        u.A = A + (size_t)g * gA + (size_t)pm * tA; u.B = B + (size_t)g * gB + (size_t)pn * tB; u.pm = pm; u.pn = pn; u.kind = g; u.pad = 0; return true;
    }
};
struct SchedOne {
    GUnit u0;
    __device__ __forceinline__ bool next(int i, GUnit& u) const { if (i != 0) return false; u = u0; return true; }
};
struct SchedMoe {
    const GAS char* A; const GAS char* W; size_t tA, eW, tB; int nN, G, c; volatile LAS unsigned* tpre;
    __device__ __forceinline__ bool next(int i, GUnit& u) const {
        const int MT = (int)tpre[8]; const int L = i * G + c; if (L >= MT * nN) return false;
        int pm, pn; tile_order(L, MT, nN, pm, pn);
        const int e = moe_expert(tpre, pm);
        u.A = A + (size_t)pm * tA; u.B = W + (size_t)e * eW + (size_t)pn * tB; u.pm = pm; u.pn = pn; u.kind = e; u.pad = 0; return true;
    }
};

#define EPI_ARGS const f32x4 (&acc)[2][2][4][2], const GUnit& u, int wr, int wc, int fr, int fq
struct EpiR2 {
    GAS bf16_t* rk; GAS bf16_t* vdst; GAS bf16_t* l1;
    __device__ __forceinline__ void operator()(EPI_ARGS) const {
        const int kind = u.kind; GAS bf16_t* base; int ldc, act = 0;
        if (kind < 3) { base = (kind == 2) ? vdst : rk + (size_t)kind * M * D; ldc = D; }
        else { base = l1 + (size_t)(kind - 3) * M * 256; ldc = 256; act = (kind == 3) ? 1 : ((kind == 5) ? 2 : 0); }
        const int row0 = u.pm * 256 + wr * 64 + fr, col0 = u.pn * 256 + wc * 32 + 8 * fq;
#pragma unroll
        for (int ai = 0; ai < 2; ++ai)
#pragma unroll
            for (int m = 0; m < 4; ++m) { GAS bf16_t* rowp = base + (size_t)(row0 + ai * 128 + m * 16) * ldc + col0;
#pragma unroll
                for (int bj = 0; bj < 2; ++bj) { f32x4 v0 = acc[ai][bj][m][0], v1 = acc[ai][bj][m][1];
                    if (act == 1) {
#pragma unroll
                        for (int j = 0; j < 4; ++j) { v0[j] = ftanh(v0[j]); v1[j] = ftanh(v1[j]); } }
                    if (act == 2) {
#pragma unroll
                        for (int j = 0; j < 4; ++j) { v0[j] = fsigmoid(v0[j]); v1[j] = fsigmoid(v1[j]); } }
                    *(GAS u32x4*)(rowp + bj * 128) = pack8(v0, v1); } }
    }
};
struct EpiR3 {
    GAS unsigned char* wsl; LAS unsigned long long* ptab; int j;
    template <int KIND> __device__ __forceinline__ void run(EPI_ARGS) const {
        GAS unsigned char* ar = wsl + WS_AR;
        GAS bf16_t* vbuf = (j == 0) ? (GAS bf16_t*)(wsl + WS_VF) : (GAS bf16_t*)(ar + AR_V); const GAS bf16_t* vfirst = (const GAS bf16_t*)(wsl + WS_VF);
        const GAS float* bias = inp_ptr(ptab, KIND == 0 ? 6 : (KIND == 1 ? 9 : 20)) + (size_t)((KIND == 3) ? 0 : j) * D;
        GAS bf16_t* base = (KIND == 3) ? vbuf : (GAS bf16_t*)(ar + AR_LW) + (size_t)KIND * M * D;
        const int row0 = u.pm * 256 + wr * 64 + fr, col0 = u.pn * 256 + wc * 32 + 8 * fq;
        f32x4 bv[2][2];
#pragma unroll
        for (int bj = 0; bj < 2; ++bj) { if (KIND != 2) { bv[bj][0] = *(const GAS f32x4*)(bias + col0 + bj * 128); bv[bj][1] = *(const GAS f32x4*)(bias + col0 + bj * 128 + 4); } else { bv[bj][0] = (f32x4){0.f, 0.f, 0.f, 0.f}; bv[bj][1] = bv[bj][0]; } }
#pragma unroll
        for (int ai = 0; ai < 2; ++ai) {
            u32x4 vw[4][2], fw[4][2];
            if (KIND == 3) {
#pragma unroll
                for (int m = 0; m < 4; ++m)
#pragma unroll
                    for (int bj = 0; bj < 2; ++bj) { const size_t o_ = (size_t)(row0 + ai * 128 + m * 16) * D + col0 + bj * 128; vw[m][bj] = *(const GAS u32x4*)(vbuf + o_); fw[m][bj] = *(const GAS u32x4*)(vfirst + o_); } }
#pragma unroll
            for (int m = 0; m < 4; ++m) { const size_t off = (size_t)(row0 + ai * 128 + m * 16) * D + col0;
#pragma unroll
                for (int bj = 0; bj < 2; ++bj) { f32x4 x0 = acc[ai][bj][m][0] + bv[bj][0], x1 = acc[ai][bj][m][1] + bv[bj][1];
                    if (KIND == 0) {
#pragma unroll
                        for (int j = 0; j < 4; ++j) { x0[j] = -0.60653066f * fsigmoid(x0[j]); x1[j] = -0.60653066f * fsigmoid(x1[j]); } }
                    else if (KIND == 1) {
#pragma unroll
                        for (int j = 0; j < 4; ++j) { x0[j] = fsigmoid(x0[j]); x1[j] = fsigmoid(x1[j]); } }
                    else if (KIND == 3) {
                        f32x4 va, vb, fa, fb; unpack8(vw[m][bj], va, vb); unpack8(fw[m][bj], fa, fb);
#pragma unroll
                        for (int j = 0; j < 4; ++j) { x0[j] = va[j] + (fa[j] - va[j]) * fsigmoid(x0[j]); x1[j] = vb[j] + (fb[j] - vb[j]) * fsigmoid(x1[j]); } }
                    *(GAS u32x4*)(base + off + bj * 128) = pack8(x0, x1); } } }
    }
    __device__ __forceinline__ void operator()(EPI_ARGS) const {
        const int kind = u.kind;
        if (kind == 0) run<0>(acc, u, wr, wc, fr, fq);
        else if (kind == 1) run<1>(acc, u, wr, wc, fr, fq);
        else if (kind == 2) run<2>(acc, u, wr, wc, fr, fq);
        else run<3>(acc, u, wr, wc, fr, fq);
    }
};
struct EpiRes {
    const GAS bf16_t* hin; GAS bf16_t* hout;
    __device__ __forceinline__ void operator()(EPI_ARGS) const {
        const int row0 = u.pm * 256 + wr * 64 + fr, col0 = u.pn * 256 + wc * 32 + 8 * fq;
#pragma unroll
        for (int ai = 0; ai < 2; ++ai) { u32x4 hw[4][2];
#pragma unroll
            for (int m = 0; m < 4; ++m)
#pragma unroll
                for (int bj = 0; bj < 2; ++bj) hw[m][bj] = *(const GAS u32x4*)(hin + (size_t)(row0 + ai * 128 + m * 16) * D + col0 + bj * 128);
#pragma unroll
            for (int m = 0; m < 4; ++m) { const size_t off = (size_t)(row0 + ai * 128 + m * 16) * D + col0;
#pragma unroll
                for (int bj = 0; bj < 2; ++bj) {
                    f32x4 h0, h1; unpack8(hw[m][bj], h0, h1);
                    *(GAS u32x4*)(hout + off + bj * 128) = pack8(h0 + acc[ai][bj][m][0], h1 + acc[ai][bj][m][1]); } } }
    }
};
struct EpiSwiglu {
    GAS bf16_t* out; int ldc;
#if MK_EPISKIP
    int skip;
#endif
    __device__ __forceinline__ void operator()(EPI_ARGS) const {
#if MK_EPISKIP == 1
        if (skip) return;
#endif
        const int row0 = u.pm * 256 + wr * 64 + fr, col0 = u.pn * 128 + wc * 32 + 8 * fq;
#pragma unroll
        for (int ai = 0; ai < 2; ++ai)
#pragma unroll
            for (int m = 0; m < 4; ++m) { f32x4 o0, o1;
#pragma unroll
                for (int j = 0; j < 4; ++j) { const float g0 = acc[ai][0][m][0][j], g1 = acc[ai][0][m][1][j]; o0[j] = g0 * fsigmoid(g0) * acc[ai][1][m][0][j]; o1[j] = g1 * fsigmoid(g1) * acc[ai][1][m][1][j]; }
                *(GAS u32x4*)(out + (size_t)(row0 + ai * 128 + m * 16) * ldc + col0) = pack8(o0, o1); }
    }
};
struct EpiGlu {
    GAS bf16_t* h; const GAS float* bglu;
    __device__ __forceinline__ void operator()(EPI_ARGS) const {
        const int row0 = u.pm * 256 + wr * 64 + fr, col0 = u.pn * 128 + wc * 32 + 8 * fq;
        const f32x4 bv0 = *(const GAS f32x4*)(bglu + col0), bv1 = *(const GAS f32x4*)(bglu + col0 + 4), bg0 = *(const GAS f32x4*)(bglu + D + col0), bg1 = *(const GAS f32x4*)(bglu + D + col0 + 4);
        u32x4 hw[2][4];
#pragma unroll
        for (int ai = 0; ai < 2; ++ai)
#pragma unroll
            for (int m = 0; m < 4; ++m) hw[ai][m] = *(const GAS u32x4*)(h + (size_t)(row0 + ai * 128 + m * 16) * D + col0);
#pragma unroll
        for (int ai = 0; ai < 2; ++ai)
#pragma unroll
            for (int m = 0; m < 4; ++m) { GAS bf16_t* p = h + (size_t)(row0 + ai * 128 + m * 16) * D + col0;
                f32x4 h0, h1; unpack8(hw[ai][m], h0, h1);
#pragma unroll
                for (int j = 0; j < 4; ++j) { h0[j] += (acc[ai][0][m][0][j] + bv0[j]) * fsigmoid(acc[ai][1][m][0][j] + bg0[j]); h1[j] += (acc[ai][0][m][1][j] + bv1[j]) * fsigmoid(acc[ai][1][m][1][j] + bg1[j]); }
                *(GAS u32x4*)p = pack8(h0, h1); }
    }
};
struct EpiS5E {
    GAS float* eb;
    __device__ __forceinline__ void operator()(EPI_ARGS) const {
        const int row0 = u.pm * 256 + wr * 64 + fr, col0 = wc * 32 + 8 * fq;
#pragma unroll
        for (int ai = 0; ai < 2; ++ai)
#pragma unroll
            for (int m = 0; m < 4; ++m) { GAS float* p = eb + ((size_t)u.kind * NBC + row0 + ai * 128 + m * 16) * 128 + col0;
                *(GAS f32x4*)p = acc[ai][0][m][0]; *(GAS f32x4*)(p + 4) = acc[ai][0][m][1]; }
    }
};
struct EpiS5Y {
    GAS bf16_t* yact; const GAS bf16_t* ug; const GAS float* dskip;
    __device__ __forceinline__ void operator()(EPI_ARGS) const {
        const int g = u.kind; const int row0 = u.pm * 256 + wr * 64 + fr, col0 = u.pn * 256 + wc * 32 + 8 * fq;
        u32x4 xw[2][2][4];
#pragma unroll
        for (int bj = 0; bj < 2; ++bj)
#pragma unroll
            for (int ai = 0; ai < 2; ++ai)
#pragma unroll
                for (int m = 0; m < 4; ++m) xw[bj][ai][m] = *(const GAS u32x4*)(ug + ((size_t)g * NBC + row0 + ai * 128 + m * 16) * S5K + col0 + bj * 128);
#pragma unroll
        for (int bj = 0; bj < 2; ++bj) { const int n = col0 + bj * 128, tl = n >> 4, ch = n & 15;
            const f32x4 d0 = *(const GAS f32x4*)(dskip + 16 * g + ch), d1 = *(const GAS f32x4*)(dskip + 16 * g + ch + 4);
#pragma unroll
            for (int ai = 0; ai < 2; ++ai)
#pragma unroll
                for (int m = 0; m < 4; ++m) { const int bc = row0 + ai * 128 + m * 16;
                    f32x4 x0, x1; unpack8(xw[bj][ai][m], x0, x1);
                    f32x4 y0 = acc[ai][bj][m][0] + d0 * x0, y1 = acc[ai][bj][m][1] + d1 * x1;
#pragma unroll
                    for (int j = 0; j < 4; ++j) { y0[j] = fgelu(y0[j]); y1[j] = fgelu(y1[j]); }
                    *(GAS u32x4*)(yact + ((size_t)bc * S5L + tl) * D + 16 * g + ch) = pack8(y0, y1); } }
    }
};
struct SchedMoeG {
    const GAS char* A; const GAS char* W; size_t eW, tB; int nN, G, c; volatile LAS unsigned* tpre; const GAS int* rowtok;
    __device__ __forceinline__ bool next(int i, GUnit& u) const {
        const int MT = (int)tpre[8]; const int L = i * G + c; if (L >= MT * nN) return false;
        int pm, pn; tile_order(L, MT, nN, pm, pn);
        const int e = moe_expert(tpre, pm);
        u.A = A; u.B = W + (size_t)e * eW + (size_t)pn * tB; u.pm = pm; u.pn = pn; u.kind = e; u.pad = 0; return true;
    }
    __device__ __forceinline__ void load_offs(int pm, int tid, unsigned (&vo)[2][2]) const {
#pragma unroll
        for (int i = 0; i < 2; ++i) { int R, C; stage_rc(tid * 16 + i * 8192, R, C);
#pragma unroll
            for (int h = 0; h < 2; ++h) { const int tok = rowtok[pm * 256 + 128 * h + R]; vo[h][i] = (unsigned)(tok * D + C) * 2u; } }
    }
};
template <> struct sched_gather<SchedMoeG> { static constexpr bool value = true; };
struct SchedMoeMain {
    const GAS char* A; const GAS char* W; size_t tA, eW, tB; int nN, G, c; volatile LAS unsigned* tpre;
    __device__ __forceinline__ bool next(int i, GUnit& u) const {
        int MT = (int)tpre[8]; MT = MT < MOE_MAIN_TILES ? MT : MOE_MAIN_TILES; const int L = i * G + c; if (L >= MT * nN) return false;
        int pm, pn; tile_order(L, MT, nN, pm, pn);
        const int e = moe_expert(tpre, pm);
        u.A = A + (size_t)pm * tA; u.B = W + (size_t)e * eW + (size_t)pn * tB; u.pm = pm; u.pn = pn; u.kind = e; u.pad = 0; return true;
    }
};
struct SchedMoeTail {
    const GAS char* A; const GAS char* W; size_t tA, eW, tB, kq_bytes; int G, c; volatile LAS unsigned* tpre;
    __device__ __forceinline__ bool next(int i, GUnit& u) const {
        const int MT = (int)tpre[8]; const int ntail = MT - MOE_MAIN_TILES; const int L = i * G + c; if (ntail <= 0 || L >= ntail * 16) return false;
        const int pm = MOE_MAIN_TILES + (L >> 4), pn = (L >> 2) & 3, kq = L & 3;
        const int e = moe_expert(tpre, pm);
        u.A = A + (size_t)pm * tA + (size_t)kq * kq_bytes; u.B = W + (size_t)e * eW + (size_t)pn * tB + (size_t)kq * kq_bytes; u.pm = pm; u.pn = pn; u.kind = e; u.pad = kq; return true;
    }
};
struct EpiMoeDown {
    GAS bf16_t* y2; const GAS int* rowslot; const GAS float* rowgate; GAS bf16_t* y2t;
    __device__ __forceinline__ void operator()(EPI_ARGS) const {
        const int row0 = u.pm * 256 + wr * 64 + fr, col0 = u.pn * 256 + wc * 32 + 8 * fq; const int kq = u.pad;
        int sl[2][4]; float gtv[2][4];
#pragma unroll
        for (int ai = 0; ai < 2; ++ai)
#pragma unroll
            for (int m = 0; m < 4; ++m) { sl[ai][m] = rowslot[row0 + ai * 128 + m * 16]; gtv[ai][m] = rowgate[row0 + ai * 128 + m * 16]; }
#pragma unroll
        for (int ai = 0; ai < 2; ++ai)
#pragma unroll
            for (int m = 0; m < 4; ++m) { const int row = row0 + ai * 128 + m * 16; const int slot = sl[ai][m]; const float gt = gtv[ai][m];
                if (slot >= 0) { GAS bf16_t* dst = (kq == 0) ? y2 + (size_t)slot * D : y2t + ((size_t)(kq - 1) * 2048 + (row - MOE_TAIL_ROW0)) * D;
#pragma unroll
                    for (int bj = 0; bj < 2; ++bj) *(GAS u32x4*)(dst + col0 + bj * 128) = pack8(acc[ai][bj][m][0] * gt, acc[ai][bj][m][1] * gt); } }
    }
};

struct CvtEnt { unsigned long long W, dst; int Ks, Ns, lds_, nblk, ldt, mode, row_off, first; };
constexpr int CVT_TAB_OFF = 102400, CVT_SCR_OFF = 32768, CVT_SCR_WAVE = 8704, CVT_MAX = 80;
__device__ __forceinline__ void cvt_add(LAS CvtEnt* tab, int& n, int& total, const GAS float* W, int Ks, int Ns, int lds_, int Kp, int Np, GAS bf16_t* dst, int ldt, int mode, int row_off) {
    LAS CvtEnt* e = tab + n; e->W = (unsigned long long)W; e->dst = (unsigned long long)dst; e->Ks = Ks; e->Ns = Ns; e->lds_ = lds_; e->nblk = Np / 32; e->ldt = ldt; e->mode = mode; e->row_off = row_off; e->first = total;
    total += (Kp / 64) * (Np / 32); ++n; tab[n].first = total;
}
__device__ __forceinline__ void cvt_fetch(const LAS CvtEnt* tab, int& ti, int f, CvtEnt& e) {
    while (f >= __builtin_amdgcn_readfirstlane(tab[ti + 1].first)) ++ti;
    const LAS CvtEnt* t = tab + ti;
    const unsigned long long w = t->W, d = t->dst;
    e.W = ((unsigned long long)(unsigned)__builtin_amdgcn_readfirstlane((int)(w >> 32)) << 32) | (unsigned)__builtin_amdgcn_readfirstlane((int)w);
    e.dst = ((unsigned long long)(unsigned)__builtin_amdgcn_readfirstlane((int)(d >> 32)) << 32) | (unsigned)__builtin_amdgcn_readfirstlane((int)d);
    e.Ks = __builtin_amdgcn_readfirstlane(t->Ks); e.Ns = __builtin_amdgcn_readfirstlane(t->Ns); e.lds_ = __builtin_amdgcn_readfirstlane(t->lds_); e.nblk = __builtin_amdgcn_readfirstlane(t->nblk);
    e.ldt = __builtin_amdgcn_readfirstlane(t->ldt); e.mode = __builtin_amdgcn_readfirstlane(t->mode); e.row_off = __builtin_amdgcn_readfirstlane(t->row_off); e.first = __builtin_amdgcn_readfirstlane(t->first);
}
__device__ __forceinline__ void cvt_load(const CvtEnt& t, int f, int lane, f32x4 (&v)[8]) {
    const int item = f - t.first, kb = fdiv(item, t.nblk), nb = item - kb * t.nblk, k0 = 64 * kb, n0 = 32 * nb;
    const int r = lane >> 3, c4 = lane & 7; const GAS float* W = (const GAS float*)t.W;
#pragma unroll
    for (int i = 0; i < 8; ++i) { const int k = k0 + 8 * i + r, n = n0 + 4 * c4;
        v[i] = (f32x4){0.f, 0.f, 0.f, 0.f}; if (k < t.Ks && n < t.Ns) v[i] = *(const GAS f32x4*)(W + (size_t)k * t.lds_ + n); }
}
__device__ __forceinline__ void cvt_store(const CvtEnt& t, LAS float* scr, int f, int lane, const f32x4 (&v)[8]) {
    const int item = f - t.first, kb = fdiv(item, t.nblk), nb = item - kb * t.nblk, k0 = 64 * kb, n0 = 32 * nb;
    const int r = lane >> 3, c4 = lane & 7; GAS bf16_t* dst = (GAS bf16_t*)t.dst;
#pragma unroll
    for (int i = 0; i < 8; ++i) { LAS float* d = scr + (8 * i + r) * 33 + 4 * c4; d[0] = v[i][0]; d[1] = v[i][1]; d[2] = v[i][2]; d[3] = v[i][3]; }
    asm volatile("s_waitcnt lgkmcnt(0)" ::: "memory");
#pragma unroll
    for (int j = 0; j < 4; ++j) { const int idx = lane + 64 * j, nn = idx >> 3, c = idx & 7; const LAS float* s_ = scr + (8 * c) * 33 + nn;
        u32x4 o; o.x = cvt_pk_bf16(s_[0 * 33], s_[1 * 33]); o.y = cvt_pk_bf16(s_[2 * 33], s_[3 * 33]); o.z = cvt_pk_bf16(s_[4 * 33], s_[5 * 33]); o.w = cvt_pk_bf16(s_[6 * 33], s_[7 * 33]);
        const int n = n0 + nn; const int drow = (t.mode == 1) ? (256 * (n >> 7) + (n & 127) + t.row_off) : (n + t.row_off);
        *(GAS u32x4*)(dst + (size_t)drow * t.ldt + k0 + 8 * c) = o; }
    asm volatile("s_waitcnt lgkmcnt(0)" ::: "memory");
}
__device__ __forceinline__ void cvt_pipe(const LAS CvtEnt* tab, int ntasks, LAS float* scr, int s0, int stepA, int stepB, int lane) {
    const int total = __builtin_amdgcn_readfirstlane(tab[ntasks].first);
    int ti = 0, fl = s0, st = 0;
    CvtEnt e0, e1, e2, e3; f32x4 v0[8], v1[8], v2[8], v3[8]; int f0 = 0, f1 = 0, f2 = 0, f3 = 0; bool m0, m1, m2, m3;
#define CVT_LD(k) do { m##k = fl < total; if (m##k) { f##k = fl; cvt_fetch(tab, ti, fl, e##k); cvt_load(e##k, fl, lane, v##k); fl += st ? stepB : stepA; st ^= 1; } } while (0)
#define CVT_ST(k) do { if (!m##k) return; cvt_store(e##k, scr, f##k, lane, v##k); } while (0)
    CVT_LD(0); CVT_LD(1); CVT_LD(2);
    for (;;) { CVT_LD(3); CVT_ST(0); CVT_LD(0); CVT_ST(1); CVT_LD(1); CVT_ST(2); CVT_LD(2); CVT_ST(3); }
#undef CVT_LD
#undef CVT_ST
}

struct Args { const float* in[40]; float* out; unsigned char* ws; int ph_lo, ph_hi; };

__global__ void __launch_bounds__(NTHREADS, 2) mk_fwd(Args args) {
    extern __shared__ __attribute__((aligned(16))) unsigned char lds_raw[];
    LAS unsigned char* lds = (LAS unsigned char*)lds_raw;
    volatile LAS unsigned* MISC = (volatile LAS unsigned*)(lds + MISC_OFF);
    const int tid0 = threadIdx.x;
    const int wave0 = __builtin_amdgcn_readfirstlane(tid0 >> 6);
    const int G0 = gridDim.x, bx0 = blockIdx.x;
    GAS unsigned char* ws = (GAS unsigned char*)args.ws;
    for (int u = tid0; u < (LDS_BYTES - LDSCTL_OFF) / 4; u += NTHREADS) ((LAS unsigned*)(lds + LDSCTL_OFF))[u] = 0u;
    __syncthreads();
    LAS unsigned long long* PTAB = (LAS unsigned long long*)(lds + PTAB_OFF);
    if (tid0 < 40) PTAB[tid0] = (unsigned long long)args.in[tid0];
    __syncthreads();
#define INP(i) inp_ptr(PTAB, (i))
#define Y2T_ADD(v_, tok_, q_) do { _Pragma("unroll") for (int k2_ = 0; k2_ < 2; ++k2_) { const int tr_ = __builtin_amdgcn_readfirstlane(((const GAS int*)(wsl + WS_TROW))[2 * (tok_) + k2_]); \
        if (tr_ >= 0) { _Pragma("unroll") for (int kq_ = 0; kq_ < 3; ++kq_) { const u32x2 yt_ = *(const GAS u32x2*)((const GAS bf16_t*)(wsl + WS_Y2T) + ((size_t)kq_ * 2048 + tr_) * D + 4 * lane + 256 * (q_)); \
            v_[0] += bf_lo(yt_.x); v_[1] += bf_hi(yt_.x); v_[2] += bf_lo(yt_.y); v_[3] += bf_hi(yt_.y); } } } } while (0)
#define E8(q_) (8 * lane + 512 * ((q_) >> 1) + 4 * ((q_) & 1))
#define PHASE_BASE() GAS unsigned char* wsl = ws; int G = G0, bx = bx0, tid = wave0 * 64 + (int)__builtin_amdgcn_mbcnt_hi(~0u, __builtin_amdgcn_mbcnt_lo(~0u, 0u)); asm volatile("" : "+s"(wsl), "+s"(G), "+s"(bx), "+v"(tid)); \
    const int lane = tid & 63, wave = __builtin_amdgcn_readfirstlane(tid >> 6); GAS unsigned* ctl = (GAS unsigned*)(wsl + WS_CTL); (void)ctl; (void)lane; \
    const int vcu = (G % 8 == 0) ? (bx % 8) * (G / 8) + bx / 8 : bx; const int gw = bx * NWAVES + wave, NGW = G * NWAVES; GAS unsigned char* ar = wsl + WS_AR; (void)ar; (void)vcu; (void)gw; (void)NGW
    XcdBarrier bar = xcd_barrier_post((unsigned*)args.ws + WS_CTL / 4 + CW_BAR, MISC + 8);
    const int lo = args.ph_lo, hi = args.ph_hi;
#define IN(k) ((lo <= (k) && (k) < hi) || ((k) == NPH - 1 && MK_N_LAUNCHES == 1))
#define SEAM(k) do { if (IN(k) && IN((k) + 1)) xcd_barrier(bar); } while (0)

#define hbuf0 ((GAS bf16_t*)(wsl + WS_H0))
#define hbuf1 ((GAS bf16_t*)(wsl + WS_H0 + (size_t)32 * 1024 * 1024))
#define vfirst ((GAS bf16_t*)(wsl + WS_VF))
#define y2 ((GAS bf16_t*)(wsl + WS_Y2))

    for (int rep_ = 0; rep_ <= ((MK_REPEAT >> 18) & 1); ++rep_) if (IN(0)) {
        PHASE_BASE();
        for (int item = bx; item < 128; item += G) {
            const int jl = item >> 6, g = item & 63;
            LAS float* pw_re = (LAS float*)lds;
            LAS float* pw_im = pw_re + 33 * 64;
            LAS float* bb_re = pw_im + 33 * 64;
            LAS float* bb_im = bb_re + 1024;
            LAS float* cc_re = bb_im + 1024;
            LAS float* cc_im = cc_re + 1024;
            LAS float* kt = cc_im + 1024;
            LAS float* sdr = kt + 8192;
            LAS float* sdi = sdr + 64;
            const GAS float* lam_re = INP(23) + ((size_t)jl * 64 + g) * 64; const GAS float* lam_im = INP(24) + ((size_t)jl * 64 + g) * 64;
            const float dt = __expf(INP(25)[jl * 64 + g]);
            if (tid < 64) { const int p = tid;
                const float lr = fminf(lam_re[p], -1e-4f), li = lam_im[p]; const float dr = lr * dt, di = li * dt;
                sdr[p] = dr; sdi[p] = di;
                const float ed = expf(dr), cd = cosf(di), sd = sinf(di), sh = sinf(0.5f * di);
                const float abar_im = ed * sd; const float num_re = expm1f(dr) * cd - 2.0f * sh * sh; const float den = lr * lr + li * li;
                const float cre = (num_re * lr + abar_im * li) / den, cim = (abar_im * lr - num_re * li) / den;
                const GAS float* bre = INP(26) + (((size_t)jl * 64 + g) * 64 + p) * 16; const GAS float* bim = INP(27) + (((size_t)jl * 64 + g) * 64 + p) * 16;
#pragma unroll
                for (int c = 0; c < 16; ++c) { const float br = bre[c], bi = bim[c]; bb_re[p * 16 + c] = cre * br - cim * bi; bb_im[p * 16 + c] = cre * bi + cim * br; }
            }
            for (int i = tid; i < 1024; i += NTHREADS) { cc_re[i] = INP(28)[((size_t)jl * 64 + g) * 1024 + i]; cc_im[i] = INP(29)[((size_t)jl * 64 + g) * 1024 + i]; }
            __syncthreads();
            for (int i = tid; i < 33 * 64; i += NTHREADS) { const int tau = i >> 6, p = i & 63;
                const float mag = expf((float)tau * sdr[p]); float rev = (float)tau * sdi[p] * 0.15915494309189535f; rev -= floorf(rev);
                const float ang = (rev > 0.5f ? rev - 1.0f : rev) * 6.283185307179586f;
                pw_re[i] = mag * cosf(ang); pw_im[i] = mag * sinf(ang); }
            __syncthreads();
            for (int i = tid; i < 8192; i += NTHREADS) { const int tau = i >> 8, co = (i >> 4) & 15, ci = i & 15; float s = 0.f;
                for (int p = 0; p < 64; ++p) { const float cr = cc_re[co * 64 + p], cm = cc_im[co * 64 + p], pr = pw_re[tau * 64 + p], pi = pw_im[tau * 64 + p];
                    const float abr = cr * pr - cm * pi, abi = cr * pi + cm * pr; s += abr * bb_re[p * 16 + ci] - abi * bb_im[p * 16 + ci]; }
                kt[i] = s; }
            __syncthreads();
            GAS bf16_t* toep = (GAS bf16_t*)(wsl + WS_WS + (size_t)jl * WSS_STRIDE + WSS_TOEP) + (size_t)g * 512 * S5K;
            for (int id = tid; id < 512 * 80; id += NTHREADS) { const int n = id / 80, kc = id % 80, k0 = kc * 8, tlo = n >> 4, co = n & 15;
                float v[8];
                if (k0 < 512) { const int tli = k0 >> 4, ci0 = k0 & 15;
#pragma unroll
                    for (int q = 0; q < 8; ++q) v[q] = (tlo >= tli) ? kt[((tlo - tli) * 16 + co) * 16 + ci0 + q] : 0.f; }
                else { const int p0 = k0 - 512; const bool im = p0 >= 64; const int pb = im ? p0 - 64 : p0; const int tau = tlo + 1;
#pragma unroll
                    for (int q = 0; q < 8; ++q) { const int p = pb + q; const float cr = cc_re[co * 64 + p], cm = cc_im[co * 64 + p], pr = pw_re[tau * 64 + p], pi = pw_im[tau * 64 + p];
                        v[q] = im ? -(cr * pi + cm * pr) : (cr * pr - cm * pi); } }
                u32x4 o; o.x = cvt_pk_bf16(v[0], v[1]); o.y = cvt_pk_bf16(v[2], v[3]); o.z = cvt_pk_bf16(v[4], v[5]); o.w = cvt_pk_bf16(v[6], v[7]);
                *(GAS u32x4*)(toep + (size_t)n * S5K + k0) = o; }
            GAS bf16_t* m1 = (GAS bf16_t*)(wsl + WS_WS + (size_t)jl * WSS_STRIDE + WSS_M1) + (size_t)g * 256 * 512;
            for (int id = tid; id < 256 * 64; id += NTHREADS) { const int n = id >> 6, kc = id & 63, k0 = kc * 8, tli = k0 >> 4, ci0 = k0 & 15;
                float v[8];
                if (n < 128) { const bool im = n >= 64; const int p = im ? n - 64 : n; const int tau = 31 - tli; const float pr = pw_re[tau * 64 + p], pi = pw_im[tau * 64 + p];
#pragma unroll
                    for (int q = 0; q < 8; ++q) { const float br = bb_re[p * 16 + ci0 + q], bi = bb_im[p * 16 + ci0 + q]; v[q] = im ? (pr * bi + pi * br) : (pr * br - pi * bi); } }
                else {
#pragma unroll
                    for (int q = 0; q < 8; ++q) v[q] = 0.f; }
                u32x4 o; o.x = cvt_pk_bf16(v[0], v[1]); o.y = cvt_pk_bf16(v[2], v[3]); o.z = cvt_pk_bf16(v[4], v[5]); o.w = cvt_pk_bf16(v[6], v[7]);
                *(GAS u32x4*)(m1 + (size_t)n * 512 + k0) = o; }
            __syncthreads();
        }
            LAS float* scr = (LAS float*)(lds + CVT_SCR_OFF + wave * CVT_SCR_WAVE);
        LAS CvtEnt* ctab = (LAS CvtEnt*)(lds + CVT_TAB_OFF);
        if (tid == 0) { int cn = 0, ctot = 0;
#pragma unroll 1
        for (int j = 0; j < 2; ++j) {
            GAS unsigned char* wr_ = wsl + WS_WR + (size_t)j * WR_STRIDE;
#pragma unroll 1
            for (int s = 0; s < 3; ++s) cvt_add(ctab, cn, ctot, INP(5) + ((size_t)j * 3 + s) * D * D, D, D, D, D, D, (GAS bf16_t*)(wr_ + WR_RKV) + (size_t)s * D * D, D, 0, 0);
            cvt_add(ctab, cn, ctot, INP(7) + (size_t)j * D * 64, D, 64, 64, D, 256, (GAS bf16_t*)(wr_ + WR_L1), D, 0, 0);
            cvt_add(ctab, cn, ctot, INP(10) + (size_t)j * D * 64, D, 64, 64, D, 256, (GAS bf16_t*)(wr_ + WR_L1) + (size_t)256 * D, D, 0, 0);
            cvt_add(ctab, cn, ctot, INP(12) + (size_t)j * D * 160, D, 160, 160, D, 256, (GAS bf16_t*)(wr_ + WR_L1) + (size_t)2 * 256 * D, D, 0, 0);
            if (j == 1) cvt_add(ctab, cn, ctot, INP(21), D, 32, 32, D, 256, (GAS bf16_t*)(wr_ + WR_L1) + (size_t)3 * 256 * D, D, 0, 0);
            cvt_add(ctab, cn, ctot, INP(8) + (size_t)j * 64 * D, 64, D, D, 256, D, (GAS bf16_t*)(wr_ + WR_L2), 256, 0, 0);
            cvt_add(ctab, cn, ctot, INP(11) + (size_t)j * 64 * D, 64, D, D, 256, D, (GAS bf16_t*)(wr_ + WR_L2) + (size_t)D * 256, 256, 0, 0);
            cvt_add(ctab, cn, ctot, INP(13) + (size_t)j * 160 * D, 160, D, D, 256, D, (GAS bf16_t*)(wr_ + WR_L2) + (size_t)2 * D * 256, 256, 0, 0);
            if (j == 1) cvt_add(ctab, cn, ctot, INP(22), 32, D, D, 256, D, (GAS bf16_t*)(wr_ + WR_L2) + (size_t)3 * D * 256, 256, 0, 0);
            cvt_add(ctab, cn, ctot, INP(19) + (size_t)j * D * D, D, D, D, D, D, (GAS bf16_t*)(wr_ + WR_WO), D, 0, 0);
            cvt_add(ctab, cn, ctot, INP(33) + (size_t)j * D * FF, D, FF, FF, D, FF, (GAS bf16_t*)(wr_ + WR_GU), D, 1, 0);
            cvt_add(ctab, cn, ctot, INP(34) + (size_t)j * D * FF, D, FF, FF, D, FF, (GAS bf16_t*)(wr_ + WR_GU), D, 1, 128);
            cvt_add(ctab, cn, ctot, INP(35) + (size_t)j * FF * D, FF, D, D, FF, D, (GAS bf16_t*)(wr_ + WR_WD), FF, 0, 0);
            GAS unsigned char* wss = wsl + WS_WS + (size_t)j * WSS_STRIDE;
            cvt_add(ctab, cn, ctot, INP(31) + (size_t)j * D * 2 * D, D, D, 2 * D, D, D, (GAS bf16_t*)(wss + WSS_GLU), D, 1, 0);
            cvt_add(ctab, cn, ctot, INP(31) + (size_t)j * D * 2 * D + D, D, D, 2 * D, D, D, (GAS bf16_t*)(wss + WSS_GLU), D, 1, 128);
        }
#pragma unroll 1
        for (int e = 0; e < NEXP; ++e) {
            cvt_add(ctab, cn, ctot, INP(37) + (size_t)e * D * FE, D, FE, FE, D, FE, (GAS bf16_t*)(wsl + WS_WM + WM_GU) + (size_t)e * 2 * FE * D, D, 1, 0);
            cvt_add(ctab, cn, ctot, INP(38) + (size_t)e * D * FE, D, FE, FE, D, FE, (GAS bf16_t*)(wsl + WS_WM + WM_GU) + (size_t)e * 2 * FE * D, D, 1, 128);
            cvt_add(ctab, cn, ctot, INP(39) + (size_t)e * FE * D, FE, D, D, FE, D, (GAS bf16_t*)(wsl + WS_WM + WM_WD) + (size_t)e * D * FE, FE, 0, 0);
        }
        MISC[41] = (unsigned)cn; }
        __syncthreads();
        {
            const int npre = (G < 128 ? G : 128) * NWAVES, NV = npre + 2 * (NGW - npre); const bool two = gw >= npre;
            cvt_pipe(ctab, (int)MISC[41], scr, two ? npre + 2 * (gw - npre) : gw, two ? 1 : NV, two ? NV - 1 : NV, lane); }
        __syncthreads();
}
    SEAM(0);

    for (int j = 0; j < 2; ++j) {
        const int pb = 1 + 19 * j;
#define wr_ (wsl + WS_WR + (size_t)j * WR_STRIDE)
#define wss (wsl + WS_WS + (size_t)j * WSS_STRIDE)
#define hcur ((j == 0) ? hbuf0 : hbuf1)
#define xs ((GAS bf16_t*)(ar + AR_XS))
#define rbuf ((GAS bf16_t*)(ar + AR_R))
#define kbuf ((GAS bf16_t*)(ar + AR_K))
#define vbuf ((j == 0) ? vfirst : (GAS bf16_t*)(ar + AR_V))
#define l1 ((GAS bf16_t*)(ar + AR_L1))
#define lwbuf ((GAS bf16_t*)(ar + AR_LW))
#define abuf ((GAS bf16_t*)(ar + AR_A))
#define gbuf ((GAS bf16_t*)(ar + AR_G))
#define yraw ((GAS float*)(ar + AR_YRAW))
#define yg ((GAS bf16_t*)(ar + AR_YG))
#define hn2 ((GAS bf16_t*)(ar + AR_HN2))
#define hmid ((GAS bf16_t*)(ar + AR_HMID))
#define ug ((GAS bf16_t*)(ar + AR_UG))
#define eb ((GAS float*)(ar + AR_EB))
#define yact ((GAS bf16_t*)(ar + AR_YACT))
#define asg_pe ((GAS unsigned*)(ar + AR_ASG))
#define asg_gate ((GAS float*)(ar + AR_ASG + 256 * 1024))
#define xsm ((GAS bf16_t*)(ar + AR_XSM))
#define rowslot ((GAS int*)(ar + AR_ROWM))
#define rowgate ((GAS float*)(ar + AR_ROWM + 512 * 1024))
#define rowtok ((GAS int*)(ar + AR_ROWM + 256 * 1024))
#define hmidm ((GAS bf16_t*)(ar + AR_HMIDM))
#define blkcnt ((GAS unsigned*)(ar + AR_ASG + 512 * 1024))

        for (int rep_ = 0; rep_ <= ((MK_REPEAT >> 0) & 1); ++rep_) if (IN(pb + 0)) {
            PHASE_BASE();
            LAS float* smu = (LAS float*)lds;
            LAS float* sg = smu + 6 * 1024;
            {   f32x4 mw[3]; float gw_[2];
#pragma unroll
                for (int u = 0; u < 3; ++u) mw[u] = *(const GAS f32x4*)(INP(4) + (size_t)j * 6 * 1024 + 4 * (tid + NTHREADS * u));
#pragma unroll
                for (int u = 0; u < 2; ++u) gw_[u] = INP(1)[(size_t)(2 * j) * 1024 + tid + NTHREADS * u];
#pragma unroll
                for (int u = 0; u < 3; ++u) *(LAS f32x4*)(smu + 4 * (tid + NTHREADS * u)) = mw[u];
#pragma unroll
                for (int u = 0; u < 2; ++u) sg[tid + NTHREADS * u] = gw_[u]; }
            __syncthreads();
#define Y2T_ADD2(v_, tr_, q_) do { if ((tr_) >= 0) { _Pragma("unroll") for (int kq_ = 0; kq_ < 3; ++kq_) { const u32x2 yt_ = *(const GAS u32x2*)((const GAS bf16_t*)(wsl + WS_Y2T) + ((size_t)kq_ * 2048 + (tr_)) * D + E8(q_)); \
            v_[0] += bf_lo(yt_.x); v_[1] += bf_hi(yt_.x); v_[2] += bf_lo(yt_.y); v_[3] += bf_hi(yt_.y); } } } while (0)
#define R1_E(q_) (8 * lane + 512 * ((q_) >> 1) + 4 * ((q_) & 1))
#define R1_LOAD(S_, tok_) do { \
            if (R1_COMB) { _Pragma("unroll") for (int g2 = 0; g2 < 2; ++g2) { lh[S_][g2] = *(const GAS u32x4*)(hbuf0 + (size_t)(tok_) * D + 8 * lane + 512 * g2); \
                    la[S_][g2] = *(const GAS u32x4*)(y2 + (size_t)(2 * (tok_)) * D + 8 * lane + 512 * g2); lb[S_][g2] = *(const GAS u32x4*)(y2 + (size_t)(2 * (tok_) + 1) * D + 8 * lane + 512 * g2); } \
                ltr[S_] = *(const GAS u32x2*)((const GAS int*)(wsl + WS_TROW) + 2 * (tok_)); } \
            else { _Pragma("unroll") for (int q = 0; q < 4; ++q) lx[S_][q] = *(const GAS f32x4*)(INP(0) + (size_t)(tok_) * D + R1_E(q)); } } while (0)
#define Y2T_ADD8(va_, vb_, tr_, g2_) do { if ((tr_) >= 0) { _Pragma("unroll") for (int kq_ = 0; kq_ < 3; ++kq_) { f32x4 ta_, tb_; \
            unpack8(*(const GAS u32x4*)((const GAS bf16_t*)(wsl + WS_Y2T) + ((size_t)kq_ * 2048 + (tr_)) * D + 8 * lane + 512 * (g2_)), ta_, tb_); va_ = va_ + ta_; vb_ = vb_ + tb_; } } } while (0)
#define R1_TOKENS() do { \
            for (int blk = bx; blk < M / 64; blk += G) { \
                const int t0 = blk * 64 + wave * 8; const bool seq0 = (t0 % T) == 0; \
                f32x4 prev[4], cur[4]; f32x4 lx[2][4]; u32x4 lh[2][2], la[2][2], lb[2][2]; u32x2 ltr[2]; \
                R1_LOAD(0, seq0 ? t0 : t0 - 1); \
                _Pragma("unroll") for (int tt = -1; tt < 8; ++tt) { \
                    const int tok = t0 + tt; const int S = (tt + 1) & 1; \
                    if (tt < 7) R1_LOAD(S ^ 1, tok + 1); \
                    float ss = 0.f; \
                    if (R1_COMB) { const int tr0 = __builtin_amdgcn_readfirstlane((int)ltr[S].x), tr1 = __builtin_amdgcn_readfirstlane((int)ltr[S].y); \
                        _Pragma("unroll") for (int g2 = 0; g2 < 2; ++g2) { f32x4 h0, h1, a0_, a1_, b0_, b1_; unpack8(lh[S][g2], h0, h1); unpack8(la[S][g2], a0_, a1_); unpack8(lb[S][g2], b0_, b1_); \
                            f32x4 va = h0 + (a0_ + b0_), vb = h1 + (a1_ + b1_); \
                            Y2T_ADD8(va, vb, tr0, g2); Y2T_ADD8(va, vb, tr1, g2); \
                            if (tt >= 0) *(GAS u32x4*)(hcur + (size_t)tok * D + 8 * lane + 512 * g2) = pack8(va, vb); \
                            cur[2 * g2] = va; cur[2 * g2 + 1] = vb; } } \
                    else { _Pragma("unroll") for (int g2 = 0; g2 < 2; ++g2) { cur[2 * g2] = lx[S][2 * g2]; cur[2 * g2 + 1] = lx[S][2 * g2 + 1]; \
                            if (tt >= 0) *(GAS u32x4*)(hcur + (size_t)tok * D + 8 * lane + 512 * g2) = pack8(cur[2 * g2], cur[2 * g2 + 1]); } } \
                    _Pragma("unroll") for (int q = 0; q < 4; ++q) ss += cur[q][0] * cur[q][0] + cur[q][1] * cur[q][1] + cur[q][2] * cur[q][2] + cur[q][3] * cur[q][3]; \
                    const float rs = rsqrtf(wave_sum(ss) * (1.0f / D) + NORM_EPS); \
                    _Pragma("unroll") for (int q = 0; q < 4; ++q) cur[q] = cur[q] * rs * *(const LAS f32x4*)(sg + R1_E(q)); \
                    if (tt == -1 && seq0) { _Pragma("unroll") for (int q = 0; q < 4; ++q) cur[q] = (f32x4){0.f, 0.f, 0.f, 0.f}; }          \
                    if (tt >= 0) { \
                        _Pragma("unroll") for (int s = 0; s < 6; ++s) \
                            _Pragma("unroll") for (int g2 = 0; g2 < 2; ++g2) { f32x4 o_[2]; \
                                _Pragma("unroll") for (int hh = 0; hh < 2; ++hh) { const int q = 2 * g2 + hh; const f32x4 mu = *(const LAS f32x4*)(smu + s * 1024 + R1_E(q)); o_[hh] = cur[q] + (prev[q] - cur[q]) * mu; } \
                                *(GAS u32x4*)(xs + (size_t)s * M * D + (size_t)tok * D + 8 * lane + 512 * g2) = pack8(o_[0], o_[1]); } } \
                    _Pragma("unroll") for (int q = 0; q < 4; ++q) prev[q] = cur[q]; \
                } \
            } } while (0)
            if (j == 0) {
#define R1_COMB false
                R1_TOKENS();
#undef R1_COMB
            } else {
#define R1_COMB true
                R1_TOKENS();
#undef R1_COMB
            }
#undef R1_TOKENS
#undef R1_LOAD
#undef R1_E
            if (j == 1) {
                __syncthreads();
                LAS float* scr = (LAS float*)(lds + CVT_SCR_OFF + wave * CVT_SCR_WAVE);
                LAS CvtEnt* ctab = (LAS CvtEnt*)(lds + CVT_TAB_OFF);
                if (tid == 0) { int cn = 0, ctot = 0;
                int dD = D, dFE = FE; asm volatile("" : "+s"(dD), "+s"(dFE));
#pragma unroll 1
                for (int e = 0; e < NEXP; ++e) {
                    cvt_add(ctab, cn, ctot, INP(37) + ((size_t)NEXP + e) * D * FE, dD, dFE, dFE, dD, dFE, (GAS bf16_t*)(wsl + WS_WM + WM_GU) + (size_t)e * 2 * FE * D, dD, 1, 0);
                    cvt_add(ctab, cn, ctot, INP(38) + ((size_t)NEXP + e) * D * FE, dD, dFE, dFE, dD, dFE, (GAS bf16_t*)(wsl + WS_WM + WM_GU) + (size_t)e * 2 * FE * D, dD, 1, 128);
                    cvt_add(ctab, cn, ctot, INP(39) + ((size_t)NEXP + e) * FE * D, dFE, dD, dD, dFE, dD, (GAS bf16_t*)(wsl + WS_WM + WM_WD) + (size_t)e * D * FE, dFE, 0, 0);
                }
                MISC[41] = (unsigned)cn; }
                __syncthreads();
                cvt_pipe(ctab, (int)MISC[41], scr, gw, NGW, NGW, lane);
            }
            __syncthreads();
        }
        SEAM(pb + 0);

        for (int rep_ = 0; rep_ <= ((MK_REPEAT >> 1) & 1); ++rep_) if (IN(pb + 1)) {
            PHASE_BASE();
            SchedR2 S{uni_ptr((const GAS char*)xs), uni_ptr((const GAS char*)(wr_ + WR_RKV)), uni_ptr((const GAS char*)(wr_ + WR_L1)), (j == 0) ? 15 : 16, G, bx};
            EpiR2 E{rbuf, vbuf, l1};
            gemm_phase(lds, tid, D, D, D, S, E);
        }
        SEAM(pb + 1);

        for (int rep_ = 0; rep_ <= ((MK_REPEAT >> 2) & 1); ++rep_) if (IN(pb + 2)) {
            PHASE_BASE();
            SchedR3 S{uni_ptr((const GAS char*)l1), uni_ptr((const GAS char*)(wr_ + WR_L2)), (j == 0) ? 12 : 16, G, bx};
            EpiR3 E{wsl, PTAB, j};
            gemm_phase(lds, tid, 256, 256, 256, S, E);
        }
        SEAM(pb + 2);

#if MK_CHUNKED
#define cqb ((GAS bf16_t*)(wsl + WS_Y2))
#define cnb ((GAS bf16_t*)(wsl + WS_Y2 + 32 * MiB))
#define czb ((GAS bf16_t*)(ar + 96 * MiB))
#define cyl ((GAS bf16_t*)(ar + 128 * MiB))
#define csb ((GAS bf16_t*)(ar + 288 * MiB))
#define cbon ((GAS float*)(ar + 320 * MiB))
        for (int rep_ = 0; rep_ <= ((MK_REPEAT >> 3) & 1); ++rep_) if (IN(pb + 3)) {
            PHASE_BASE();
#if MK_STAMP == 6
            if (j == 0 && tid == 0) MISC[40] = 1u;
            __syncthreads();
            STAMP_AT(0, true);
#endif
            constexpr int LD = 72;
            LAS bf16_t* T_ABAR = (LAS bf16_t*)(lds + 0); LAS bf16_t* T_RBAR = (LAS bf16_t*)(lds + 9216); LAS bf16_t* T_BT = (LAS bf16_t*)(lds + 18432); LAS bf16_t* T_KT = (LAS bf16_t*)(lds + 27648);
            LAS bf16_t* T_BTT = (LAS bf16_t*)(lds + 36864); LAS bf16_t* T_KTT = (LAS bf16_t*)(lds + 46080); LAS bf16_t* T_VT = (LAS bf16_t*)(lds + 55296);
            LAS bf16_t* T_AAB = (LAS bf16_t*)(lds + 64512);
            LAS float* F_DIAG = (LAS float*)(lds + 73728);
            LAS float* F_G = (LAS float*)(lds + 64512);
            LAS bf16_t* T_AAK = (LAS bf16_t*)(lds + 81920); LAS bf16_t* T_ABR = (LAS bf16_t*)(lds + 91136); LAS bf16_t* T_AKR = (LAS bf16_t*)(lds + 100352);
            LAS float* F_W = (LAS float*)(lds + 109568);
            LAS bf16_t* T_V = (LAS bf16_t*)(lds + 109568);
            LAS float* F_SEG = (LAS float*)(lds + 125952);
            LAS float* F_TI = (LAS float*)(lds + 125952);
            LAS float* F_PL = (LAS float*)(lds + 130816);
            LAS bf16_t* T_MTT = T_BT; LAS bf16_t* T_X1T = T_KT;
            const int r = lane & 15, q = lane >> 4;
            const GAS float* k_k = INP(14) + (size_t)j * D; const GAS float* k_a = INP(15) + (size_t)j * D; const GAS float* r_k = INP(16) + (size_t)j * D;
            LAS float* P_KK = (LAS float*)(lds + LDSCTL_OFF + 4096); LAS float* P_KA = P_KK + 1024; LAS float* P_RK = P_KA + 1024;
            {   const int i0 = 4 * tid;
                const f32x4 p0_ = *(const GAS f32x4*)((i0 < 1024 ? k_k : k_a - 1024) + i0); f32x4 p1_ = (f32x4){0.f, 0.f, 0.f, 0.f}; if (tid < 256) p1_ = *(const GAS f32x4*)(r_k + i0);
                *(LAS f32x4*)(P_KK + i0) = p0_; if (tid < 256) *(LAS f32x4*)(P_RK + i0) = p1_; }
            __syncthreads();
#define TILE_MMA(acc_, At_, arow_, Bt_, brow_) do { _Pragma("unroll") for (int ks_ = 0; ks_ < 2; ++ks_) { \
                const bf16x8 a_ = *(const LAS bf16x8*)((At_) + ((arow_) + r) * LD + 32 * ks_ + 8 * q), b_ = *(const LAS bf16x8*)((Bt_) + ((brow_) + r) * LD + 32 * ks_ + 8 * q); \
                acc_ = __builtin_amdgcn_mfma_f32_16x16x32_bf16(a_, b_, acc_, 0, 0, 0); } } while (0)
            u32x4 pf_r, pf_k, pf_v, pf_l, pf_a;
#define W1_LOAD(it_) do { const int hd_ = (it_) >> 5, c_ = (it_) & 31; const size_t go_ = ((size_t)(hd_ >> 4) * T + c_ * 64 + (tid >> 3)) * D + (hd_ & 15) * 64 + 8 * (tid & 7); \
                pf_r = *(const GAS u32x4*)(rbuf + go_); pf_k = *(const GAS u32x4*)(kbuf + go_); pf_v = *(const GAS u32x4*)(vbuf + go_); pf_l = *(const GAS u32x4*)(lwbuf + go_); pf_a = *(const GAS u32x4*)(abuf + go_); } while (0)
            for (int it = bx; it < 4096; it += G) {
                W1_LOAD(it);
                const int hd = it >> 5, c = it & 31, b = hd >> 4, h = hd & 15;
                const size_t tok0 = (size_t)b * T + c * 64;
                const int t = tid >> 3, c8 = tid & 7;
                f32x4 al0, al1, be0, be1, km0, km1, r0, r1, lq0, lq1;
                {
                    f32x4 k0, k1, v0, v1, a0, a1;
                    unpack8(pf_r, r0, r1); unpack8(pf_k, k0, k1); unpack8(pf_v, v0, v1); unpack8(pf_l, lq0, lq1); unpack8(pf_a, a0, a1);
                    const int co = h * 64 + 8 * c8;
                    const f32x4 kk0w = *(const LAS f32x4*)(P_KK + co), kk1w = *(const LAS f32x4*)(P_KK + co + 4), ka0 = *(const LAS f32x4*)(P_KA + co), ka1 = *(const LAS f32x4*)(P_KA + co + 4);
                    const f32x4 rk0 = *(const LAS f32x4*)(P_RK + co), rk1 = *(const LAS f32x4*)(P_RK + co + 4);
                    f32x4 kk0 = k0 * kk0w, kk1 = k1 * kk1w; float n2 = 0.f, bon = 0.f;
#pragma unroll
                    for (int e = 0; e < 4; ++e) { n2 += kk0[e] * kk0[e] + kk1[e] * kk1[e]; km0[e] = k0[e] * (1.0f + (a0[e] - 1.0f) * ka0[e]); km1[e] = k1[e] * (1.0f + (a1[e] - 1.0f) * ka1[e]);
                        bon += r0[e] * km0[e] * rk0[e] + r1[e] * km1[e] * rk1[e]; }
                    n2 = quad_sum(n2); n2 += dpp_f<0x141>(n2); bon = quad_sum(bon); bon += dpp_f<0x141>(bon);
                    const float inv = 1.0f / fmaxf(sqrtf(n2), 1e-12f); kk0 = kk0 * inv; kk1 = kk1 * inv;
                    al0 = -kk0; al1 = -kk1; be0 = kk0 * a0; be1 = kk1 * a1;
                    if (c8 == 0) cbon[(tok0 + t) * 16 + h] = bon;
                    *(LAS f32x4*)(F_G + t * 64 + 8 * c8) = lq0; *(LAS f32x4*)(F_G + t * 64 + 8 * c8 + 4) = lq1;
                    *(LAS u32x4*)(T_V + t * LD + 8 * c8) = pack8(v0, v1);
                }
                __syncthreads();
                {
                    const int jj = tid & 63, seg = tid >> 6; float pv[8]; float run = 0.f;
#pragma unroll
                    for (int e = 0; e < 8; ++e) { run += F_G[(8 * seg + e) * 64 + jj]; pv[e] = run; }
                    F_SEG[seg * 64 + jj] = run;
                    __syncthreads();
                    float offs = 0.f;
#pragma unroll
                    for (int s_ = 0; s_ < 7; ++s_) offs += (s_ < seg) ? F_SEG[s_ * 64 + jj] : 0.f;
#pragma unroll
                    for (int e = 0; e < 8; ++e) F_G[(8 * seg + e) * 64 + jj] = pv[e] + offs;
                    if (seg == 7) F_PL[jj] = __expf(pv[7] + offs);
                }
                __syncthreads();
                {
                    const f32x4 g0 = *(const LAS f32x4*)(F_G + t * 64 + 8 * c8), g1 = *(const LAS f32x4*)(F_G + t * 64 + 8 * c8 + 4);
                    f32x4 ab0, ab1, rb0, rb1, bt0, bt1, kt0, kt1;
#pragma unroll
                    for (int e = 0; e < 4; ++e) { const float eg0 = __expf(g0[e]), eg1 = __expf(g1[e]), em0 = __expf(g0[e] - lq0[e]), em1 = __expf(g1[e] - lq1[e]), ei0 = __expf(-g0[e]), ei1 = __expf(-g1[e]);
                        ab0[e] = al0[e] * em0; ab1[e] = al1[e] * em1; rb0[e] = r0[e] * eg0; rb1[e] = r1[e] * eg1; bt0[e] = be0[e] * ei0; bt1[e] = be1[e] * ei1; kt0[e] = km0[e] * ei0; kt1[e] = km1[e] * ei1; }
                    *(LAS u32x4*)(T_ABAR + t * LD + 8 * c8) = pack8(ab0, ab1); *(LAS u32x4*)(T_RBAR + t * LD + 8 * c8) = pack8(rb0, rb1);
                    *(LAS u32x4*)(T_BT + t * LD + 8 * c8) = pack8(bt0, bt1); *(LAS u32x4*)(T_KT + t * LD + 8 * c8) = pack8(kt0, kt1);
                }
                __syncthreads();
                {
                    const int jj = tid & 63, seg = tid >> 6;
                    unsigned wb[4], wk_[4], wv_[4];
#pragma unroll
                    for (int e = 0; e < 4; ++e) { const int s0 = 8 * seg + 2 * e;
                        wb[e] = (unsigned)T_BT[s0 * LD + jj] | ((unsigned)T_BT[(s0 + 1) * LD + jj] << 16); wk_[e] = (unsigned)T_KT[s0 * LD + jj] | ((unsigned)T_KT[(s0 + 1) * LD + jj] << 16);
                        wv_[e] = (unsigned)T_V[s0 * LD + jj] | ((unsigned)T_V[(s0 + 1) * LD + jj] << 16); }
                    *(LAS u32x4*)(T_BTT + jj * LD + 8 * seg) = (u32x4){wb[0], wb[1], wb[2], wb[3]}; *(LAS u32x4*)(T_KTT + jj * LD + 8 * seg) = (u32x4){wk_[0], wk_[1], wk_[2], wk_[3]};
                    *(LAS u32x4*)(T_VT + jj * LD + 8 * seg) = (u32x4){wv_[0], wv_[1], wv_[2], wv_[3]};
                }
                __syncthreads();
                {
                    const int pidx = wave >> 1, mh = wave & 1;
                    const LAS bf16_t* At_ = (pidx < 2) ? T_ABAR : T_RBAR; const LAS bf16_t* Bt_ = (pidx & 1) ? T_KT : T_BT;
                    LAS bf16_t* Ot = (pidx == 0) ? T_AAB : ((pidx == 1) ? T_AAK : ((pidx == 2) ? T_ABR : T_AKR));
#pragma unroll
                    for (int mi = 0; mi < 2; ++mi)
#pragma unroll
                        for (int nt = 0; nt < 4; ++nt) { const int mt = 2 * mh + mi; f32x4 acc = (f32x4){0.f, 0.f, 0.f, 0.f};
                            TILE_MMA(acc, At_, 16 * mt, Bt_, 16 * nt);
                            const int s_ = 16 * nt + r;
#pragma unroll
                            for (int e = 0; e < 4; ++e) { const int tt = 16 * mt + 4 * q + e; const bool keep = (pidx < 2) ? (s_ < tt) : (s_ <= tt); const float v_ = keep ? acc[e] : 0.f;
                                Ot[tt * LD + s_] = (bf16_t)(cvt_pk_bf16(v_, 0.f) & 0xffffu);
                                if (pidx == 0 && (mt == nt)) F_DIAG[(mt * 16 + 4 * q + e) * 20 + r] = v_; } }
                }
                __syncthreads();
                {
                    const int mt = wave >> 1;
#pragma unroll
                    for (int nn = 0; nn < 2; ++nn) { const int nt = 2 * (wave & 1) + nn; f32x4 acc = (f32x4){0.f, 0.f, 0.f, 0.f};
                        TILE_MMA(acc, T_AAK, 16 * mt, T_VT, 16 * nt);
#pragma unroll
                        for (int e = 0; e < 4; ++e) F_W[(16 * mt + 4 * q + e) * 64 + 16 * nt + r] = acc[e]; }
                    if (wave == 7) {
                        const int blk = lane >> 4, cc = lane & 15; float x[16];
#pragma unroll
                        for (int tl = 0; tl < 16; ++tl) { float acc = (tl == cc) ? 1.0f : 0.0f;
#pragma unroll
                            for (int s4 = 0; s4 < (tl + 3) / 4; ++s4) { const f32x4 cf = *(const LAS f32x4*)(F_DIAG + (blk * 16 + tl) * 20 + 4 * s4);
#pragma unroll
                                for (int e = 0; e < 4; ++e) if (4 * s4 + e < tl) acc += cf[e] * x[4 * s4 + e]; }
                            x[tl] = acc; F_TI[(blk * 16 + tl) * 16 + cc] = acc; }
                    }
                }
                __syncthreads();
                {
                    const int sub = wave >> 2, ct = wave & 3;
                    LAS bf16_t* OT = (sub == 0) ? T_MTT : T_X1T;
                    { unsigned z_; asm volatile("v_mov_b32 %0, 0" : "=v"(z_)); LAS bf16_t* zr = OT + (16 * ct + r) * LD + 16 * q; *(LAS u32x4*)zr = (u32x4){z_, z_, z_, z_}; *(LAS u32x4*)(zr + 8) = (u32x4){z_, z_, z_, z_}; }
                    asm volatile("s_waitcnt lgkmcnt(0)" ::: "memory");
                    for (int bk = 0; bk < 4; ++bk) {
                        f32x4 d = (f32x4){0.f, 0.f, 0.f, 0.f};
                        if (bk > 0) TILE_MMA(d, T_AAB, 16 * bk, OT, 16 * ct);
#pragma unroll
                        for (int e = 0; e < 4; ++e) { const int tt = 16 * bk + 4 * q + e; d[e] += (sub == 0) ? __uint_as_float((unsigned)T_ABAR[tt * LD + 16 * ct + r] << 16) : F_W[tt * 64 + 16 * ct + r]; }
                        const f32x4 ti4 = *(const LAS f32x4*)(F_TI + (bk * 16 + r) * 16 + 4 * q);
                        f32x4 o = (f32x4){0.f, 0.f, 0.f, 0.f};
#pragma unroll
                        for (int kk = 0; kk < 4; ++kk) o = __builtin_amdgcn_mfma_f32_16x16x4f32(d[kk], ti4[kk], o, 0, 0, 0);
#pragma unroll
                        for (int e = 0; e < 4; ++e) OT[(16 * ct + 4 * q + e) * LD + 16 * bk + r] = (bf16_t)(cvt_pk_bf16(o[e], 0.f) & 0xffffu);
                        asm volatile("s_waitcnt lgkmcnt(0)" ::: "memory");
                    }
                }
                __syncthreads();
                {
                    const int mt = wave >> 1; const int row4 = 16 * mt + 4 * q;
                    GAS bf16_t* nb_it = cnb + (size_t)it * 4096; GAS bf16_t* qb_it = cqb + (size_t)it * 4096; GAS bf16_t* zb_it = czb + (size_t)it * 4096; GAS bf16_t* yl_it = cyl + (size_t)it * 4096;
#pragma unroll
                    for (int nn = 0; nn < 2; ++nn) { const int nt = 2 * (wave & 1) + nn; const int col = 16 * nt + r;
                        {
                            f32x4 acc = (f32x4){0.f, 0.f, 0.f, 0.f}; TILE_MMA(acc, T_MTT, 16 * mt, T_ABR, 16 * nt);
                            const u32x2 rb = *(const LAS u32x2*)(T_RBAR + col * LD + row4);
                            acc[0] += bf_lo(rb.x); acc[1] += bf_hi(rb.x); acc[2] += bf_lo(rb.y); acc[3] += bf_hi(rb.y);
                            u32x2 o; o.x = cvt_pk_bf16(acc[0], acc[1]); o.y = cvt_pk_bf16(acc[2], acc[3]); *(GAS u32x2*)(nb_it + col * 64 + row4) = o; } __builtin_amdgcn_sched_barrier(0);
                        {
                            const int prow = 4 * mt + 16 * (r >> 2) + (r & 3) - r;
                            f32x4 acc = (f32x4){0.f, 0.f, 0.f, 0.f}; TILE_MMA(acc, T_X1T, prow, T_ABR, 16 * nt); TILE_MMA(acc, T_VT, prow, T_AKR, 16 * nt);
                            u32x2 o; o.x = cvt_pk_bf16(acc[0], acc[1]); o.y = cvt_pk_bf16(acc[2], acc[3]); *(GAS u32x2*)(yl_it + (nt * 64 + lane) * 16 + 4 * mt) = o; } __builtin_amdgcn_sched_barrier(0);
                        {
                            f32x4 acc = (f32x4){0.f, 0.f, 0.f, 0.f}; TILE_MMA(acc, T_MTT, 16 * mt, T_BTT, 16 * nt);
                            const float pl = F_PL[col];
#pragma unroll
                            for (int e = 0; e < 4; ++e) acc[e] = pl * (acc[e] + ((row4 + e == col) ? 1.0f : 0.0f));
                            u32x2 o; o.x = cvt_pk_bf16(acc[0], acc[1]); o.y = cvt_pk_bf16(acc[2], acc[3]); *(GAS u32x2*)(qb_it + col * 64 + 32 * (mt >> 1) + 8 * q + 4 * (mt & 1)) = o; } __builtin_amdgcn_sched_barrier(0);
                        {
                            f32x4 acc = (f32x4){0.f, 0.f, 0.f, 0.f}; TILE_MMA(acc, T_BTT, 16 * mt, T_X1T, 16 * nt); TILE_MMA(acc, T_KTT, 16 * mt, T_VT, 16 * nt);
                            const f32x4 pl = *(const LAS f32x4*)(F_PL + row4);
                            u32x2 o; o.x = cvt_pk_bf16(acc[0] * pl[0], acc[1] * pl[1]); o.y = cvt_pk_bf16(acc[2] * pl[2], acc[3] * pl[3]); *(GAS u32x2*)(zb_it + col * 64 + 16 * q + 4 * mt) = o;        } __builtin_amdgcn_sched_barrier(0);
                    }
                }
                __syncthreads();
            }
#undef TILE_MMA
#undef W1_LOAD
        #if MK_STAMP == 6
            __syncthreads(); STAMP_AT(3, true); __syncthreads(); if (tid == 0) MISC[40] = 0u;
#endif
        }
        SEAM(pb + 3);

        for (int rep_ = 0; rep_ <= ((MK_REPEAT >> 4) & 1); ++rep_) if (IN(pb + 4)) {
            PHASE_BASE();
            const int r = lane & 15, q = lane >> 4;
            volatile LAS unsigned* w2f = (volatile LAS unsigned*)(lds + LDSCTL_OFF + 2048);
            if (tid < 196) w2f[tid] = 0u;
            __syncthreads();
            const bool fast = (2 * vcu + 1 < 512) && (2 * vcu + 2 * G >= 512);
            const int hd0 = (2 * vcu) >> 2;
            LAS unsigned char* qring = lds + 65536;
            if (fast && wave >= 4) {
                const int k = wave - 4; const int lrow = lane >> 3, lch = lane & 7;
                u32x4 qd0[2], qd1[2], qd2[2], qd3[2];
#define W2Q_LOAD(qd, c_) do { const GAS bf16_t* qb_ = cqb + ((size_t)hd0 * 32 + (c_)) * 4096 + (16 * k + lrow) * 64 + 8 * lch; qd[0] = *(const GAS u32x4*)qb_; qd[1] = *(const GAS u32x4*)(qb_ + 8 * 64); } while (0)
#define W2Q_PUT(qd, c_) do { if ((c_) >= 8) { while ((int)w2f[192] < (c_) - 7 || (int)w2f[193] < (c_) - 7) __builtin_amdgcn_s_sleep(1); } \
                    LAS unsigned char* sl_ = qring + ((c_) & 7) * 8192 + (16 * k + lrow) * 128 + ((lch ^ (lrow & 7)) * 16); \
                    *(LAS u32x4*)sl_ = qd[0]; *(LAS u32x4*)(sl_ + 8 * 128) = qd[1]; asm volatile("s_waitcnt lgkmcnt(0)" ::: "memory"); if (lane == 0) w2f[64 + 4 * (c_) + k] = 1u; } while (0)
                W2Q_LOAD(qd0, 0); W2Q_LOAD(qd1, 1); W2Q_LOAD(qd2, 2); W2Q_LOAD(qd3, 3);
                for (int c = 0; c < 32; c += 4) {
                    W2Q_PUT(qd0, c);     W2Q_LOAD(qd0, (c + 4 < 32 ? c + 4 : 31));
                    W2Q_PUT(qd1, c + 1); W2Q_LOAD(qd1, (c + 5 < 32 ? c + 5 : 31));
                    W2Q_PUT(qd2, c + 2); W2Q_LOAD(qd2, (c + 6 < 32 ? c + 6 : 31));
                    W2Q_PUT(qd3, c + 3); W2Q_LOAD(qd3, (c + 7 < 32 ? c + 7 : 31)); }
#undef W2Q_LOAD
#undef W2Q_PUT
            }
            if (fast && (wave == 2 || wave == 3)) {
                const int cw = wave - 2, wi = 2 * vcu + cw; const int iq = wi & 3; const int rr = lane >> 3, pc = lane & 7;
                for (int c = 0; c < 32; ++c) {
                    while (w2f[32 * cw + c] == 0u) __builtin_amdgcn_s_sleep(1);
                    asm volatile("" ::: "memory");
                    const LAS unsigned char* slot = lds + (size_t)cw * 32768 + (c & 15) * 2048;
                    const u32x4 d0 = *(const LAS u32x4*)(slot + rr * 128 + pc * 16), d1 = *(const LAS u32x4*)(slot + (8 + rr) * 128 + pc * 16);
                    asm volatile("s_waitcnt lgkmcnt(0)" ::: "memory"); if (lane == 0) w2f[194 + cw] = (unsigned)(c + 1);
                    GAS bf16_t* dstt = csb + ((size_t)hd0 * 32 + c) * 4096 + (size_t)(16 * iq) * 64;
                    *(GAS u32x4*)(dstt + rr * 64 + 8 * (pc ^ (rr & 7))) = d0; *(GAS u32x4*)(dstt + (8 + rr) * 64 + 8 * (pc ^ (rr & 7))) = d1; }
                asm volatile("s_waitcnt vmcnt(0)" ::: "memory");
            }
            if (fast && wave < 2) {
                const int wi = 2 * vcu + wave, iq = wi & 3, i = 16 * iq + r;
                f32x4 Dt[4];
#pragma unroll
                for (int mt = 0; mt < 4; ++mt) Dt[mt] = (f32x4){0.f, 0.f, 0.f, 0.f};
                u32x4 zq0[2], zq1[2], zq2[2], zq3[2];
#define W2Z_LOAD(zq, c_) do { const GAS bf16_t* zb_ = czb + ((size_t)hd0 * 32 + (c_)) * 4096 + i * 64 + 16 * q; zq[0] = *(const GAS u32x4*)zb_; zq[1] = *(const GAS u32x4*)(zb_ + 8); } while (0)
#define W2F_STEP(zq, c_) do { u32x2 pk[4]; \
                    _Pragma("unroll") for (int mt = 0; mt < 4; ++mt) { pk[mt].x = cvt_pk_bf16(Dt[mt][0], Dt[mt][1]); pk[mt].y = cvt_pk_bf16(Dt[mt][2], Dt[mt][3]); } \
                    if ((c_) >= 16) { while ((int)w2f[194 + wave] < (c_) - 15) __builtin_amdgcn_s_sleep(1); } \
                    {   LAS unsigned char* slot_ = lds + (size_t)wave * 32768 + ((c_) & 15) * 2048 + r * 128 + 8 * (q & 1); \
                        _Pragma("unroll") for (int mt = 0; mt < 4; ++mt) *(LAS u32x2*)(slot_ + 16 * ((2 * mt + (q >> 1)) ^ (r & 7))) = pk[mt]; \
                        asm volatile("s_waitcnt lgkmcnt(0)" ::: "memory"); if (lane == 0) w2f[32 * wave + (c_)] = 1u; } \
                    for (;;) { const u32x4 f_ = *(volatile LAS u32x4*)(w2f + 64 + 4 * (c_)); if (f_.x && f_.y && f_.z && f_.w) break; __builtin_amdgcn_s_sleep(1); } \
                    asm volatile("" ::: "memory"); \
                    u32x4 qa[4][2]; { const LAS unsigned char* qs_ = qring + ((c_) & 7) * 8192 + r * 128; \
                        _Pragma("unroll") for (int mt = 0; mt < 4; ++mt) _Pragma("unroll") for (int ks = 0; ks < 2; ++ks) qa[mt][ks] = *(const LAS u32x4*)(qs_ + 16 * mt * 128 + (((4 * ks + q) ^ (r & 7)) * 16)); } \
                    asm volatile("s_waitcnt lgkmcnt(0)" ::: "memory"); if (lane == 0) w2f[192 + wave] = (unsigned)((c_) + 1); \
                    f32x4 zl[4]; unpack8(zq[0], zl[0], zl[1]); unpack8(zq[1], zl[2], zl[3]); \
                    _Pragma("unroll") for (int mt = 0; mt < 4; ++mt) { f32x4 acc = zl[mt]; \
                        _Pragma("unroll") for (int ks = 0; ks < 2; ++ks) { const u32x4 aw = qa[mt][ks]; const u32x4 bw = (u32x4){pk[2 * ks].x, pk[2 * ks].y, pk[2 * ks + 1].x, pk[2 * ks + 1].y}; \
                            acc = __builtin_amdgcn_mfma_f32_16x16x32_bf16(__builtin_bit_cast(bf16x8, aw), __builtin_bit_cast(bf16x8, bw), acc, 0, 0, 0); } \
                        Dt[mt] = acc; } } while (0)
                W2Z_LOAD(zq0, 0); W2Z_LOAD(zq1, 1); W2Z_LOAD(zq2, 2); W2Z_LOAD(zq3, 3);
                for (int c = 0; c < 32; c += 4) {
                    W2F_STEP(zq0, c);     W2Z_LOAD(zq0, (c + 4 < 32 ? c + 4 : 31));
                    W2F_STEP(zq1, c + 1); W2Z_LOAD(zq1, (c + 5 < 32 ? c + 5 : 31));
                    W2F_STEP(zq2, c + 2); W2Z_LOAD(zq2, (c + 6 < 32 ? c + 6 : 31));
                    W2F_STEP(zq3, c + 3); W2Z_LOAD(zq3, (c + 7 < 32 ? c + 7 : 31)); }
#undef W2Z_LOAD
#undef W2F_STEP
            }
            if (!fast) for (int wi = 2 * vcu + wave; wave < 2 && wi < 512; wi += 2 * G) {
                const int hd = wi >> 2, iq = wi & 3, i = 16 * iq + r;
                f32x4 Dt[4];
#pragma unroll
                for (int mt = 0; mt < 4; ++mt) Dt[mt] = (f32x4){0.f, 0.f, 0.f, 0.f};
                u32x4 qa0[4][2], qa1[4][2], qa2[4][2], qa3[4][2]; u32x2 za0[4], za1[4], za2[4], za3[4];
#define W2_LOAD(qa, za, c_) do { const GAS bf16_t* qb_ = cqb + ((size_t)hd * 32 + (c_)) * 4096; const GAS bf16_t* zb_ = czb + ((size_t)hd * 32 + (c_)) * 4096; \
                    _Pragma("unroll") for (int mt = 0; mt < 4; ++mt) { za[mt] = *(const GAS u32x2*)(zb_ + i * 64 + 16 * q + 4 * mt); \
                        _Pragma("unroll") for (int ks = 0; ks < 2; ++ks) qa[mt][ks] = *(const GAS u32x4*)(qb_ + (16 * mt + r) * 64 + 32 * ks + 8 * q); } } while (0)
#define W2_STEP(qa, za, c_) do { GAS bf16_t* sb_ = csb + ((size_t)hd * 32 + (c_)) * 4096 + i * 64 + 4 * q; u32x2 pk[4]; \
                    _Pragma("unroll") for (int mt = 0; mt < 4; ++mt) { pk[mt].x = cvt_pk_bf16(Dt[mt][0], Dt[mt][1]); pk[mt].y = cvt_pk_bf16(Dt[mt][2], Dt[mt][3]); *(GAS u32x2*)(sb_ + 16 * mt) = pk[mt]; } \
                    _Pragma("unroll") for (int mt = 0; mt < 4; ++mt) { f32x4 acc = (f32x4){bf_lo(za[mt].x), bf_hi(za[mt].x), bf_lo(za[mt].y), bf_hi(za[mt].y)}; \
                        _Pragma("unroll") for (int ks = 0; ks < 2; ++ks) { const u32x4 aw = qa[mt][ks]; const u32x4 bw = (u32x4){pk[2 * ks].x, pk[2 * ks].y, pk[2 * ks + 1].x, pk[2 * ks + 1].y}; \
                            acc = __builtin_amdgcn_mfma_f32_16x16x32_bf16(__builtin_bit_cast(bf16x8, aw), __builtin_bit_cast(bf16x8, bw), acc, 0, 0, 0); } \
                        Dt[mt] = acc; } } while (0)
                W2_LOAD(qa0, za0, 0); W2_LOAD(qa1, za1, 1); W2_LOAD(qa2, za2, 2); W2_LOAD(qa3, za3, 3);
                for (int c = 0; c < 32; c += 4) {
                    W2_STEP(qa0, za0, c);     W2_LOAD(qa0, za0, (c + 4 < 32 ? c + 4 : 31));
                    W2_STEP(qa1, za1, c + 1); W2_LOAD(qa1, za1, (c + 5 < 32 ? c + 5 : 31));
                    W2_STEP(qa2, za2, c + 2); W2_LOAD(qa2, za2, (c + 6 < 32 ? c + 6 : 31));
                    W2_STEP(qa3, za3, c + 3); W2_LOAD(qa3, za3, (c + 7 < 32 ? c + 7 : 31)); }
#undef W2_LOAD
#undef W2_STEP
            }
        }
        SEAM(pb + 4);

        for (int rep_ = 0; rep_ <= ((MK_REPEAT >> 5) & 1); ++rep_) if (IN(pb + 5)) {
            PHASE_BASE();
            const int r = lane & 15, q = lane >> 4;
            const GAS float* lnw = INP(17) + (size_t)j * D; const GAS float* lnb = INP(18) + (size_t)j * D;
            for (int it = gw; it < 4096; it += NGW) {
                const int hd = it >> 5, c = it & 31, b = hd >> 4, h = hd & 15;
                const size_t tok0 = (size_t)b * T + c * 64;
                const GAS bf16_t* sb_ = csb + (size_t)it * 4096; const GAS bf16_t* nb_ = cnb + (size_t)it * 4096; const GAS bf16_t* yl_ = cyl + (size_t)it * 4096;
                bf16x8 af[4][2], bfm[4][2];
#pragma unroll
                for (int mt = 0; mt < 4; ++mt)
#pragma unroll
                    for (int ks = 0; ks < 2; ++ks) { af[mt][ks] = *(const GAS bf16x8*)(sb_ + (16 * (r >> 2) + 4 * mt + (r & 3)) * 64 + 32 * ks + 8 * q); bfm[mt][ks] = *(const GAS bf16x8*)(nb_ + (16 * mt + r) * 64 + 32 * ks + 8 * q); }
                u32x4 ylw[4][2], vw[4][2], gw_[4][2]; float bonr[4]; f32x4 lw4[4], lb4[4];
                const int chq = h * 64 + 16 * q;
#pragma unroll
                for (int nt = 0; nt < 4; ++nt) { const size_t tok = tok0 + 16 * nt + r; bonr[nt] = cbon[tok * 16 + h];
#pragma unroll
                    for (int hh = 0; hh < 2; ++hh) { ylw[nt][hh] = *(const GAS u32x4*)(yl_ + (nt * 64 + lane) * 16 + 8 * hh); vw[nt][hh] = *(const GAS u32x4*)(vbuf + tok * D + chq + 8 * hh); gw_[nt][hh] = *(const GAS u32x4*)(gbuf + tok * D + chq + 8 * hh); } }
#pragma unroll
                for (int mt = 0; mt < 4; ++mt) { lw4[mt] = *(const GAS f32x4*)(lnw + chq + 4 * mt); lb4[mt] = *(const GAS f32x4*)(lnb + chq + 4 * mt); }
                asm volatile("" ::: "memory");
                u32x4 wout[4][2];
#pragma unroll
                for (int nt = 0; nt < 4; ++nt) {
                    f32x4 acc[4]; float sum = 0.f; f32x4 yl4[4], v4[4], g4[4];
#pragma unroll
                    for (int hh = 0; hh < 2; ++hh) { unpack8(ylw[nt][hh], yl4[2 * hh], yl4[2 * hh + 1]); unpack8(vw[nt][hh], v4[2 * hh], v4[2 * hh + 1]); unpack8(gw_[nt][hh], g4[2 * hh], g4[2 * hh + 1]); }
#pragma unroll
                    for (int mt = 0; mt < 4; ++mt) { acc[mt] = yl4[mt];
#pragma unroll
                        for (int ks = 0; ks < 2; ++ks) acc[mt] = __builtin_amdgcn_mfma_f32_16x16x32_bf16(af[mt][ks], bfm[nt][ks], acc[mt], 0, 0, 0);
                        sum += (acc[mt][0] + acc[mt][1]) + (acc[mt][2] + acc[mt][3]); }
                    sum += __int_as_float(__builtin_amdgcn_ds_bpermute(4 * (lane ^ 16), __float_as_int(sum))); sum += __int_as_float(__builtin_amdgcn_ds_bpermute(4 * (lane ^ 32), __float_as_int(sum)));
                    const float mean = sum * (1.0f / 64.0f); float sq = 0.f;
#pragma unroll
                    for (int mt = 0; mt < 4; ++mt)
#pragma unroll
                        for (int e = 0; e < 4; ++e) { const float d_ = acc[mt][e] - mean; sq += d_ * d_; }
                    sq += __int_as_float(__builtin_amdgcn_ds_bpermute(4 * (lane ^ 16), __float_as_int(sq))); sq += __int_as_float(__builtin_amdgcn_ds_bpermute(4 * (lane ^ 32), __float_as_int(sq)));
                    const float rstd = rsqrtf(sq * (1.0f / 64.0f) + LNX_EPS);
                    const float bon = bonr[nt];
                    f32x4 o[4];
#pragma unroll
                    for (int mt = 0; mt < 4; ++mt)
#pragma unroll
                        for (int e = 0; e < 4; ++e) o[mt][e] = (((acc[mt][e] - mean) * rstd) * lw4[mt][e] + lb4[mt][e] + bon * v4[mt][e]) * g4[mt][e];
                    wout[nt][0] = pack8(o[0], o[1]); wout[nt][1] = pack8(o[2], o[3]);
                }
#pragma unroll
                for (int nt = 0; nt < 4; ++nt) { const size_t tok = tok0 + 16 * nt + r;
#pragma unroll
                    for (int hh = 0; hh < 2; ++hh) *(GAS u32x4*)(yg + tok * D + chq + 8 * hh) = wout[nt][hh]; }
            }
        }
        SEAM(pb + 5);
#undef cqb
#undef cnb
#undef czb
#undef cyl
#undef csb
#undef cbon
#else
        for (int rep_ = 0; rep_ <= ((MK_REPEAT >> 3) & 1); ++rep_) if (IN(pb + 3)) {
            PHASE_BASE();
            constexpr int VB = 5 * 2048 + 1024 + 64;
            LAS float* sbuf = (LAS float*)lds;
            LAS float* syb = sbuf + 2 * VB;
            const GAS float* k_k = INP(14) + (size_t)j * D; const GAS float* k_a = INP(15) + (size_t)j * D;
            constexpr int NBLK = T / 32;
            for (int item = bx; item < 256; item += G) {
                const int b = item >> 5, h = (item >> 1) & 15, half = item & 1;
                const int pt = tid >> 4, pc = tid & 15;
                const int ch0 = h * 64 + 4 * pc;
                const f32x4 kkw = *(const GAS f32x4*)(k_k + ch0), kaw = *(const GAS f32x4*)(k_a + ch0);
                const int srow = wave * 4 + (lane >> 4), sc = lane & 15;
                const GAS bf16_t* rp = rbuf + ((size_t)b * T + pt) * D + ch0; const GAS bf16_t* kp = kbuf + ((size_t)b * T + pt) * D + ch0; const GAS bf16_t* vp = vbuf + ((size_t)b * T + pt) * D + ch0;
                const GAS bf16_t* lp = lwbuf + ((size_t)b * T + pt) * D + ch0; const GAS bf16_t* ap = abuf + ((size_t)b * T + pt) * D + ch0;
                GAS float* yp = yraw + ((size_t)b * T + pt) * D + h * 64 + half * 32 + 2 * pc;
                u32x2 pr_, pk_, pv_, pl_, pa_;
#define SCAN_LOAD(blk_) do { const size_t o_ = (size_t)(blk_) * 32 * D; pr_ = *(const GAS u32x2*)(rp + o_); pk_ = *(const GAS u32x2*)(kp + o_); pv_ = *(const GAS u32x2*)(vp + o_); pl_ = *(const GAS u32x2*)(lp + o_); pa_ = *(const GAS u32x2*)(ap + o_); } while (0)
#define SCAN_PREP(buf_) do { LAS float* B_ = sbuf + (buf_) * VB; \
                    const f32x4 r4 = (f32x4){bf_lo(pr_.x), bf_hi(pr_.x), bf_lo(pr_.y), bf_hi(pr_.y)}, k4 = (f32x4){bf_lo(pk_.x), bf_hi(pk_.x), bf_lo(pk_.y), bf_hi(pk_.y)}; \
                    const f32x4 v4 = (f32x4){bf_lo(pv_.x), bf_hi(pv_.x), bf_lo(pv_.y), bf_hi(pv_.y)}, l4 = (f32x4){bf_lo(pl_.x), bf_hi(pl_.x), bf_lo(pl_.y), bf_hi(pl_.y)}; \
                    const f32x4 a4 = (f32x4){bf_lo(pa_.x), bf_hi(pa_.x), bf_lo(pa_.y), bf_hi(pa_.y)}; \
                    f32x4 kk = k4 * kkw; float n2 = kk[0] * kk[0] + kk[1] * kk[1] + kk[2] * kk[2] + kk[3] * kk[3]; n2 = row16_sum(n2); \
                    const float inv = 1.0f / fmaxf(sqrtf(n2), 1e-12f); kk = kk * inv; f32x4 wv, km; \
                    _Pragma("unroll") for (int q = 0; q < 4; ++q) { wv[q] = __expf(l4[q]); km[q] = k4[q] * (1.0f + (a4[q] - 1.0f) * kaw[q]); } \
                    *(LAS f32x4*)(B_ + pt * 64 + 4 * pc) = -kk; *(LAS f32x4*)(B_ + 2048 + pt * 64 + 4 * pc) = wv; *(LAS f32x4*)(B_ + 4096 + pt * 64 + 4 * pc) = kk * a4; \
                    *(LAS f32x4*)(B_ + 6144 + pt * 64 + 4 * pc) = km; *(LAS f32x4*)(B_ + 8192 + pt * 64 + 4 * pc) = wv * r4; \
                    { const f32x4 bb_ = kk * a4; float br_ = bb_[0] * r4[0] + bb_[1] * r4[1] + bb_[2] * r4[2] + bb_[3] * r4[3], kr_ = km[0] * r4[0] + km[1] * r4[1] + km[2] * r4[2] + km[3] * r4[3]; \
                      br_ = row16_sum(br_); kr_ = row16_sum(kr_); if (pc == 0) *(LAS f32x2*)(B_ + 11264 + 2 * pt) = (f32x2){br_, kr_}; } \
                    if ((pc >> 3) == half) *(LAS f32x4*)(B_ + 10240 + pt * 32 + 4 * (pc & 7)) = v4; } while (0)
                f32x2 s01 = {0.f, 0.f}, s23 = {0.f, 0.f};
                SCAN_LOAD(0); SCAN_PREP(0); SCAN_LOAD(1);
                __syncthreads();
                for (int blk = 0; blk < NBLK; ++blk) {
                    if (blk + 1 < NBLK) SCAN_PREP((blk + 1) & 1);
                    if (blk + 2 < NBLK) SCAN_LOAD(blk + 2);
                    if (blk > 0) *(GAS f32x2*)(yp + (size_t)(blk - 1) * 32 * D) = *(const LAS f32x2*)(syb + ((blk - 1) & 1) * 1024 + pt * 32 + 2 * pc);
                    const LAS float* B_ = sbuf + (blk & 1) * VB + 4 * sc; const LAS float* V_ = sbuf + (blk & 1) * VB + 10240 + srow;
                    LAS float* yb = syb + (blk & 1) * 1024 + srow;
                    const LAS float* C_ = sbuf + (blk & 1) * VB + 11264;
                    f32x4 al = *(const LAS f32x4*)(B_), w4 = *(const LAS f32x4*)(B_ + 2048), be = *(const LAS f32x4*)(B_ + 4096), km = *(const LAS f32x4*)(B_ + 6144), wr4 = *(const LAS f32x4*)(B_ + 8192);
                    float vi = V_[0]; f32x2 sc2 = *(const LAS f32x2*)(C_);
#pragma unroll 8
                    for (int t = 0; t < 32; ++t) {
                        const int tn = (t + 1) & 31;
                        const f32x4 al_n = *(const LAS f32x4*)(B_ + tn * 64), w4_n = *(const LAS f32x4*)(B_ + 2048 + tn * 64), be_n = *(const LAS f32x4*)(B_ + 4096 + tn * 64);
                        const f32x4 km_n = *(const LAS f32x4*)(B_ + 6144 + tn * 64), wr_n = *(const LAS f32x4*)(B_ + 8192 + tn * 64); const float vi_n = V_[tn * 32]; const f32x2 sc2_n = *(const LAS f32x2*)(C_ + 2 * tn);
                        const f32x2 p = s01 * (f32x2){al[0], al[1]} + s23 * (f32x2){al[2], al[3]};
                        const f32x2 q = s01 * (f32x2){wr4[0], wr4[1]} + s23 * (f32x2){wr4[2], wr4[3]};
                        float sa = p.x + p.y, yo = q.x + q.y;
                        sa += dpp_f<0xB1>(sa); yo += dpp_f<0xB1>(yo); sa += dpp_f<0x4E>(sa); yo += dpp_f<0x4E>(yo);
                        sa += dpp_f<0x141>(sa); yo += dpp_f<0x141>(yo); sa += dpp_f<0x140>(sa); yo += dpp_f<0x140>(yo);
                        const f32x2 u01 = (f32x2){be[0], be[1]} * sa + (f32x2){km[0], km[1]} * vi, u23 = (f32x2){be[2], be[3]} * sa + (f32x2){km[2], km[3]} * vi;
                        s01 = s01 * (f32x2){w4[0], w4[1]} + u01; s23 = s23 * (f32x2){w4[2], w4[3]} + u23;
                        const float y = yo + sa * sc2.x + vi * sc2.y;
                        if (sc == 0) yb[t * 32] = y;
                        al = al_n; w4 = w4_n; be = be_n; km = km_n; wr4 = wr_n; vi = vi_n; sc2 = sc2_n;
                    }
                    __syncthreads();
                }
                *(GAS f32x2*)(yp + (size_t)(NBLK - 1) * 32 * D) = *(const LAS f32x2*)(syb + ((NBLK - 1) & 1) * 1024 + pt * 32 + 2 * pc);
                __syncthreads();
#undef SCAN_LOAD
#undef SCAN_PREP
            }
        }
        SEAM(pb + 3);

        for (int rep_ = 0; rep_ <= ((MK_REPEAT >> 4) & 1); ++rep_) if (IN(pb + 4)) {
            PHASE_BASE();
            const int c0 = 16 * lane;
            f32x4 ka[4], rk[4], lw_[4], lb_[4];
#pragma unroll
            for (int q = 0; q < 4; ++q) { ka[q] = *(const GAS f32x4*)(INP(15) + (size_t)j * D + c0 + 4 * q); rk[q] = *(const GAS f32x4*)(INP(16) + (size_t)j * D + c0 + 4 * q);
                lw_[q] = *(const GAS f32x4*)(INP(17) + (size_t)j * D + c0 + 4 * q); lb_[q] = *(const GAS f32x4*)(INP(18) + (size_t)j * D + c0 + 4 * q); }
            for (int tok = gw; tok < M; tok += NGW) {
                const size_t off = (size_t)tok * D + c0;
                f32x4 y[4], r[4], k[4], v[4], a[4], g[4];
#pragma unroll
                for (int q = 0; q < 4; ++q) y[q] = *(const GAS f32x4*)(yraw + off + 4 * q);
                unpack8(*(const GAS u32x4*)(rbuf + off), r[0], r[1]); unpack8(*(const GAS u32x4*)(rbuf + off + 8), r[2], r[3]);
                unpack8(*(const GAS u32x4*)(kbuf + off), k[0], k[1]); unpack8(*(const GAS u32x4*)(kbuf + off + 8), k[2], k[3]);
                unpack8(*(const GAS u32x4*)(vbuf + off), v[0], v[1]); unpack8(*(const GAS u32x4*)(vbuf + off + 8), v[2], v[3]);
                unpack8(*(const GAS u32x4*)(abuf + off), a[0], a[1]); unpack8(*(const GAS u32x4*)(abuf + off + 8), a[2], a[3]);
                unpack8(*(const GAS u32x4*)(gbuf + off), g[0], g[1]); unpack8(*(const GAS u32x4*)(gbuf + off + 8), g[2], g[3]);
                float dot = 0.f, sy = 0.f;
#pragma unroll
                for (int q = 0; q < 4; ++q)
#pragma unroll
                    for (int e = 0; e < 4; ++e) { const float km = k[q][e] * (1.0f + (a[q][e] - 1.0f) * ka[q][e]); dot += r[q][e] * km * rk[q][e]; sy += y[q][e]; }
                dot = quad_sum(dot); sy = quad_sum(sy);
                const float mean = sy * (1.0f / 64.0f); float sq = 0.f;
#pragma unroll
                for (int q = 0; q < 4; ++q)
#pragma unroll
                    for (int e = 0; e < 4; ++e) { const float d = y[q][e] - mean; sq += d * d; }
                sq = quad_sum(sq);
                const float rstd = rsqrtf(sq * (1.0f / 64.0f) + LNX_EPS);
                f32x4 o[4];
#pragma unroll
                for (int q = 0; q < 4; ++q)
#pragma unroll
                    for (int e = 0; e < 4; ++e) o[q][e] = (((y[q][e] - mean) * rstd) * lw_[q][e] + lb_[q][e] + dot * v[q][e]) * g[q][e];
                *(GAS u32x4*)(yg + off) = pack8(o[0], o[1]); *(GAS u32x4*)(yg + off + 8) = pack8(o[2], o[3]);
            }
        }
        SEAM(pb + 4);

        SEAM(pb + 5);
#endif

        for (int rep_ = 0; rep_ <= ((MK_REPEAT >> 5) & 1); ++rep_) if (IN(pb + 6)) {
            PHASE_BASE();
            SchedPlain S{uni_ptr((const GAS char*)yg), uni_ptr((const GAS char*)(wr_ + WR_WO)), (size_t)256 * D * 2, (size_t)256 * D * 2, 64, 4, G, bx};
            EpiRes E{hcur, hcur};
            gemm_phase(lds, tid, D, D, D, S, E);
        }
        SEAM(pb + 6);

        for (int rep_ = 0; rep_ <= ((MK_REPEAT >> 6) & 1); ++rep_) if (IN(pb + 7)) {
            PHASE_BASE();
            const GAS float* gn = INP(2) + (size_t)(2 * j) * D;
            f32x4 gq[4];
#pragma unroll
            for (int q = 0; q < 4; ++q) gq[q] = *(const GAS f32x4*)(gn + E8(q));
            u32x2 hwn[4];
#pragma unroll
            for (int q = 0; q < 4; ++q) hwn[q] = *(const GAS u32x2*)(hcur + (size_t)gw * D + E8(q));
            for (int tok = gw; tok < M; tok += NGW) {
                f32x4 v[4]; float ss = 0.f; u32x2 hwc[4]; const int tn = (tok + NGW < M) ? tok + NGW : tok;
#pragma unroll
                for (int q = 0; q < 4; ++q) hwc[q] = hwn[q];
#pragma unroll
                for (int q = 0; q < 4; ++q) hwn[q] = *(const GAS u32x2*)(hcur + (size_t)tn * D + E8(q));
#pragma unroll
                for (int q = 0; q < 4; ++q) { const u32x2 hw = hwc[q]; v[q] = (f32x4){bf_lo(hw.x), bf_hi(hw.x), bf_lo(hw.y), bf_hi(hw.y)}; ss += v[q][0] * v[q][0] + v[q][1] * v[q][1] + v[q][2] * v[q][2] + v[q][3] * v[q][3]; }
                const float rs = rsqrtf(wave_sum(ss) * (1.0f / D) + NORM_EPS);
#pragma unroll
                for (int q = 0; q < 4; ++q) { const f32x4 o = v[q] * rs * gq[q]; u32x2 w; w.x = cvt_pk_bf16(o[0], o[1]); w.y = cvt_pk_bf16(o[2], o[3]); *(GAS u32x2*)(hn2 + (size_t)tok * D + E8(q)) = w; }
            }
        }
        SEAM(pb + 7);

        for (int rep_ = 0; rep_ <= ((MK_REPEAT >> 7) & 1); ++rep_) if (IN(pb + 8)) {
            PHASE_BASE();
            SchedPlain S{uni_ptr((const GAS char*)hn2), uni_ptr((const GAS char*)(wr_ + WR_GU)), (size_t)256 * D * 2, (size_t)256 * D * 2, 64, FF / 128, G, bx};
            EpiSwiglu E{hmid, FF};
            gemm_phase(lds, tid, D, D, D, S, E);
        }
        SEAM(pb + 8);

        for (int rep_ = 0; rep_ <= ((MK_REPEAT >> 8) & 1); ++rep_) if (IN(pb + 9)) {
            PHASE_BASE();
            SchedPlain S{uni_ptr((const GAS char*)hmid), uni_ptr((const GAS char*)(wr_ + WR_WD)), (size_t)256 * FF * 2, (size_t)256 * FF * 2, 64, 4, G, bx};
            EpiRes E{hcur, hcur};
            gemm_phase(lds, tid, FF, FF, FF, S, E);
        }
        SEAM(pb + 9);

        for (int rep_ = 0; rep_ <= ((MK_REPEAT >> 9) & 1); ++rep_) if (IN(pb + 10)) {
            PHASE_BASE();
            const GAS float* gn = INP(1) + (size_t)(2 * j + 1) * D;
            f32x4 gq[4];
#pragma unroll
            for (int q = 0; q < 4; ++q) gq[q] = *(const GAS f32x4*)(gn + 16 * lane + 4 * q);
            for (int blk = bx; blk < M / 64; blk += G) {
                u32x4 hn0 = *(const GAS u32x4*)(hcur + (size_t)(blk * 64 + wave * 8) * D + 16 * lane), hn1 = *(const GAS u32x4*)(hcur + (size_t)(blk * 64 + wave * 8) * D + 16 * lane + 8);
                for (int tt = 0; tt < 8; ++tt) { const int tok = blk * 64 + wave * 8 + tt; const int tn = tt < 7 ? tok + 1 : tok;
                    f32x4 v[4]; float ss = 0.f;
                    const u32x4 hc0 = hn0, hc1 = hn1;
                    hn0 = *(const GAS u32x4*)(hcur + (size_t)tn * D + 16 * lane); hn1 = *(const GAS u32x4*)(hcur + (size_t)tn * D + 16 * lane + 8);
                    unpack8(hc0, v[0], v[1]); unpack8(hc1, v[2], v[3]);
#pragma unroll
                    for (int q = 0; q < 4; ++q) { ss += v[q][0] * v[q][0] + v[q][1] * v[q][1] + v[q][2] * v[q][2] + v[q][3] * v[q][3]; }
                    const float rs = rsqrtf(wave_sum(ss) * (1.0f / D) + NORM_EPS);
#pragma unroll
                    for (int q = 0; q < 4; ++q) v[q] = v[q] * rs * gq[q];
                    LAS unsigned char* st_ = lds + wave * 16384 + tt * 2048;
                    *(LAS u32x4*)(st_ + (((2 * lane) ^ tt) * 16)) = pack8(v[0], v[1]); *(LAS u32x4*)(st_ + (((2 * lane + 1) ^ tt) * 16)) = pack8(v[2], v[3]); }
                asm volatile("s_waitcnt lgkmcnt(0)" ::: "memory");
                {   const int tok0 = blk * 64 + wave * 8;
#pragma unroll
                    for (int s_ = 0; s_ < 16; ++s_) { const int g = 4 * s_ + (lane >> 4), t16 = lane & 15, tt = t16 >> 1, hf = t16 & 1;
                        const u32x4 w_ = *(const LAS u32x4*)(lds + wave * 16384 + tt * 2048 + (((2 * g + hf) ^ tt) * 16));
                        *(GAS u32x4*)(ug + ((size_t)g * NBC + (tok0 >> 5)) * S5K + ((tok0 & 31) + tt) * 16 + hf * 8) = w_; }
                    asm volatile("s_waitcnt lgkmcnt(0)" ::: "memory"); } }
        }
        SEAM(pb + 10);

#define WG_REREAD_FENCE() do { asm volatile("s_waitcnt vmcnt(0)" ::: "memory"); __syncthreads(); if (tid == 0) { __builtin_amdgcn_fence(__ATOMIC_ACQUIRE, "agent"); asm volatile("s_waitcnt vmcnt(0)" ::: "memory"); } __syncthreads(); } while (0)
        for (int rep_ = 0; rep_ <= ((MK_REPEAT >> 10) & 1); ++rep_) if (IN(pb + 11)) {
            PHASE_BASE();
            for (int mu = vcu; mu < 256; mu += G) {
                const int g = mu >> 2, pm = (mu >> 1) & 1, pn = mu & 1;
                {   SchedOne S{GUnit{uni_ptr((const GAS char*)ug + (size_t)g * NBC * S5K * 2 + (size_t)pm * 256 * S5K * 2), uni_ptr((const GAS char*)(wss + WSS_M1) + (size_t)g * 256 * 512 * 2), pm, 0, g, 0}};
                    EpiS5E E{eb};
                    gemm_phase(lds, tid, 512, S5K, 512, S, E); }
                WG_REREAD_FENCE();
                if (tid < 256) { const int bq = tid >> 6, p = tid & 63, b = 4 * pm + bq;
                    const float lr = fminf(INP(23)[((size_t)j * 64 + g) * 64 + p], -1e-4f), li = INP(24)[((size_t)j * 64 + g) * 64 + p]; const float dt = __expf(INP(25)[j * 64 + g]);
                    const float mag = expf(32.0f * lr * dt); float rev = 32.0f * (li * dt) * 0.15915494309189535f; rev -= floorf(rev);
                    const float ang = (rev > 0.5f ? rev - 1.0f : rev) * 6.283185307179586f; const float are = mag * cosf(ang), aim = mag * sinf(ang);
                    float hre = 0.f, him = 0.f;
#pragma unroll 1
                    for (int c0 = 0; c0 < 64; c0 += 16) {
                        float ere[16], eim[16];
                        const GAS float* ep = eb + ((size_t)g * NBC + b * 64 + c0) * 128 + p;
#pragma unroll
                        for (int q = 0; q < 16; ++q) { ere[q] = ep[q * 128]; eim[q] = ep[q * 128 + 64]; }
                        GAS bf16_t* dst = ug + ((size_t)g * NBC + b * 64 + c0) * S5K + 512 + p;
#pragma unroll
                        for (int q = 0; q < 16; ++q) {
                            dst[(size_t)q * S5K] = (bf16_t)(cvt_pk_bf16(hre, 0.f) & 0xffffu); dst[(size_t)q * S5K + 64] = (bf16_t)(cvt_pk_bf16(him, 0.f) & 0xffffu);
                            const float nre = are * hre - aim * him + ere[q], nim = are * him + aim * hre + eim[q]; hre = nre; him = nim; }
                    }
                }
                WG_REREAD_FENCE();
                {   SchedOne S{GUnit{uni_ptr((const GAS char*)ug + (size_t)g * NBC * S5K * 2 + (size_t)pm * 256 * S5K * 2), uni_ptr((const GAS char*)(wss + WSS_TOEP) + (size_t)g * 512 * S5K * 2 + (size_t)pn * 256 * S5K * 2), pm, pn, g, 0}};
                    EpiS5Y E{yact, ug, INP(30) + (size_t)j * D};
                    gemm_phase(lds, tid, S5K, S5K, S5K, S, E); }
            }
        }
        SEAM(pb + 11);
#undef WG_REREAD_FENCE

        for (int rep_ = 0; rep_ <= ((MK_REPEAT >> 13) & 1); ++rep_) if (IN(pb + 14)) {
            PHASE_BASE();
            SchedPlain S{uni_ptr((const GAS char*)yact), uni_ptr((const GAS char*)(wss + WSS_GLU)), (size_t)256 * D * 2, (size_t)256 * D * 2, 64, 8, G, bx};
            EpiGlu E{hcur, INP(32) + (size_t)j * 2 * D};
            gemm_phase(lds, tid, D, D, D, S, E);
        }
        SEAM(pb + 14);

        for (int rep_ = 0; rep_ <= ((MK_REPEAT >> 14) & 1); ++rep_) if (IN(pb + 15)) {
            PHASE_BASE();
            LAS float* srt = (LAS float*)lds;
            LAS unsigned* stg = (LAS unsigned*)(srt + 8192);
            {   f32x4 rw[4];
#pragma unroll
                for (int u = 0; u < 4; ++u) rw[u] = *(const GAS f32x4*)(INP(36) + (size_t)j * 8192 + 4 * (tid + NTHREADS * u));
#pragma unroll
                for (int u = 0; u < 4; ++u) { const int i = 4 * (tid + NTHREADS * u);
#pragma unroll
                    for (int z = 0; z < 4; ++z) srt[((i + z) & 7) * 1024 + ((i + z) >> 3)] = rw[u][z]; } }
            const GAS float* gn = INP(2) + (size_t)(2 * j + 1) * D;
            f32x4 gq[4];
#pragma unroll
            for (int q = 0; q < 4; ++q) gq[q] = *(const GAS f32x4*)(gn + E8(q));
            __syncthreads();
            for (int blk = bx; blk < M / 64; blk += G) {
                u32x2 hwn[4];
#pragma unroll
                for (int q = 0; q < 4; ++q) hwn[q] = *(const GAS u32x2*)(hcur + (size_t)(blk * 64 + wave * 8) * D + E8(q));
                for (int tt = 0; tt < 8; ++tt) { const int tok = blk * 64 + wave * 8 + tt; const int tn = tt < 7 ? tok + 1 : tok;
                    f32x4 v[4]; float ss = 0.f; u32x2 hwc[4];
#pragma unroll
                    for (int q = 0; q < 4; ++q) hwc[q] = hwn[q];
#pragma unroll
                    for (int q = 0; q < 4; ++q) hwn[q] = *(const GAS u32x2*)(hcur + (size_t)tn * D + E8(q));
#pragma unroll
                    for (int q = 0; q < 4; ++q) { const u32x2 hw = hwc[q]; v[q] = (f32x4){bf_lo(hw.x), bf_hi(hw.x), bf_lo(hw.y), bf_hi(hw.y)}; ss += v[q][0] * v[q][0] + v[q][1] * v[q][1] + v[q][2] * v[q][2] + v[q][3] * v[q][3]; }
                    const float rs = rsqrtf(wave_sum(ss) * (1.0f / D) + NORM_EPS);
                    float lg[8];
#pragma unroll
                    for (int e = 0; e < 8; ++e) lg[e] = 0.f;
#pragma unroll
                    for (int q = 0; q < 4; ++q) { const f32x4 o = v[q] * rs * gq[q]; u32x2 w; w.x = cvt_pk_bf16(o[0], o[1]); w.y = cvt_pk_bf16(o[2], o[3]); *(GAS u32x2*)(hn2 + (size_t)tok * D + E8(q)) = w;
#pragma unroll
                        for (int e = 0; e < 8; ++e) { const f32x4 rr = *(const LAS f32x4*)(srt + e * 1024 + E8(q));
                            lg[e] += o[0] * rr[0]; lg[e] += o[1] * rr[1]; lg[e] += o[2] * rr[2]; lg[e] += o[3] * rr[3]; } }
#pragma unroll
                    for (int e = 0; e < 8; ++e) lg[e] = wave_sum(lg[e]);
                    int e0 = 0; float v0 = lg[0];
#pragma unroll
                    for (int e = 1; e < 8; ++e) if (lg[e] > v0) { v0 = lg[e]; e0 = e; }
                    int e1 = -1; float v1 = -3.0e38f;
#pragma unroll
                    for (int e = 0; e < 8; ++e) if (e != e0 && lg[e] > v1) { v1 = lg[e]; e1 = e; }
                    const float g0 = 1.0f / (1.0f + expf(v1 - v0)), g1 = 1.0f - g0;
                    if (lane == 0) { const int lt = wave * 8 + tt; stg[lt * 4 + 0] = (unsigned)e0; stg[lt * 4 + 1] = (unsigned)e1; stg[lt * 4 + 2] = __float_as_uint(g0); stg[lt * 4 + 3] = __float_as_uint(g1); }
                }
                __syncthreads();
                if (wave == 0) { const int tok = blk * 64 + lane;
                    const int e0 = (int)stg[lane * 4 + 0], e1 = (int)stg[lane * 4 + 1]; const float g0 = __uint_as_float(stg[lane * 4 + 2]), g1 = __uint_as_float(stg[lane * 4 + 3]);
                    const unsigned long long lt_mask = (lane == 0) ? 0ull : (~0ull >> (64 - lane));
                    unsigned pos0 = 0, pos1 = 0;
#pragma unroll
                    for (int e = 0; e < 8; ++e) { const unsigned long long m0 = __ballot(e0 == e), m1 = __ballot(e1 == e); const unsigned n0 = (unsigned)__popcll(m0), n1 = (unsigned)__popcll(m1);
                        if (lane == 0) blkcnt[blk * 8 + e] = n0 + n1;
                        if (e0 == e) pos0 = (unsigned)__popcll(m0 & lt_mask);
                        if (e1 == e) pos1 = n0 + (unsigned)__popcll(m1 & lt_mask); }
                    asg_pe[2 * tok] = ((unsigned)e0 << 24) | pos0; asg_pe[2 * tok + 1] = ((unsigned)e1 << 24) | pos1; asg_gate[2 * tok] = g0; asg_gate[2 * tok + 1] = g1; }
                __syncthreads();
            }
        }
        SEAM(pb + 15);

        if (IN(pb + 16) || IN(pb + 17) || IN(pb + 18)) {
            PHASE_BASE();
            LAS unsigned* sbase = (LAS unsigned*)(lds + 65536);
            { const int e = wave; unsigned c[4]; unsigned tot = 0;
#pragma unroll
              for (int i = 0; i < 4; ++i) { c[i] = blkcnt[(4 * lane + i) * 8 + e]; }
              unsigned run = c[0] + c[1] + c[2] + c[3], incl = run;
#pragma unroll
              for (int o = 1; o < 64; o <<= 1) { const unsigned t_ = (unsigned)__builtin_amdgcn_ds_bpermute(4 * (lane - o), (int)incl); if (lane >= o) incl += t_; }
              unsigned ex = incl - run;
#pragma unroll
              for (int i = 0; i < 4; ++i) { sbase[(4 * lane + i) * 8 + e] = ex; ex += c[i]; }
              tot = (unsigned)__builtin_amdgcn_readlane((int)incl, 63);
              if (lane == 0) MISC[32 + e] = tot; }
            __syncthreads();
            if (tid == 0) { unsigned acc_ = 0; MISC[16] = 0u;
                for (int e = 0; e < 8; ++e) { const unsigned c = MISC[32 + e]; acc_ += (c + 255u) >> 8; MISC[17 + e] = acc_; } }
            __syncthreads();
        }
        for (int rep_ = 0; rep_ <= ((MK_REPEAT >> 15) & 1); ++rep_) if (IN(pb + 16)) {
            PHASE_BASE();
            unsigned cnt[8], pst[8];
#pragma unroll
            for (int e = 0; e < 8; ++e) { cnt[e] = MISC[32 + e]; pst[e] = MISC[16 + e] * 256u; }
            const LAS unsigned* sbase = (const LAS unsigned*)(lds + 65536);
            for (int a = gw * 64 + lane; a < NASG; a += NGW * 64) { const unsigned pe = asg_pe[a]; const int e = (int)(pe >> 24); const unsigned pos = pe & 0xffffffu;
                unsigned ps = 0;
#pragma unroll
                for (int q = 0; q < 8; ++q) ps = (q == e) ? pst[q] : ps;
                const int tok = a >> 1; const unsigned row = ps + sbase[(tok >> 6) * 8 + e] + pos;
                rowslot[row] = a; rowgate[row] = asg_gate[a]; rowtok[row] = tok; ((GAS int*)(wsl + WS_TROW))[a] = ((int)row >= MOE_TAIL_ROW0) ? (int)row - MOE_TAIL_ROW0 : -1; }
            if (bx < 8) {
#pragma unroll
                for (int e = 0; e < 8; ++e) if (e == bx) { const unsigned padded = ((cnt[e] + 255u) >> 8) << 8;
                    for (unsigned r = cnt[e] + tid; r < padded; r += NTHREADS) { rowslot[pst[e] + r] = -1; rowgate[pst[e] + r] = 0.f; rowtok[pst[e] + r] = 0; } }
            }
        }
        SEAM(pb + 16);

        for (int rep_ = 0; rep_ <= ((MK_REPEAT >> 16) & 1); ++rep_) if (IN(pb + 17)) {
            PHASE_BASE();
            SchedMoeG S{uni_ptr((const GAS char*)hn2), uni_ptr((const GAS char*)(wsl + WS_WM + WM_GU)), (size_t)2 * FE * D * 2, (size_t)256 * D * 2, FE / 128, G, bx, MISC + 16, rowtok};
#if MK_EPISKIP
            EpiSwiglu E{hmidm, FE, rep_};
#else
            EpiSwiglu E{hmidm, FE};
#endif
#if MK_STAMP && MK_STAMP != 6
            if (j == 0 && tid == 0) MISC[40] = 1u;
            __syncthreads();
#endif
            gemm_phase(lds, tid, D, D, D, S, E);
#if MK_STAMP
            __syncthreads();
            if (tid == 0) MISC[40] = 0u;
#endif
        }
        SEAM(pb + 17);

        for (int rep_ = 0; rep_ <= ((MK_REPEAT >> 17) & 1); ++rep_) if (IN(pb + 18)) {
            PHASE_BASE();
            EpiMoeDown E{y2, rowslot, rowgate, (GAS bf16_t*)(wsl + WS_Y2T)};
            {   SchedMoeMain S{uni_ptr((const GAS char*)hmidm), uni_ptr((const GAS char*)(wsl + WS_WM + WM_WD)), (size_t)256 * FE * 2, (size_t)D * FE * 2, (size_t)256 * FE * 2, 4, G, bx, MISC + 16};
                gemm_phase(lds, tid, FE, FE, FE, S, E); }
            {   SchedMoeTail S{uni_ptr((const GAS char*)hmidm), uni_ptr((const GAS char*)(wsl + WS_WM + WM_WD)), (size_t)256 * FE * 2, (size_t)D * FE * 2, (size_t)256 * FE * 2, (size_t)(FE / 4) * 2, G, vcu, MISC + 16};
                gemm_phase(lds, tid, FE / 4, FE, FE, S, E); }
        }
        SEAM(pb + 18);
    }

    if (MK_N_LAUNCHES == 1 && hi < NPH - 1) xcd_barrier(bar);
#if MK_PROBE_SRC >= 2
    if (IN(NPH - 1)) {
        PHASE_BASE();
        for (int tok = gw; tok < M; tok += NGW) {
#pragma unroll
            for (int q = 0; q < 4; ++q) { f32x4 x;
                if (MK_PROBE_SRC == 2) { const u32x2 w = *(const GAS u32x2*)((const GAS bf16_t*)(ar + MK_PROBE_OFF) + (size_t)tok * D + 4 * lane + 256 * q); x = (f32x4){bf_lo(w.x), bf_hi(w.x), bf_lo(w.y), bf_hi(w.y)}; }
                else if (MK_PROBE_SRC == 5) { x = *(const GAS f32x4*)(INP(MK_PROBE_INP) + 4 * lane + 256 * q); }
                else if (MK_PROBE_SRC == 4) { x = (f32x4){0.f, 0.f, 0.f, 0.f}; const size_t offs[5] = {AR_R, AR_K, (size_t)WS_VF - (size_t)WS_AR, AR_A, AR_G};
#pragma unroll
                    for (int z = 0; z < 5; ++z) { const u32x2 w = *(const GAS u32x2*)((const GAS bf16_t*)(ar + offs[z]) + (size_t)tok * D + 4 * lane + 256 * q); x += (f32x4){bf_lo(w.x), bf_hi(w.x), bf_lo(w.y), bf_hi(w.y)}; } }
                else x = *(const GAS f32x4*)((const GAS float*)(ar + MK_PROBE_OFF) + (size_t)tok * D + 4 * lane + 256 * q);
                *(GAS f32x4*)((GAS float*)args.out + (size_t)tok * D + 4 * lane + 256 * q) = x; }
        }
    }
#else
    if (IN(NPH - 1)) {
        PHASE_BASE();
        f32x4 gq[4];
#pragma unroll
        for (int q = 0; q < 4; ++q) gq[q] = *(const GAS f32x4*)(INP(3) + E8(q));
        u32x2 hwn[4], yan[4], ybn[4];
        u32x2 trn = *(const GAS u32x2*)((const GAS int*)(wsl + WS_TROW) + 2 * gw);
#pragma unroll
        for (int q = 0; q < 4; ++q) { hwn[q] = *(const GAS u32x2*)((MK_PROBE_SRC ? hbuf1 : hbuf0) + (size_t)gw * D + E8(q));
            yan[q] = *(const GAS u32x2*)(y2 + (size_t)(2 * gw) * D + E8(q)); ybn[q] = *(const GAS u32x2*)(y2 + (size_t)(2 * gw + 1) * D + E8(q)); }
        for (int tok = gw; tok < M; tok += NGW) {
            f32x4 v[4]; float ss = 0.f; u32x2 hwc[4], yac[4], ybc[4]; const int tn = (tok + NGW < M) ? tok + NGW : tok;
#pragma unroll
            for (int q = 0; q < 4; ++q) { hwc[q] = hwn[q]; yac[q] = yan[q]; ybc[q] = ybn[q]; }
            const u32x2 trc = trn; trn = *(const GAS u32x2*)((const GAS int*)(wsl + WS_TROW) + 2 * tn);
            const int tr0 = __builtin_amdgcn_readfirstlane((int)trc.x), tr1 = __builtin_amdgcn_readfirstlane((int)trc.y);
#pragma unroll
            for (int q = 0; q < 4; ++q) { hwn[q] = *(const GAS u32x2*)((MK_PROBE_SRC ? hbuf1 : hbuf0) + (size_t)tn * D + E8(q));
                yan[q] = *(const GAS u32x2*)(y2 + (size_t)(2 * tn) * D + E8(q)); ybn[q] = *(const GAS u32x2*)(y2 + (size_t)(2 * tn + 1) * D + E8(q)); }
#pragma unroll
            for (int q = 0; q < 4; ++q) { const u32x2 hw = hwc[q];
                f32x4 x = (f32x4){bf_lo(hw.x), bf_hi(hw.x), bf_lo(hw.y), bf_hi(hw.y)};
                if (MK_PROBE_Y2) { const u32x2 ya = yac[q], yb = ybc[q];
                x[0] += bf_lo(ya.x) + bf_lo(yb.x); x[1] += bf_hi(ya.x) + bf_hi(yb.x); x[2] += bf_lo(ya.y) + bf_lo(yb.y); x[3] += bf_hi(ya.y) + bf_hi(yb.y);
                Y2T_ADD2(x, tr0, q); Y2T_ADD2(x, tr1, q); }
                v[q] = x; ss += x[0] * x[0] + x[1] * x[1] + x[2] * x[2] + x[3] * x[3]; }
            const float rs = rsqrtf(wave_sum(ss) * (1.0f / D) + NORM_EPS);
#pragma unroll
            for (int q = 0; q < 4; ++q) *(GAS f32x4*)((GAS float*)args.out + (size_t)tok * D + E8(q)) = v[q] * rs * gq[q];
        }
    }
#endif
#if MK_STAMP
    if (bx0 == 0 && tid0 == 0) {
        volatile LAS unsigned long long* st_ = (volatile LAS unsigned long long*)(lds + MISC_OFF + 256);
        const unsigned long long c0 = st_[0], r0 = st_[1], c1 = st_[2], r1 = st_[3], c2 = st_[4], r2 = st_[5], c3 = st_[6], r3 = st_[7];
        unsigned long long us_ = 0;
        if (MK_STAMP == 1) us_ = (c1 - c0) / 16;
        if (MK_STAMP == 2) us_ = (r1 - r0) * 10 / 16;
        if (MK_STAMP == 3) us_ = (r3 - r0) / 20;
        if (MK_STAMP == 4) us_ = (r2 - r1) * 10 / 2;
        if (MK_STAMP == 5 || MK_STAMP == 6) us_ = (c3 - c0) * 100 / (r3 - r0);
        (void)c2;
        if (us_ > 30000) us_ = 30000;
        const unsigned long long t0_ = __builtin_amdgcn_s_memrealtime();
        while (__builtin_amdgcn_s_memrealtime() - t0_ < us_ * 100) __builtin_amdgcn_s_sleep(16);
    }
#endif
#undef IN
#undef SEAM
#undef hbuf0
#undef vfirst
#undef y2
#undef wr_
#undef wss
#undef hin_l
#undef hcur
#undef xs
#undef rbuf
#undef kbuf
#undef vbuf
#undef l1
#undef lwbuf
#undef abuf
#undef gbuf
#undef yraw
#undef yg
#undef hn2
#undef hmid
#undef ug
#undef eb
#undef yact
#undef asg_pe
#undef asg_gate
#undef xsm
#undef rowslot
#undef rowgate
#undef hmidm
#undef blkcnt
#undef rowtok
#undef INP
#undef PHASE_BASE
}

extern "C" void kernel_launch(void* const* d_in, const int* in_sizes, int n_in, void* d_out, int out_size, void* d_ws, size_t ws_size, hipStream_t stream) {
    static int grid = 0;
    if (grid == 0) {
        if (n_in != 40 || out_size != M * D || ws_size < WS_END) { fprintf(stderr, "kernel_launch: unexpected shapes (n_in %d, out %d, ws %zu < %zu)\n", n_in, out_size, ws_size, (size_t)WS_END); grid = -1; return; }
        int dev = 0, cus = 0, per_cu = 0;
        if (hipGetDevice(&dev) != hipSuccess || hipDeviceGetAttribute(&cus, hipDeviceAttributeMultiprocessorCount, dev) != hipSuccess) { grid = -1; return; }
        if (hipFuncSetAttribute((const void*)mk_fwd, hipFuncAttributeMaxDynamicSharedMemorySize, LDS_BYTES) != hipSuccess) { fprintf(stderr, "kernel_launch: hipFuncSetAttribute failed\n"); grid = -1; return; }
        if (hipOccupancyMaxActiveBlocksPerMultiprocessor(&per_cu, (const void*)mk_fwd, NTHREADS, LDS_BYTES) != hipSuccess || per_cu < 1) fprintf(stderr, "kernel_launch: occupancy query says %d\n", per_cu);
        (void)hipGetLastError();
        grid = cus;
    }
    if (grid < 0) return;
    (void)in_sizes;
#ifdef MK_ZERO_WS
    if (hipMemsetAsync((char*)d_ws, 0, WS_END, stream) != hipSuccess) return;
    if (hipMemsetAsync((char*)d_out, 0, (size_t)M * D * 4, stream) != hipSuccess) return;
#endif
    if (hipMemsetAsync((char*)d_ws + WS_CTL, 0, CTL_BYTES, stream) != hipSuccess) return;
    Args a{};
    for (int i = 0; i < 40; ++i) a.in[i] = (const float*)d_in[i];
    a.out = (float*)d_out; a.ws = (unsigned char*)d_ws;
#if MK_N_LAUNCHES == 1
    a.ph_lo = 0; a.ph_hi = (MK_STOP_AFTER + 1 < NPH - 1) ? MK_STOP_AFTER + 1 : NPH;
    hipLaunchKernelGGL(mk_fwd, dim3(grid), dim3(NTHREADS), LDS_BYTES, stream, a);
#else
    for (int p = 0; p < NPH; ++p) { if (p > MK_STOP_AFTER && p != NPH - 1) continue; a.ph_lo = p; a.ph_hi = p + 1; hipLaunchKernelGGL(mk_fwd, dim3(grid), dim3(NTHREADS), LDS_BYTES, stream, a); }
#endif
}
```
